# Optimizing an MI355X kernel written in HIP

```python
import jax, jax.numpy as jnp
from jax import lax
import numpy as np

D_MODEL = 2048
BATCH = 4
SEQ = 2048
DEPTH = 1

CHUNK = 64
Q_BLOCK = 128
FOX_HEADS = 8
FOX_HEAD_DIM = 128
FOX_WIDTH = FOX_HEADS * FOX_HEAD_DIM
RWKV_HEAD_DIM = 64
RWKV_HEADS = 16
RWKV_WIDTH = RWKV_HEADS * RWKV_HEAD_DIM
DECAY_LORA = 96
AAA_LORA = 96
GATE_LORA = 256
RWKV_LNX_EPS = 64e-5
D_FF = ((8 * D_MODEL // 3 + 255) // 256) * 256
DEEPNORM_ALPHA = (2.0 * DEPTH) ** 0.25
DEEPNORM_BETA = (8.0 * DEPTH) ** -0.25
LN_EPS = 1e-5
RMS_EPS = 1e-6
FOX_COLS = 4 * FOX_WIDTH + FOX_HEADS
RWKV_COLS = 3 * RWKV_WIDTH + DECAY_LORA + AAA_LORA + GATE_LORA
IN_COLS = FOX_COLS + RWKV_COLS + 2 * D_MODEL

kernel_name = "fox_rwkv7_gated_hybrid_deepnorm_adaln"


def _layernorm(x):
    xf = x.astype(jnp.float32)
    mu = jnp.mean(xf, axis=-1, keepdims=True)
    var = jnp.mean(jnp.square(xf - mu), axis=-1, keepdims=True)
    return ((xf - mu) * lax.rsqrt(var + LN_EPS)).astype(x.dtype)


def _rmsnorm(x, g):
    xf = x.astype(jnp.float32)
    y = xf * lax.rsqrt(jnp.mean(jnp.square(xf), axis=-1, keepdims=True) + RMS_EPS)
    return y.astype(x.dtype) * g


def _forgetting_attention(q, k, v, log_f):
    s_len = q.shape[2]
    cum = jnp.cumsum(log_f, axis=-1)
    scale = FOX_HEAD_DIM ** -0.5
    outs = []
    for blk in range(s_len // Q_BLOCK):
        q0, q1 = blk * Q_BLOCK, (blk + 1) * Q_BLOCK
        qb = q[:, :, q0:q1]
        kb, vb = k[:, :, :q1], v[:, :, :q1]
        logits = jnp.einsum('bhqd,bhkd->bhqk', qb, kb).astype(jnp.float32) * scale
        logits = logits + cum[:, :, q0:q1, None] - cum[:, :, None, :q1]
        qpos = jnp.arange(q0, q1)[:, None]
        kpos = jnp.arange(q1)[None, :]
        logits = jnp.where(kpos <= qpos, logits, -jnp.inf)
        p = jax.nn.softmax(logits, axis=-1)
        outs.append(jnp.einsum('bhqk,bhkd->bhqd', p.astype(vb.dtype), vb))
    return jnp.concatenate(outs, axis=2)


def _rwkv7_recurrence(r, w, k, v, a, b):
    bsz, _, heads, n = r.shape

    def step(state, inp):
        r_t, w_t, k_t, v_t, a_t, b_t = inp
        sa = jnp.einsum('bhvk,bhk->bhv', state, a_t)
        state = (state * w_t[:, :, None, :]
                 + sa[..., None] * b_t[:, :, None, :]
                 + v_t[..., None] * k_t[:, :, None, :])
        y = jnp.einsum('bhvk,bhk->bhv', state, r_t)
        return state, y

    xs = tuple(jnp.moveaxis(t, 1, 0) for t in (r, w, k, v, a, b))
    s0 = jnp.zeros((bsz, heads, n, n), jnp.float32)
    _, ys = lax.scan(step, s0, xs)
    return jnp.moveaxis(ys, 0, 1)


def setup_inputs(seed: int = 0) -> dict:
    key = jax.random.key(seed)
    ks = jax.random.split(key, 32)
    f32 = jnp.float32
    nrm = lambda i, shape, s: (jax.random.normal(ks[i], shape, f32) * s).astype(f32)
    D = D_MODEL
    return {
        "x": nrm(0, (BATCH, SEQ, D), 1.0),
        "c": nrm(1, (BATCH, D), 1.0),
        "w_ada": nrm(2, (D, 6 * D), 0.5 * D ** -0.5),
        "b_ada": nrm(3, (6 * D,), 0.01),
        "w_in": nrm(4, (D, IN_COLS), D ** -0.5),
        "b_fgate": 2.0 + nrm(5, (FOX_HEADS,), 0.5),
        "q_norm_g": 1.0 + nrm(6, (FOX_HEAD_DIM,), 0.02),
        "k_norm_g": 1.0 + nrm(7, (FOX_HEAD_DIM,), 0.02),
        "rwkv_mu": jax.random.uniform(ks[8], (RWKV_COLS,), f32, 0.1, 0.9),
        "rwkv_w0": nrm(9, (RWKV_WIDTH,), 0.5),
        "rwkv_w2": nrm(10, (DECAY_LORA, RWKV_WIDTH), 0.5 * DECAY_LORA ** -0.5),
        "rwkv_a0": nrm(11, (RWKV_WIDTH,), 0.1),
        "rwkv_a2": nrm(12, (AAA_LORA, RWKV_WIDTH), AAA_LORA ** -0.5),
        "rwkv_g2": nrm(13, (GATE_LORA, RWKV_WIDTH), GATE_LORA ** -0.5),
        "rwkv_k_k": 0.85 + nrm(14, (RWKV_WIDTH,), 0.02),
        "rwkv_k_a": 1.0 + nrm(15, (RWKV_WIDTH,), 0.02),
        "rwkv_r_k": nrm(16, (RWKV_HEADS, RWKV_HEAD_DIM), 0.1),
        "rwkv_lnx_g": 1.0 + nrm(17, (RWKV_WIDTH,), 0.02),
        "rwkv_lnx_b": nrm(18, (RWKV_WIDTH,), 0.01),
        "w_branch_a": nrm(19, (FOX_WIDTH, D), DEEPNORM_BETA * FOX_WIDTH ** -0.5),
        "w_branch_b": nrm(20, (RWKV_WIDTH, D), DEEPNORM_BETA * RWKV_WIDTH ** -0.5),
        "w_out": nrm(21, (D, D), DEEPNORM_BETA * D ** -0.5),
        "ln1_g": 1.0 + nrm(22, (D,), 0.02),
        "ln1_b": nrm(23, (D,), 0.01),
        "w_ffn_gu": nrm(24, (D, 2 * D_FF), D ** -0.5),
        "w_ffn_down": nrm(25, (D_FF, D), DEEPNORM_BETA * D_FF ** -0.5),
        "ln2_g": 1.0 + nrm(26, (D,), 0.02),
        "ln2_b": nrm(27, (D,), 0.01),
    }


def reference(x, c, w_ada, b_ada, w_in, b_fgate, q_norm_g, k_norm_g,
              rwkv_mu, rwkv_w0, rwkv_w2, rwkv_a0, rwkv_a2, rwkv_g2,
              rwkv_k_k, rwkv_k_a, rwkv_r_k, rwkv_lnx_g, rwkv_lnx_b,
              w_branch_a, w_branch_b, w_out, ln1_g, ln1_b,
              w_ffn_gu, w_ffn_down, ln2_g, ln2_b):
    assert x.shape[1] % CHUNK == 0
    B, S, _ = x.shape
    f32 = jnp.float32

    mod = jnp.einsum('bd,de->be', jax.nn.silu(c), w_ada) + b_ada
    shift1, scale1, gate1, shift2, scale2, gate2 = jnp.split(mod[:, None, :], 6, axis=-1)

    for _layer in range(DEPTH):
        h = _layernorm(x) * (1.0 + scale1) + shift1
        proj = jnp.einsum('bsd,de->bse', h, w_in)
        fox = proj[..., :FOX_COLS]
        rw = proj[..., FOX_COLS:FOX_COLS + RWKV_COLS]
        gate_a, gate_b = jnp.split(proj[..., FOX_COLS + RWKV_COLS:], 2, axis=-1)

        fq, fk, fv, f_og, f_logit = jnp.split(
            fox, [FOX_WIDTH, 2 * FOX_WIDTH, 3 * FOX_WIDTH, 4 * FOX_WIDTH], axis=-1)
        q = _rmsnorm(fq.reshape(B, S, FOX_HEADS, FOX_HEAD_DIM), q_norm_g)
        k = _rmsnorm(fk.reshape(B, S, FOX_HEADS, FOX_HEAD_DIM), k_norm_g)
        v = fv.reshape(B, S, FOX_HEADS, FOX_HEAD_DIM)
        log_f = jax.nn.log_sigmoid((f_logit + b_fgate).astype(f32))
        o = _forgetting_attention(q.transpose(0, 2, 1, 3), k.transpose(0, 2, 1, 3),
                                  v.transpose(0, 2, 1, 3), log_f.transpose(0, 2, 1))
        o = o.transpose(0, 2, 1, 3).reshape(B, S, FOX_WIDTH) * jax.nn.sigmoid(f_og)
        u_a = jnp.einsum('bse,ed->bsd', o, w_branch_a)

        rw_prev = jnp.pad(rw, ((0, 0), (1, 0), (0, 0)))[:, :-1]
        rw = rw + (rw_prev - rw) * rwkv_mu
        r, kr, vr, xw, xa, xg = jnp.split(
            rw, [RWKV_WIDTH, 2 * RWKV_WIDTH, 3 * RWKV_WIDTH, 3 * RWKV_WIDTH + DECAY_LORA,
                 3 * RWKV_WIDTH + DECAY_LORA + AAA_LORA], axis=-1)
        w_raw = -jax.nn.softplus(-(rwkv_w0 + jnp.tanh(xw) @ rwkv_w2)) - 0.5
        w = jnp.exp(-jnp.exp(w_raw.astype(f32)))
        a = jax.nn.sigmoid(rwkv_a0 + xa @ rwkv_a2)
        g = jax.nn.sigmoid(xg) @ rwkv_g2
        hs = lambda t: t.reshape(B, S, RWKV_HEADS, RWKV_HEAD_DIM).astype(f32)
        kk = hs(kr * rwkv_k_k)
        kk = kk / jnp.maximum(jnp.linalg.norm(kk, axis=-1, keepdims=True), 1e-12)
        kr = kr * (1.0 + (a - 1.0) * rwkv_k_a)
        rh, kh, vh, ah = hs(r), hs(kr), hs(vr), hs(a)
        y = _rwkv7_recurrence(rh, hs(w), kh, vh, -kk, kk * ah)
        mu_y = jnp.mean(y, axis=-1, keepdims=True)
        var_y = jnp.mean(jnp.square(y - mu_y), axis=-1, keepdims=True)
        y = (y - mu_y) * lax.rsqrt(var_y + RWKV_LNX_EPS)
        y = y.reshape(B, S, RWKV_WIDTH) * rwkv_lnx_g + rwkv_lnx_b
        bonus = jnp.sum(rh * kh * rwkv_r_k, axis=-1, keepdims=True) * vh
        y = (y + bonus.reshape(B, S, RWKV_WIDTH)).astype(x.dtype) * g
        u_b = jnp.einsum('bse,ed->bsd', y, w_branch_b)

        merged = jax.nn.sigmoid(gate_a) * u_a + jax.nn.sigmoid(gate_b) * u_b
        mix_out = jnp.einsum('bsd,de->bse', merged, w_out)
        x = _layernorm(DEEPNORM_ALPHA * x + gate1 * mix_out) * ln1_g + ln1_b

        h2 = _layernorm(x) * (1.0 + scale2) + shift2
        gu = jnp.einsum('bsd,df->bsf', h2, w_ffn_gu)
        ff_gate, ff_up = jnp.split(gu, 2, axis=-1)
        ffn = jnp.einsum('bsf,fd->bsd', jax.nn.silu(ff_gate) * ff_up, w_ffn_down)
        x = _layernorm(DEEPNORM_ALPHA * x + gate2 * ffn) * ln2_g + ln2_b

    return x
```

```cpp
#include <hip/hip_runtime.h>
#include <hip/hip_bf16.h>
#include <hip/hip_cooperative_groups.h>
#include <cstdio>
#include <cstdint>
namespace cg = cooperative_groups;

namespace pg8 {
#define PG8_LAS __attribute__((address_space(3)))
typedef unsigned short bf16_t;
typedef short bf16x8 __attribute__((ext_vector_type(8)));
typedef float f32x4 __attribute__((ext_vector_type(4)));
typedef unsigned u32x4 __attribute__((ext_vector_type(4)));
constexpr int BM = 256, BK = 64, HALF = 128, HTB = HALF * BK * 2  , STAGE_BYTES = 8 * HTB, NXCD = 8, WGM = 8;

__host__ __device__ __forceinline__ int lds_byte(int r, int c) { const int st = (r >> 4) * 2 + (c >> 5), rr = r & 15, cc = c & 31, ob = rr * 64 + cc * 2; return st * 1024 + (ob ^ (((ob >> 9) & 1) << 5)); }
__host__ __device__ __forceinline__ void stage_rc(int b, int& R, int& C) { const int st = b / 1024, sb = b % 1024, swz = sb ^ (((sb >> 9) & 1) << 5); R = (st >> 1) * 16 + swz / 64; C = (st & 1) * 32 + (swz % 64) / 2; }
__host__ __device__ __forceinline__ int perm32(int rho) { const int n = rho >> 4, i = rho & 15; return 8 * (i >> 2) + 4 * n + (i & 3); }

struct Unit { int pm, pn; };
struct Gemm { const bf16_t* A; const bf16_t* Bt; int M, N, K; };

struct StaticOrder {
    int nM, nN, nwg, G, c;
    __host__ __device__ void init(int M, int N, int G_, int c_) { nM = M / BM; nN = N / BM; nwg = nM * nN; G = G_; c = c_; }
    __host__ __device__ bool next(int i, Unit& u) const {
        const long L = (long)i * G + c; if (L >= nwg) return false;
        int wgid = (int)L; { const int q = nwg / NXCD, r = nwg % NXCD, xcd = wgid % NXCD, off = wgid / NXCD; wgid = (xcd < r ? xcd * (q + 1) : r * (q + 1) + (xcd - r) * q) + off; }
        const int nig = WGM * nN, gid = wgid / nig, fm = gid * WGM, gsz = (nM - fm) < WGM ? (nM - fm) : WGM;
        u.pm = fm + ((wgid % nig) % gsz); u.pn = (wgid % nig) / gsz; return true;
    }
    __device__ __forceinline__ void a_ready(const Unit&) const {}
    __device__ __forceinline__ void done(const Unit&) const {}
};
__device__ __forceinline__ unsigned cvt_pk_bf16(float lo, float hi) { unsigned r; asm volatile("v_cvt_pk_bf16_f32 %0, %1, %2" : "=v"(r) : "v"(lo), "v"(hi)); return r; }
typedef float f32x2 __attribute__((ext_vector_type(2)));
template <class Epi, class Sched, bool ALIGN_EPI = false, bool SP2 = false>
__device__ __forceinline__ void gemm_phase(PG8_LAS unsigned char* lds, const Gemm g, const Sched& S, const Epi& E) {
    int tid = threadIdx.x; asm volatile("" : "+v"(tid));
    const int wid = __builtin_amdgcn_readfirstlane(tid >> 6), lane = tid & 63, wr = wid >> 2, wc = wid & 3, fr = lane & 15, fq = lane >> 4;
    const int K = g.K, nt = K / BK;
    unsigned voffA[2], voffB[2];
#pragma unroll
    for (int i = 0; i < 2; ++i) { int R, C; stage_rc(tid * 16 + i * 8192, R, C); const int Rb = Epi::PERM ? ((R & ~31) + perm32(R & 31)) : R;
        voffA[i] = (unsigned)(R * K + C) * 2u; voffB[i] = (unsigned)(Rb * K + C) * 2u; }
    const size_t kstep = (size_t)(BK * 2);
    const size_t hstep = (size_t)HALF * K * 2;
    const size_t tstep = 2 * hstep;
    const unsigned ldsw = (unsigned)wid * 1024u;
    const int aoff = lds_byte(wr * 64 + fr, fq * 8), boff = lds_byte(wc * 32 + fr, fq * 8);
#define PG8_SA(b, h) (((b) * 2 + (h)) * HTB)
#define PG8_SB(b, h) ((4 + (b) * 2 + (h)) * HTB)
#define PG8_STAGE(bufoff, gbase, voff) do { _Pragma("unroll") for (int _i = 0; _i < 2; ++_i) \
        __builtin_amdgcn_global_load_lds((const unsigned*)((const char*)(gbase) + (voff)[_i]), (PG8_LAS unsigned*)(lds + (bufoff) + ldsw + _i * 8192), 16, 0, 0); } while (0)
#define PG8_LDA(dst, b, h) do { _Pragma("unroll") for (int m = 0; m < 4; ++m) _Pragma("unroll") for (int k = 0; k < 2; ++k) dst[m][k] = *(const PG8_LAS bf16x8*)(lds + PG8_SA(b, h) + aoff + m * 2048 + k * 1024); } while (0)
#define PG8_LDB(dst, b, h) do { _Pragma("unroll") for (int n = 0; n < 2; ++n) _Pragma("unroll") for (int k = 0; k < 2; ++k) dst[n][k] = *(const PG8_LAS bf16x8*)(lds + PG8_SB(b, h) + boff + n * 2048 + k * 1024); } while (0)
#define PG8_MMA(ai, bj, At, Bt) do { __builtin_amdgcn_s_setprio(1); _Pragma("unroll") for (int m = 0; m < 4; ++m) _Pragma("unroll") for (int n = 0; n < 2; ++n) _Pragma("unroll") for (int k = 0; k < 2; ++k) \
        acc[ai][bj][m][n] = __builtin_amdgcn_mfma_f32_16x16x32_bf16(Bt[n][k], At[m][k], acc[ai][bj][m][n], 0, 0, 0); __builtin_amdgcn_s_setprio(0); } while (0)
#define PG8_WAIT_V(n) asm volatile("s_waitcnt vmcnt(" #n ")" ::: "memory")
#define PG8_WAIT_L(n) asm volatile("s_waitcnt lgkmcnt(" #n ")" ::: "memory")
#define PG8_BAR __builtin_amdgcn_s_barrier()
#define PG8_SCHED __builtin_amdgcn_sched_barrier(0)
    Unit cur, nxt; int ui = 0;
    if (!S.next(0, cur)) return;
    f32x4 acc[2][2][4][2];
#pragma unroll
    for (int a = 0; a < 2; ++a)
#pragma unroll
        for (int b = 0; b < 2; ++b)
#pragma unroll
            for (int m = 0; m < 4; ++m)
#pragma unroll
                for (int n = 0; n < 2; ++n) acc[a][b][m][n] = (f32x4){0.f, 0.f, 0.f, 0.f};
    bf16x8 At[4][2], B0[2][2], B1[2][2];
    const char* cA = (const char*)g.A + (size_t)cur.pm * tstep; const char* cB = (const char*)g.Bt + (size_t)cur.pn * tstep;
    S.a_ready(cur);
    if constexpr (SP2) {
        PG8_STAGE(PG8_SB(0, 0), cB, voffB); PG8_STAGE(PG8_SB(0, 1), cB + hstep, voffB); PG8_STAGE(PG8_SA(0, 0), cA, voffA); PG8_STAGE(PG8_SA(0, 1), cA + hstep, voffA);
        if (wr == 1) PG8_BAR;
        PG8_WAIT_V(2); PG8_BAR;
        PG8_STAGE(PG8_SB(1, 0), cB + kstep, voffB); PG8_STAGE(PG8_SA(1, 0), cA + kstep, voffA); PG8_STAGE(PG8_SB(1, 1), cB + hstep + kstep, voffB);
        PG8_WAIT_V(6); PG8_BAR;
    } else {
        PG8_STAGE(PG8_SB(0, 0), cB, voffB); PG8_STAGE(PG8_SA(0, 0), cA, voffA); PG8_STAGE(PG8_SB(0, 1), cB + hstep, voffB); PG8_STAGE(PG8_SA(0, 1), cA + hstep, voffA);
        if (wr == 1) PG8_BAR;
        PG8_WAIT_V(4); PG8_BAR;
        PG8_STAGE(PG8_SB(1, 0), cB + kstep, voffB); PG8_STAGE(PG8_SA(1, 0), cA + kstep, voffA); PG8_STAGE(PG8_SB(1, 1), cB + hstep + kstep, voffB);
        PG8_WAIT_V(6); PG8_BAR;
    }
    for (;;) {
        const bool has_next = S.next(ui + 1, nxt);
        const char* nA = has_next ? (const char*)g.A + (size_t)nxt.pm * tstep : cA; const char* nB = has_next ? (const char*)g.Bt + (size_t)nxt.pn * tstep : cB;
        for (int t = 0; t < nt; t += 2) {
            const bool last = (t == nt - 2);
            const char* a1 = cA + (size_t)(t + 1) * kstep;
            const char* a2 = last ? nA : cA + (size_t)(t + 2) * kstep; const char* b2 = last ? nB : cB + (size_t)(t + 2) * kstep;
            const char* a3 = a2 + kstep; const char* b3 = b2 + kstep;
            if (last && has_next) S.a_ready(nxt);
            if constexpr (SP2) {
            PG8_LDB(B0, 0, 0); PG8_LDB(B1, 0, 1); PG8_SCHED; PG8_LDA(At, 0, 0); PG8_STAGE(PG8_SA(1, 1), a1 + hstep, voffA);
            PG8_WAIT_V(8); PG8_WAIT_L(0); PG8_BAR; PG8_MMA(0, 0, At, B0); PG8_MMA(0, 1, At, B1); PG8_BAR; PG8_SCHED;
            PG8_LDA(At, 0, 1); PG8_STAGE(PG8_SB(0, 0), b2, voffB); PG8_STAGE(PG8_SB(0, 1), b2 + hstep, voffB); PG8_STAGE(PG8_SA(0, 0), a2, voffA);
            PG8_WAIT_V(8); PG8_WAIT_L(0); PG8_BAR; PG8_MMA(1, 0, At, B0); PG8_MMA(1, 1, At, B1); PG8_BAR; PG8_SCHED;
            PG8_LDB(B0, 1, 0); PG8_LDB(B1, 1, 1); PG8_SCHED; PG8_LDA(At, 1, 0); PG8_STAGE(PG8_SA(0, 1), a2 + hstep, voffA);
            PG8_WAIT_V(8); PG8_WAIT_L(0); PG8_BAR; PG8_MMA(0, 0, At, B0); PG8_MMA(0, 1, At, B1); PG8_BAR; PG8_SCHED;
            PG8_LDA(At, 1, 1); PG8_STAGE(PG8_SB(1, 0), b3, voffB); PG8_STAGE(PG8_SB(1, 1), b3 + hstep, voffB); PG8_STAGE(PG8_SA(1, 0), a3, voffA);
            PG8_WAIT_V(8); PG8_WAIT_L(0); PG8_BAR; PG8_MMA(1, 0, At, B0); PG8_MMA(1, 1, At, B1); PG8_BAR; PG8_SCHED;
            } else {
            PG8_LDB(B0, 0, 0); PG8_SCHED; PG8_LDA(At, 0, 0); PG8_STAGE(PG8_SA(1, 1), a1 + hstep, voffA);
            PG8_WAIT_L(8); PG8_BAR; PG8_WAIT_L(0); PG8_MMA(0, 0, At, B0); PG8_BAR; PG8_SCHED;
            PG8_LDB(B1, 0, 1); PG8_STAGE(PG8_SB(0, 0), b2, voffB);
            PG8_BAR; PG8_WAIT_L(0); PG8_MMA(0, 1, At, B1); PG8_BAR;
            PG8_LDA(At, 0, 1); PG8_STAGE(PG8_SA(0, 0), a2, voffA);
            PG8_BAR; PG8_WAIT_L(0); PG8_MMA(1, 0, At, B0); PG8_BAR; PG8_SCHED;
            PG8_STAGE(PG8_SB(0, 1), b2 + hstep, voffB);
            PG8_WAIT_V(6); PG8_BAR; PG8_MMA(1, 1, At, B1); PG8_BAR;
            PG8_LDB(B0, 1, 0); PG8_SCHED; PG8_LDA(At, 1, 0); PG8_STAGE(PG8_SA(0, 1), a2 + hstep, voffA);
            PG8_WAIT_L(8); PG8_BAR; PG8_WAIT_L(0); PG8_MMA(0, 0, At, B0); PG8_BAR; PG8_SCHED;
            PG8_LDB(B1, 1, 1); PG8_STAGE(PG8_SB(1, 0), b3, voffB);
            PG8_BAR; PG8_WAIT_L(0); PG8_MMA(0, 1, At, B1); PG8_BAR;
            PG8_LDA(At, 1, 1); PG8_STAGE(PG8_SA(1, 0), a3, voffA);
            PG8_BAR; PG8_WAIT_L(0); PG8_MMA(1, 0, At, B0); PG8_BAR; PG8_SCHED;
            PG8_STAGE(PG8_SB(1, 1), b3 + hstep, voffB);
            PG8_WAIT_V(6); PG8_BAR; PG8_MMA(1, 1, At, B1); PG8_BAR;
            }
        }
        if constexpr (ALIGN_EPI) { if (wr == 0) PG8_BAR; }
        if constexpr (!Epi::AFTER_DRAIN) { E(acc, cur, wr, wc, fr, fq); S.done(cur); }
        if (!has_next) break;
#pragma unroll
        for (int a = 0; a < 2; ++a)
#pragma unroll
            for (int b = 0; b < 2; ++b)
#pragma unroll
                for (int m = 0; m < 4; ++m)
#pragma unroll
                    for (int n = 0; n < 2; ++n) acc[a][b][m][n] = (f32x4){0.f, 0.f, 0.f, 0.f};
        cur = nxt; cA = nA; cB = nB; ++ui;
        if constexpr (ALIGN_EPI) { if (wr == 1) PG8_BAR; }
    }
    PG8_WAIT_V(0);
    if constexpr (!ALIGN_EPI) { if (wr == 0) PG8_BAR; }
    PG8_BAR;
    if constexpr (Epi::AFTER_DRAIN) { E.fused(acc, cur, wr, wc, fr, fq, lds, wid, lane); S.done(cur); }
#undef PG8_SA
#undef PG8_SB
#undef PG8_STAGE
#undef PG8_LDA
#undef PG8_LDB
#undef PG8_MMA
#undef PG8_WAIT_V
#undef PG8_WAIT_L
#undef PG8_BAR
#undef PG8_SCHED
}
}
namespace fa {
constexpr int D = 128; constexpr bool WSKIP = false; constexpr float THR = 8.f;
constexpr float SCALE = 0.08838834764831845f;
constexpr int NW = 8, QBLK = 32, KVBLK = 64, QB = NW * QBLK;
constexpr int SHM_V = KVBLK * D * 2, SHM_K = KVBLK * D * 2;
constexpr int LDS_BYTES = 2 * SHM_V + 2 * SHM_K + NW * 64 * 4;
constexpr int KB_OFF = LDS_BYTES;
constexpr int FA_LDS_BYTES = LDS_BYTES + 2 * 2048 * 4;
__device__ __forceinline__ void load_kbias(const float* CB, int P0, float* dst) {
    const float c0 = CB[P0]; const float inv = 1.0f / SCALE;
    for (int s = threadIdx.x; s < P0 + QB; s += 512) dst[s] = (c0 - CB[s]) * inv;
}
using bf16 = __hip_bfloat16;
typedef short bf16x8 __attribute__((ext_vector_type(8)));
typedef short s16x4 __attribute__((ext_vector_type(4)));
typedef float f32x16 __attribute__((ext_vector_type(16)));
typedef float f32x4 __attribute__((ext_vector_type(4)));
typedef unsigned u32x4 __attribute__((ext_vector_type(4)));
template <class A, class Bt> struct same_t { static constexpr bool v = false; };
template <class A> struct same_t<A, A> { static constexpr bool v = true; };

#define KSWZ(row, colB) ((row) * 256 + ((colB) ^ (((row) & 7) << 4)))
#define SBAR() __builtin_amdgcn_sched_barrier(0)
__device__ __forceinline__ int v_st(int k, int c) { const int kk = (k & ~0xC) | ((k & 4) << 1) | ((k & 8) >> 1); return ((kk >> 3) * 4 + (c >> 5)) * 512 + ((kk & 7) * 32 + (c & 31)) * 2; }
__device__ __forceinline__ int v_rd_base(int lane) { return ((lane & 3) << 3) | (((lane >> 2) & 3) << 6) | (((lane >> 4) & 1) << 5) | (((lane >> 5) & 1) << 8); }
constexpr int v_rd_off(int d0, int ks, int half) { return d0 * 512 + ks * 4096 + half * 2048; }
__device__ __forceinline__ int crow(int r, int hi) { return (r & 3) + 8 * (r >> 2) + 4 * hi; }
__device__ __forceinline__ unsigned cvtpk(float lo, float hi) {
    unsigned r; asm volatile("v_cvt_pk_bf16_f32 %0, %1, %2" : "=v"(r) : "v"(lo), "v"(hi)); return r;
}
__device__ __forceinline__ bf16x8 pack8(f32x4 a, f32x4 b) {
    u32x4 w = {cvtpk(a[0], a[1]), cvtpk(a[2], a[3]), cvtpk(b[0], b[1]), cvtpk(b[2], b[3])};
    return *reinterpret_cast<bf16x8*>(&w);
}
template <class T> __device__ __forceinline__ bf16x8 load8(const T* p) {
    if constexpr (same_t<T, float>::v) { return pack8(*(const f32x4*)p, *(const f32x4*)(p + 4)); }
    else { return *reinterpret_cast<const bf16x8*>(p); }
}
__device__ __forceinline__ void mask_tile(f32x16& p0, f32x16& p1, int dq, unsigned W) {
    const float NEG = -__builtin_inff();
#pragma unroll
    for (int r = 0; r < 16; ++r) {
        const int c = (r & 3) + 8 * (r >> 2);
        if ((unsigned)(dq - c) >= W) p0[r] = NEG;
        if ((unsigned)(dq - c - 32) >= W) p1[r] = NEG;
    }
}
__device__ __forceinline__ void partialSM(f32x16& p0, f32x16& p1, float& m_reg, float& mn, float& alpha) {
    float pmax = p0[0]; for (int r = 1; r < 16; ++r) pmax = fmaxf(pmax, p0[r]); for (int r = 0; r < 16; ++r) pmax = fmaxf(pmax, p1[r]);
    { auto rr = __builtin_amdgcn_permlane32_swap(__float_as_uint(pmax), __float_as_uint(pmax), false, false);
      pmax = fmaxf(__uint_as_float(rr[0]), __uint_as_float(rr[1])); }
    constexpr float C2 = 1.4426950408889634f * SCALE;
    if (__builtin_expect(__all((pmax - m_reg) * SCALE <= THR), 1)) { mn = m_reg; alpha = 1.f; }
    else { mn = fmaxf(m_reg, pmax); alpha = __builtin_amdgcn_exp2f((m_reg - mn) * C2); m_reg = mn; }
    const float mnL = -mn * C2;
    for (int r = 0; r < 16; ++r) p0[r] = fmaf(p0[r], C2, mnL); for (int r = 0; r < 16; ++r) p1[r] = fmaf(p1[r], C2, mnL);
    for (int r = 0; r < 16; ++r) p0[r] = __builtin_amdgcn_exp2f(p0[r]);
}
__device__ __forceinline__ void finishSM(f32x16& p0, f32x16& p1, float alpha, float& l_reg, bf16x8& pa0, bf16x8& pa1, bf16x8& pa2, bf16x8& pa3) {
    for (int r = 0; r < 16; ++r) p1[r] = __builtin_amdgcn_exp2f(p1[r]);
    float ps = 0; for (int r = 0; r < 16; ++r) ps += p0[r]; for (int r = 0; r < 16; ++r) ps += p1[r];
    { auto rr = __builtin_amdgcn_permlane32_swap(__float_as_uint(ps), __float_as_uint(ps), false, false);
      ps = __uint_as_float(rr[0]) + __uint_as_float(rr[1]); }
    l_reg = l_reg * alpha + ps;
#define PK4(P, B_, OUT) do { unsigned a0 = cvtpk(P[B_+0], P[B_+1]), a1 = cvtpk(P[B_+2], P[B_+3]);                          \
        unsigned b0 = cvtpk(P[B_+4], P[B_+5]), b1 = cvtpk(P[B_+6], P[B_+7]);                                             \
        auto r0 = __builtin_amdgcn_permlane32_swap(a0, b0, false, false); auto r1 = __builtin_amdgcn_permlane32_swap(a1, b1, false, false); \
        u32x4 w = {r0[0], r1[0], r0[1], r1[1]}; OUT = *reinterpret_cast<bf16x8*>(&w); } while (0)
    PK4(p0, 0, pa0); PK4(p0, 8, pa1); PK4(p1, 0, pa2); PK4(p1, 8, pa3);
#undef PK4
}
template <int KB, bool SK>
__device__ __forceinline__ void qkt(f32x16& p0, f32x16& p1, const char* K_lds, int r32, int hi, const bf16x8* qr, bool act, const float* kbp) {
    if (SK && !act) { const float NEG = -__builtin_inff();
#pragma unroll
        for (int r = 0; r < 16; ++r) { p0[r] = NEG; p1[r] = NEG; } return; }
    p0 = f32x16{}; p1 = f32x16{};
    const char* kb[4];
#pragma unroll
    for (int dd = 0; dd < 4; ++dd) kb[dd] = K_lds + KB * SHM_K + KSWZ(r32, (dd * 16 + hi * 8) * 2);
#pragma unroll
    for (int d0 = 0; d0 < 8; ++d0) { const char* a = kb[d0 & 3] + (d0 >> 2) * 128;
        bf16x8 b0 = *reinterpret_cast<const bf16x8*>(a);
        bf16x8 b1 = *reinterpret_cast<const bf16x8*>(a + 32 * 256);
        p0 = __builtin_amdgcn_mfma_f32_32x32x16_bf16(b0, qr[d0], p0, 0, 0, 0);
        p1 = __builtin_amdgcn_mfma_f32_32x32x16_bf16(b1, qr[d0], p1, 0, 0, 0); }
    {
        const float c0_ = hi ? 0.f : kbp[r32], c1_ = hi ? 0.f : kbp[32 + r32];
        const unsigned hp = cvtpk(c0_, c1_); const float r0_ = c0_ - __uint_as_float(hp << 16), r1_ = c1_ - __uint_as_float(hp & 0xffff0000u);
        const unsigned mp = cvtpk(r0_, r1_); const unsigned lp = cvtpk(r0_ - __uint_as_float(mp << 16), r1_ - __uint_as_float(mp & 0xffff0000u));
        u32x4 k0_ = {(hp & 0xffffu) | (mp << 16), lp & 0xffffu, 0u, 0u}, k1_ = {(hp >> 16) | (mp & 0xffff0000u), lp >> 16, 0u, 0u};
        const u32x4 q1_ = {0x3F803F80u, 0x00003F80u, 0u, 0u};
        p0 = __builtin_amdgcn_mfma_f32_32x32x16_bf16(*reinterpret_cast<bf16x8*>(&k0_), *reinterpret_cast<const bf16x8*>(&q1_), p0, 0, 0, 0);
        p1 = __builtin_amdgcn_mfma_f32_32x32x16_bf16(*reinterpret_cast<bf16x8*>(&k1_), *reinterpret_cast<const bf16x8*>(&q1_), p1, 0, 0, 0); }
}
template <int VB, bool SK>
__device__ __forceinline__ void pv_tile(f32x16* o, int vb0, bf16x8 pa0, bf16x8 pa1, bf16x8 pa2, bf16x8 pa3, bool act) {
    if (SK && !act) return;
#define TRRD(dst, off) asm volatile("ds_read_b64_tr_b16 %0, %1 offset:%2" : "=&v"(dst) : "v"(vb0), "i"(off) : "memory")
#define PV_D0(d0) do { s16x4 l0, l1, l2, l3, h0, h1, h2, h3; constexpr int b_ = VB * SHM_V + v_rd_off(d0, 0, 0);     \
        TRRD(l0, b_); TRRD(h0, b_ + 2048); TRRD(l1, b_ + 4096); TRRD(h1, b_ + 6144); TRRD(l2, b_ + 8192); TRRD(h2, b_ + 10240); TRRD(l3, b_ + 12288); TRRD(h3, b_ + 14336); \
        asm volatile("s_waitcnt lgkmcnt(0)" ::: "memory"); SBAR();                 \
        o[d0] = __builtin_amdgcn_mfma_f32_32x32x16_bf16(pa0, (bf16x8){l0[0], l0[1], l0[2], l0[3], h0[0], h0[1], h0[2], h0[3]}, o[d0], 0, 0, 0);   \
        o[d0] = __builtin_amdgcn_mfma_f32_32x32x16_bf16(pa1, (bf16x8){l1[0], l1[1], l1[2], l1[3], h1[0], h1[1], h1[2], h1[3]}, o[d0], 0, 0, 0);   \
        o[d0] = __builtin_amdgcn_mfma_f32_32x32x16_bf16(pa2, (bf16x8){l2[0], l2[1], l2[2], l2[3], h2[0], h2[1], h2[2], h2[3]}, o[d0], 0, 0, 0);   \
        o[d0] = __builtin_amdgcn_mfma_f32_32x32x16_bf16(pa3, (bf16x8){l3[0], l3[1], l3[2], l3[3], h3[0], h3[1], h3[2], h3[3]}, o[d0], 0, 0, 0); } while (0)
    PV_D0(0); PV_D0(1); PV_D0(2); PV_D0(3);
#undef PV_D0
#undef TRRD
}
template <class TIn, class TOut> struct BlockRef { const TIn* Q; const TIn* K; const TIn* V; TOut* O; const TOut* SG; const float* CB; int P0; };
template <class TIn> struct Seam {
    bf16x8 qr[8];
    bf16x8 st_v0, st_v1, st_k0, st_k1; f32x4 sf0, sf1, sf2, sf3;
    int kbsel;
};
__device__ __forceinline__ int swa_jlo(int P0, int W) { const int lowk = P0 - W + 1; return lowk > 0 ? lowk / KVBLK : 0; }
#define ROW(p, k0, rr) ((p) + (size_t)((k0) + (rr)) * D + sc)
#define VMW() asm volatile("s_waitcnt vmcnt(0)" ::: "memory")
#define VMWN(n) asm volatile("s_waitcnt vmcnt(%0)" :: "i"(n) : "memory")
#define ROWK(p, k0, rr) ((p) + (size_t)((k0) + (rr)) * KP + sc)
#define ROWV(p, k0, rr) ((p) + (size_t)((k0) + (rr)) * VP + sc)
#define SLOAD_H(Kp, Vp, k0) do { S.st_v0 = load8<TIn>(ROWV(Vp, k0, sr)); S.st_v1 = load8<TIn>(ROWV(Vp, k0, 32 + sr));              \
                         S.st_k0 = load8<TIn>(ROWK(Kp, k0, sr)); S.st_k1 = load8<TIn>(ROWK(Kp, k0, 32 + sr)); } while (0)
#define SWRITE_HK(bf) do { *(bf16x8*)(K_lds + (bf) * SHM_K + kws) = S.st_k0; *(bf16x8*)(K_lds + (bf) * SHM_K + kws + 32 * 256) = S.st_k1; } while (0)
#define SWRITE_HV(bf) do { *(bf16x8*)(V_lds + (bf) * SHM_V + vst0) = S.st_v0; *(bf16x8*)(V_lds + (bf) * SHM_V + vst1) = S.st_v1; } while (0)
#define SWRITE_H(bf) do { SWRITE_HV(bf); SWRITE_HK(bf); } while (0)
#define SLOAD_F(p, k0) do { S.sf0 = *(const f32x4*)ROW(p, k0, sr); S.sf1 = *(const f32x4*)(ROW(p, k0, sr) + 4);                \
                            S.sf2 = *(const f32x4*)ROW(p, k0, 32 + sr); S.sf3 = *(const f32x4*)(ROW(p, k0, 32 + sr) + 4); } while (0)
#define SWRITE_KF(bf) do { *(bf16x8*)(K_lds + (bf) * SHM_K + kws) = pack8(S.sf0, S.sf1); *(bf16x8*)(K_lds + (bf) * SHM_K + kws + 32 * 256) = pack8(S.sf2, S.sf3); } while (0)
#define SWRITE_VF(bf) do { *(bf16x8*)(V_lds + (bf) * SHM_V + vst0) = pack8(S.sf0, S.sf1); *(bf16x8*)(V_lds + (bf) * SHM_V + vst1) = pack8(S.sf2, S.sf3); } while (0)
template <class TIn, class TOut, int QP, int KP, int VP>
__device__ __forceinline__ void causal_swa_prime(const BlockRef<TIn, TOut>& cur, int W, char* lds, Seam<TIn>& S) {
    constexpr bool F32 = same_t<TIn, float>::v;
    int tid = threadIdx.x; asm volatile("" : "+v"(tid));
    const int wid = __builtin_amdgcn_readfirstlane(tid >> 6), lane = tid & 63, r32 = lane & 31, hi = lane >> 5;
    const int sr = tid >> 4, sc = (tid & 15) * 8, kws = KSWZ(sr, sc * 2); char* K_lds = lds + 2 * SHM_V;
    const int kb0 = swa_jlo(cur.P0, W) * KVBLK;
    for (int d0 = 0; d0 < 8; ++d0) S.qr[d0] = load8<TIn>(cur.Q + (size_t)(wid * QBLK + r32) * QP + d0 * 16 + hi * 8);
    if constexpr (F32) { SLOAD_F((const float*)cur.K, kb0); VMW(); SWRITE_KF(0); SBAR(); SLOAD_F((const float*)cur.V, kb0); }
    else { SLOAD_H(cur.K, cur.V, kb0); VMW(); SWRITE_HK(0); }
    load_kbias(cur.CB, cur.P0, (float*)(lds + KB_OFF)); S.kbsel = 0;
    __syncthreads();
}
template <class TIn, class TOut, int QP, int KP, int VP>
__device__ __forceinline__ void causal_swa_block(const BlockRef<TIn, TOut>& cur, const BlockRef<TIn, TOut>& nxt, int skv, int W, char* lds, Seam<TIn>& S) {
    constexpr bool F32 = same_t<TIn, float>::v;
    int tid = threadIdx.x; asm volatile("" : "+v"(tid));
    const int wid = __builtin_amdgcn_readfirstlane(tid >> 6), lane = tid & 63, r32 = lane & 31, hi = lane >> 5;
    const int j_lo = swa_jlo(cur.P0, W);
    int j_hi = (cur.P0 + QB - 1) / KVBLK + 1; if (j_hi > skv / KVBLK) j_hi = skv / KVBLK;
    const int NT = j_hi - j_lo;
    const int kbn = swa_jlo(nxt.P0, W) * KVBLK;
    const int qlo = cur.P0 + wid * QBLK, qm = qlo + r32 - 4 * hi;
    char* V_lds = lds; char* K_lds = lds + 2 * SHM_V; const float* kbl = (const float*)(lds + KB_OFF) + S.kbsel * 2048;
    float* ws = (float*)(lds + 2 * SHM_V + 2 * SHM_K) + wid * 64; float* li_l = ws, * al_l = ws + 32;
    float m_reg = -1e30f, l_reg = 0; f32x16 o[4] = {};
    const int sr = tid >> 4, sc = (tid & 15) * 8, vst0 = v_st(sr, sc), vst1 = v_st(32 + sr, sc), kws = KSWZ(sr, sc * 2);
    const int vb0 = (int)(uintptr_t)V_lds + v_rd_base(lane);
    const TIn* Kh = cur.K; const TIn* Vh = cur.V;
#define RESC(a) do { if (__any((a) < 1.f)) { if (hi == 0) al_l[r32] = (a); asm volatile("s_waitcnt lgkmcnt(0)" ::: "memory");              \
                     for (int d_ = 0; d_ < 4; ++d_) for (int r = 0; r < 16; ++r) o[d_][r] *= al_l[crow(r, hi)]; } } while (0)
#define KBASE(t) ((j_lo + (t)) * KVBLK)
#define KBP(t) (kbl + KBASE(t))
#define ACT(t) (KBASE(t) <= qlo + QBLK - 1 && KBASE(t) + KVBLK - 1 >= qlo - W + 1)
#define MASKT(P0_, P1_, t) do { const int kb_ = KBASE(t); if ((!SK || ACT(t)) && (kb_ + KVBLK - 1 > qlo || kb_ <= qlo + QBLK - 1 - W)) mask_tile(P0_, P1_, qm - kb_, (unsigned)W); } while (0)
    constexpr int NQL = F32 ? 16 : 8;
    constexpr bool SK = WSKIP && !F32;
#define SEAM_K0() do { VMWN(NQL); if constexpr (F32) { SWRITE_KF(0); SBAR(); SLOAD_F((const float*)nxt.V, kbn); } else { SWRITE_HK(0); } SBAR(); } while (0)
    f32x16 pA0, pA1, pB0, pB1; float mnA, mnB, alA, alB; bf16x8 pa0, pa1, pa2, pa3;
    if constexpr (F32) { VMW(); SWRITE_VF(0); SBAR(); } else { SWRITE_HV(0); SBAR(); }
    if (NT > 1) { if constexpr (F32) SLOAD_F((const float*)Kh, KBASE(1)); else SLOAD_H(Kh, Vh, KBASE(1)); }
    SBAR(); qkt<0, SK>(pA0, pA1, K_lds, r32, hi, S.qr, ACT(0), KBP(0));
    if constexpr (F32) { if (NT > 1) { VMW(); SWRITE_KF(1); SBAR(); SLOAD_F((const float*)Vh, KBASE(1)); } }
    MASKT(pA0, pA1, 0); partialSM(pA0, pA1, m_reg, mnA, alA);
    if (NT > 1) { VMW(); if constexpr (F32) { SWRITE_VF(1); SBAR(); if (NT > 2) SLOAD_F((const float*)Kh, KBASE(2)); } else SWRITE_H(1); }
    __syncthreads();
#define HALF_STEP(PX0, PX1, mnX, alX, PY0, PY1, alY, t, KB, VB, SB) do {                                                      \
        SBAR(); qkt<KB, SK>(PX0, PX1, K_lds, r32, hi, S.qr, ACT(t), KBP(t));                                             \
        finishSM(PY0, PY1, alY, l_reg, pa0, pa1, pa2, pa3); SBAR();                                                           \
        if ((t) + 1 < NT) { if constexpr (F32) { VMW(); SWRITE_KF(SB); SBAR(); SLOAD_F((const float*)Vh, KBASE((t) + 1)); }  \
                            else { SLOAD_H(Kh, Vh, KBASE((t) + 1)); } SBAR(); }                                               \
        pv_tile<VB, SK>(o, vb0, pa0, pa1, pa2, pa3, ACT((t) - 1)); MASKT(PX0, PX1, (t)); partialSM(PX0, PX1, m_reg, mnX, alX);                                        \
        __syncthreads();                                                                                                      \
        if ((t) + 1 < NT) { VMW(); if constexpr (F32) { SWRITE_VF(SB); SBAR(); if ((t) + 2 < NT) SLOAD_F((const float*)Kh, KBASE((t) + 2)); } \
                            else { SWRITE_H(SB); } }                                                                          \
        RESC(alX); __syncthreads(); } while (0)
    for (int t = 1; t + 1 < NT; t += 2) {
        HALF_STEP(pB0, pB1, mnB, alB, pA0, pA1, alA, t, 1, 0, 0);
        HALF_STEP(pA0, pA1, mnA, alA, pB0, pB1, alB, t + 1, 0, 1, 1);
    }
    const bool even = (NT & 1) == 0;
    if (even) { SBAR(); qkt<1, SK>(pB0, pB1, K_lds, r32, hi, S.qr, ACT(NT - 1), KBP(NT - 1)); SBAR(); }
#define QROW(e) (nxt.Q + (size_t)(wid * QBLK + r32) * D + ((e) >> 1) * 16 + hi * 8 + ((e) & 1) * 4)
    if constexpr (F32) { SLOAD_F((const float*)nxt.K, kbn); SBAR();
#pragma unroll
        for (int e = 0; e < 8; ++e) (void)0; }
    else { SLOAD_H(nxt.K, nxt.V, kbn); SBAR();
#pragma unroll
        for (int d0 = 0; d0 < 8; ++d0) S.qr[d0] = load8<TIn>(nxt.Q + (size_t)(wid * QBLK + r32) * QP + d0 * 16 + hi * 8); }
    SBAR();
    finishSM(pA0, pA1, alA, l_reg, pa0, pa1, pa2, pa3); SBAR();
    if constexpr (F32) {
#pragma unroll
        for (int e = 8; e < 16; ++e) (void)0; SBAR(); }
#undef QROW
    pv_tile<0, SK>(o, vb0, pa0, pa1, pa2, pa3, ACT(even ? NT - 2 : NT - 1));
    if (even) { MASKT(pB0, pB1, NT - 1); partialSM(pB0, pB1, m_reg, mnB, alB); __syncthreads(); RESC(alB);
        finishSM(pB0, pB1, alB, l_reg, pa0, pa1, pa2, pa3); SBAR(); pv_tile<1, SK>(o, vb0, pa0, pa1, pa2, pa3, ACT(NT - 1)); }
    SBAR(); SEAM_K0();
    if (hi == 0) li_l[r32] = l_reg; asm volatile("s_waitcnt lgkmcnt(0)" ::: "memory");
    float rli[16];
#pragma unroll
    for (int r = 0; r < 16; ++r) rli[r] = __builtin_amdgcn_rcpf(li_l[crow(r, hi)]);
    TOut* Ow = cur.O + (size_t)(wid * QBLK) * QP; const TOut* SGw = cur.SG + (size_t)(wid * QBLK) * VP;
#pragma unroll
    for (int r = 0; r < 16; ++r) { const int orow = crow(r, hi);
#pragma unroll
        for (int d0 = 0; d0 < 4; ++d0) { const float v = o[d0][r] * rli[r] * __bfloat162float(SGw[(size_t)orow * VP + d0 * 32 + r32]);
            if constexpr (same_t<TOut, float>::v) { Ow[(size_t)orow * QP + d0 * 32 + r32] = v; }
            else { const float vn = __shfl_xor(v, 1);
                   if ((r32 & 1) == 0) *(unsigned*)(Ow + (size_t)orow * QP + d0 * 32 + r32) = cvtpk(v, vn); } } }
    if constexpr (F32) {
#pragma unroll
        for (int d0 = 0; d0 < 8; ++d0) (void)0; }
    load_kbias(nxt.CB, nxt.P0, (float*)(lds + KB_OFF) + (S.kbsel ^ 1) * 2048);
    __syncthreads();
    S.kbsel ^= 1;
#undef RESC
#undef KBASE
#undef KBP
#undef ACT
#undef MASKT
#undef SEAM_K0
#undef HALF_STEP
}
#undef ROW
#undef VMW
#undef VMWN
#undef SLOAD_H
#undef SWRITE_HK
#undef SWRITE_HV
#undef SWRITE_H
#undef SLOAD_F
#undef SWRITE_KF
#undef SWRITE_VF

}
#define LAS __attribute__((address_space(3)))
typedef unsigned short bf16_t;
typedef float f32x4 __attribute__((ext_vector_type(4)));
typedef float f32x2 __attribute__((ext_vector_type(2)));
typedef unsigned u32x4 __attribute__((ext_vector_type(4)));
typedef unsigned u32x2 __attribute__((ext_vector_type(2)));
constexpr int DM = 2048, NB = 4, SEQ = 2048, MT = NB * SEQ;
constexpr int DFF = 5632, NMOD = 12288;
constexpr int NBF = 8192, NF32 = 3584, NPROJ = NBF + NF32;
constexpr int PBP = NBF + 64;
constexpr float ALPHA = 1.189207115002721f, LN_EPS = 1e-5f, RMS_EPS = 1e-6f, LNX_EPS = 64e-5f;
constexpr size_t MiB = 1u << 20;
constexpr size_t WS_MOD = 0, WS_CUM = 1 * MiB, WS_PART = 2 * MiB, WS_BAR = 5 * MiB;
constexpr size_t WS_WOUT = 8 * MiB, WS_WA = 16 * MiB, WS_WB = 20 * MiB, WS_WLORA = 24 * MiB;
constexpr size_t WS_WIN = 28 * MiB;
constexpr size_t WS_ACAT = 60 * MiB, WS_MERGED = 235 * MiB;
constexpr int KSP = PBP / 2;
constexpr size_t WS_XN = 74 * MiB;
constexpr size_t WS_QN = 74 * MiB, WS_KN = 90 * MiB;
constexpr size_t WS_PBF = 106 * MiB;
constexpr size_t WS_PF32 = 235 * MiB;
constexpr size_t WS_WD = 235 * MiB, WS_BB = 267 * MiB, WS_G = 299 * MiB, WS_YRAW = 315 * MiB, WS_WGU = 28 * MiB;
constexpr size_t WS_KK = 347 * MiB;
constexpr size_t WS_O = 379 * MiB;
constexpr size_t WS_WDOWN = 395 * MiB;
constexpr size_t WS_END = 417 * MiB;
constexpr int LDS_BYTES = 131072 + 64;

struct Params { const float* in[28]; float* out; unsigned char* ws; };

__device__ __forceinline__ unsigned f2bf(float f) { unsigned u = __builtin_bit_cast(unsigned, f); return (u + 0x7fffu + ((u >> 16) & 1u)) >> 16; }
__device__ __forceinline__ unsigned pk2(float lo, float hi) { return pg8::cvt_pk_bf16(lo, hi); }
__device__ __forceinline__ float bflo(unsigned w) { return __builtin_bit_cast(float, w << 16); }
__device__ __forceinline__ float bfhi(unsigned w) { return __builtin_bit_cast(float, w & 0xffff0000u); }
__device__ __forceinline__ float sigm(float x) { return __builtin_amdgcn_rcpf(1.f + __builtin_amdgcn_exp2f(-1.4426950408889634f * x)); }
__device__ __forceinline__ float wave_sum(float v) {
#pragma unroll
    for (int o = 1; o < 64; o <<= 1) v += __shfl_xor(v, o);
    return v;
}
template <int CTRL> __device__ __forceinline__ float dppf(float x) { return __builtin_bit_cast(float, __builtin_amdgcn_mov_dpp(__builtin_bit_cast(int, x), CTRL, 0xf, 0xf, true)); }
__device__ __forceinline__ float rowsum16(float v) { v += dppf<0xB1>(v); v += dppf<0x4E>(v); v += dppf<0x141>(v); v += dppf<0x128>(v); return v; }
#define LDS_WAIT() asm volatile("s_waitcnt lgkmcnt(0)" ::: "memory")

namespace pg8 {
__device__ __forceinline__ f32x4 sig4(f32x4 v) { f32x4 r; r[0] = sigm(v[0]); r[1] = sigm(v[1]); r[2] = sigm(v[2]); r[3] = sigm(v[3]); return r; }
__device__ __forceinline__ u32x4 pack8(f32x4 a, f32x4 b) { u32x4 w; w.x = cvt_pk_bf16(a[0], a[1]); w.y = cvt_pk_bf16(a[2], a[3]); w.z = cvt_pk_bf16(b[0], b[1]); w.w = cvt_pk_bf16(b[2], b[3]); return w; }
struct EpiProjBf { static constexpr bool PERM = true, AFTER_DRAIN = false; bf16_t* O;
    __device__ __forceinline__ void operator()(const f32x4 (&acc)[2][2][4][2], const Unit& u, int wr, int wc, int fr, int fq) const {
        const int row0 = u.pm * BM + wr * 64 + fr, col0 = u.pn * BM + wc * 32 + 8 * fq; const bool sg = u.pn >= 12;
#pragma unroll
        for (int ai = 0; ai < 2; ++ai)
#pragma unroll
            for (int m = 0; m < 4; ++m) { bf16_t* rowp = O + (size_t)(row0 + ai * HALF + m * 16) * PBP + col0;
#pragma unroll
                for (int bj = 0; bj < 2; ++bj) { f32x4 v0 = acc[ai][bj][m][0], v1 = acc[ai][bj][m][1];
                    if (sg) { v0 = sig4(v0); v1 = sig4(v1); }
                    *(u32x4*)(rowp + bj * HALF) = pack8(v0, v1); } }
    }
};
struct EpiF32 { static constexpr bool PERM = false, AFTER_DRAIN = false; float* O; int ldc;
    __device__ __forceinline__ void operator()(const f32x4 (&acc)[2][2][4][2], const Unit& u, int wr, int wc, int fr, int fq) const {
        const int row0 = u.pm * BM + wr * 64 + fr, col0 = u.pn * BM + wc * 32 + 4 * fq;
#pragma unroll
        for (int ai = 0; ai < 2; ++ai)
#pragma unroll
            for (int m = 0; m < 4; ++m) { float* rowp = O + (size_t)(row0 + ai * HALF + m * 16) * ldc + col0;
#pragma unroll
                for (int bj = 0; bj < 2; ++bj)
#pragma unroll
                    for (int n = 0; n < 2; ++n) *(f32x4*)(rowp + bj * HALF + n * 16) = acc[ai][bj][m][n]; }
    }
};
struct EpiLora { static constexpr bool PERM = false, AFTER_DRAIN = false;
    const float* w0; const float* a0; const float* k_a; float* WD; float* BB; float* KS; const float* KK; bf16_t* G;
    __device__ __forceinline__ void operator()(const f32x4 (&acc)[2][2][4][2], const Unit& u, int wr, int wc, int fr, int fq) const {
        const int row0 = u.pm * BM + wr * 64 + fr, sel = u.pn >> 2, cb = (u.pn & 3) * BM + wc * 32 + 4 * fq;
#pragma unroll
        for (int bj = 0; bj < 2; ++bj)
#pragma unroll
            for (int n = 0; n < 2; ++n) { const int c = cb + bj * HALF + n * 16;
                if (sel == 0) { const f32x4 wv = *(const f32x4*)(w0 + c);
#pragma unroll
                    for (int ai = 0; ai < 2; ++ai)
#pragma unroll
                        for (int m = 0; m < 4; ++m) { const size_t off = (size_t)(row0 + ai * HALF + m * 16) * 1024 + c; f32x4 o;
#pragma unroll
                            for (int i = 0; i < 4; ++i) { const float x = wv[i] + acc[ai][bj][m][n][i];
                                const float wraw = fminf(x, 0.f) - __logf(1.f + __expf(-fabsf(x))) - 0.5f; o[i] = __expf(-__expf(wraw)); }
                            *(f32x4*)(WD + off) = o; }
                } else if (sel == 1) { const f32x4 av = *(const f32x4*)(a0 + c), kav = *(const f32x4*)(k_a + c);
#pragma unroll
                    for (int ai = 0; ai < 2; ++ai)
#pragma unroll
                        for (int m = 0; m < 4; ++m) { const size_t off = (size_t)(row0 + ai * HALF + m * 16) * 1024 + c;
                            const size_t offk = (size_t)(row0 + ai * HALF + m * 16) * KSP + c; const f32x4 kk = *(const f32x4*)(KK + off), ks = *(const f32x4*)(KS + offk); f32x4 ob, ok;
#pragma unroll
                            for (int i = 0; i < 4; ++i) { const float a = sigm(av[i] + acc[ai][bj][m][n][i]); ob[i] = kk[i] * a; ok[i] = ks[i] * (1.f + (a - 1.f) * kav[i]); }
                            *(f32x4*)(BB + off) = ob; *(f32x4*)(KS + offk) = ok; }
                } else {
#pragma unroll
                    for (int ai = 0; ai < 2; ++ai)
#pragma unroll
                        for (int m = 0; m < 4; ++m) { const size_t off = (size_t)(row0 + ai * HALF + m * 16) * 1024 + c; const f32x4 v = acc[ai][bj][m][n];
                            u32x2 w; w.x = cvt_pk_bf16(v[0], v[1]); w.y = cvt_pk_bf16(v[2], v[3]); *(u32x2*)(G + off) = w; }
                } }
    }
};
template <int PASS> struct EpiMerge { static constexpr bool PERM = true, AFTER_DRAIN = false; const bf16_t* SG; float* TMP; bf16_t* MG;
    __device__ __forceinline__ void operator()(const f32x4 (&acc)[2][2][4][2], const Unit& u, int wr, int wc, int fr, int fq) const {
        const int row0 = u.pm * BM + wr * 64 + fr, col0 = u.pn * BM + wc * 32 + 8 * fq;
#pragma unroll
        for (int ai = 0; ai < 2; ++ai)
#pragma unroll
            for (int m = 0; m < 4; ++m) { const int row = row0 + ai * HALF + m * 16;
#pragma unroll
                for (int bj = 0; bj < 2; ++bj) { const int c = col0 + bj * HALF; const u32x4 s = *(const u32x4*)(SG + (size_t)row * PBP + c);
                    f32x4 v0 = acc[ai][bj][m][0], v1 = acc[ai][bj][m][1];
                    v0 = v0 * (f32x4){bflo(s.x), bfhi(s.x), bflo(s.y), bfhi(s.y)}; v1 = v1 * (f32x4){bflo(s.z), bfhi(s.z), bflo(s.w), bfhi(s.w)};
                    float* tp = TMP + (size_t)row * DM + c;
                    if (PASS == 1) { *(f32x4*)tp = v0; *(f32x4*)(tp + 4) = v1; }
                    else { v0 = v0 + *(const f32x4*)tp; v1 = v1 + *(const f32x4*)(tp + 4); *(u32x4*)(MG + (size_t)row * DM + c) = pack8(v0, v1); } } }
    }
};
struct EpiRes { static constexpr bool PERM = false, AFTER_DRAIN = false; const float* X; float* OUT; const float* gate;
    __device__ __forceinline__ void operator()(const f32x4 (&acc)[2][2][4][2], const Unit& u, int wr, int wc, int fr, int fq) const {
        const int row0 = u.pm * BM + wr * 64 + fr, col0 = u.pn * BM + wc * 32 + 4 * fq; const float* gp = gate + (size_t)(u.pm >> 3) * NMOD;
#pragma unroll
        for (int bj = 0; bj < 2; ++bj)
#pragma unroll
            for (int n = 0; n < 2; ++n) { const int c = col0 + bj * HALF + n * 16; const f32x4 gv = *(const f32x4*)(gp + c);
#pragma unroll
                for (int ai = 0; ai < 2; ++ai)
#pragma unroll
                    for (int m = 0; m < 4; ++m) { const size_t off = (size_t)(row0 + ai * HALF + m * 16) * DM + c;
                        const f32x4 xv = *(const f32x4*)(X + off); *(f32x4*)(OUT + off) = xv * ALPHA + gv * acc[ai][bj][m][n]; } }
    }
};
struct EpiSwiGLU { static constexpr bool PERM = true, AFTER_DRAIN = false; bf16_t* ACT;
    __device__ __forceinline__ void operator()(const f32x4 (&acc)[2][2][4][2], const Unit& u, int wr, int wc, int fr, int fq) const {
        const int row0 = u.pm * BM + wr * 64 + fr, col0 = u.pn * HALF + wc * 32 + 8 * fq;
#pragma unroll
        for (int ai = 0; ai < 2; ++ai)
#pragma unroll
            for (int m = 0; m < 4; ++m) { const f32x4 g0 = acc[ai][0][m][0], g1 = acc[ai][0][m][1], u0 = acc[ai][1][m][0], u1 = acc[ai][1][m][1];
                const f32x4 a0 = g0 * sig4(g0) * u0, a1 = g1 * sig4(g1) * u1;
                *(u32x4*)(ACT + (size_t)(row0 + ai * HALF + m * 16) * DFF + col0) = pack8(a0, a1); }
    }
};
}
__device__ __forceinline__ int q_pop(unsigned* ctr, int lane) { unsigned v = 0u; if (lane == 0) v = __hip_atomic_fetch_add(ctr, 1u, __ATOMIC_RELAXED, __HIP_MEMORY_SCOPE_AGENT); return (int)__builtin_amdgcn_readfirstlane(v); }
struct MapId { __device__ __forceinline__ int operator()(int n) const { return n; } };
struct MapWin { __device__ __forceinline__ int operator()(int n) const {
    return n < 4096 ? n : n < 8192 ? 7624 + (n - 4096) : n < 11712 ? 4104 + (n - 8192) : n < 11720 ? 4096 + (n - 11712) : -1; } };
struct MapGu { __device__ __forceinline__ int operator()(int n) const { const int pn = n >> 8, j = n & 255; return j < 128 ? 128 * pn + j : DFF + 128 * pn + (j - 128); } };
template <class Map>
__device__ __forceinline__ void transpose_item(const float* W, int ldw, bf16_t* WT, int Kd, int kb, int nb, LAS float* scr, int lane, Map map) {
    const int k0 = 64 * kb, n0 = 32 * nb; const int src = map(n0 + (lane & 31));
    const float* wp = W + (size_t)(k0 + (lane >> 5)) * ldw + (src >= 0 ? src : 0);
    float tv[32];
#pragma unroll
    for (int i = 0; i < 32; ++i) tv[i] = src >= 0 ? __builtin_nontemporal_load(wp + (size_t)(2 * i) * ldw) : 0.f;
#pragma unroll
    for (int i = 0; i < 32; ++i) scr[(2 * i + (lane >> 5)) * 33 + (lane & 31)] = tv[i];
    LDS_WAIT();
    const int c = lane & 7;
#pragma unroll
    for (int j = 0; j < 4; ++j) { const int n = (lane >> 3) + 8 * j; const LAS float* s = scr + (8 * c) * 33 + n;
        u32x4 o; o.x = pk2(s[0 * 33], s[1 * 33]); o.y = pk2(s[2 * 33], s[3 * 33]); o.z = pk2(s[4 * 33], s[5 * 33]); o.w = pk2(s[6 * 33], s[7 * 33]);
        *(u32x4*)(WT + (size_t)(n0 + n) * Kd + k0 + 8 * c) = o; }
    LDS_WAIT();
}
__device__ __forceinline__ void ln_stats(const f32x4 (&v)[8], float& mean, float& rstd) {
    float s = 0.f;
#pragma unroll
    for (int j = 0; j < 8; ++j) s += (v[j][0] + v[j][1]) + (v[j][2] + v[j][3]);
    mean = wave_sum(s) * (1.f / DM); float q = 0.f;
#pragma unroll
    for (int j = 0; j < 8; ++j) { const f32x4 d = v[j] - mean; q += (d[0] * d[0] + d[1] * d[1]) + (d[2] * d[2] + d[3] * d[3]); }
    rstd = 1.f / sqrtf(wave_sum(q) * (1.f / DM) + LN_EPS);
}

__device__ __forceinline__ void prep_row(const Params& p, int t, int lane) {
    unsigned char* ws = p.ws;
    const bf16_t* PBF = (const bf16_t*)(ws + WS_PBF) + (size_t)t * PBP;
    bf16_t* QN = (bf16_t*)(ws + WS_QN) + (size_t)t * 1024; bf16_t* KN = (bf16_t*)(ws + WS_KN) + (size_t)t * 1024;
    u32x4 qk4[4];
#pragma unroll
    for (int ps = 0; ps < 4; ++ps) qk4[ps] = *(const u32x4*)(PBF + (ps >> 1) * 1024 + (ps & 1) * 512 + lane * 8);
#pragma unroll
    for (int ps = 0; ps < 4; ++ps) {
        const int isk = ps >> 1, c = (ps & 1) * 512 + lane * 8;
        const u32x4 w = qk4[ps];
        float x[8] = {bflo(w.x), bfhi(w.x), bflo(w.y), bfhi(w.y), bflo(w.z), bfhi(w.z), bflo(w.w), bfhi(w.w)};
        float ss = 0.f;
#pragma unroll
        for (int i = 0; i < 8; ++i) ss += x[i] * x[i];
        ss = rowsum16(ss);
        const float rs = 1.f / sqrtf(ss * (1.f / 128.f) + RMS_EPS);
        const float* gp = (isk ? p.in[7] : p.in[6]) + (c & 127);
        const f32x4 g0 = *(const f32x4*)gp, g1 = *(const f32x4*)(gp + 4);
        u32x4 o; o.x = pk2(x[0] * rs * g0[0], x[1] * rs * g0[1]); o.y = pk2(x[2] * rs * g0[2], x[3] * rs * g0[3]);
        o.z = pk2(x[4] * rs * g1[0], x[5] * rs * g1[1]); o.w = pk2(x[6] * rs * g1[2], x[7] * rs * g1[3]);
        *(u32x4*)((isk ? KN : QN) + c) = o;
    }
    const float* cur = (const float*)(ws + WS_PF32) + (size_t)t * NF32; const float* prv = cur - NF32;
    const bool first = (t & (SEQ - 1)) == 0; const float* mu = p.in[8];
    float* R = p.out + (size_t)t * 1024; float* V32 = p.out + (size_t)MT * 1024 + (size_t)t * 1024;
    float* KS = (float*)(ws + WS_PBF) + (size_t)t * KSP; float* KK = (float*)(ws + WS_KK) + (size_t)t * 1024;
    asm volatile("" ::: "memory");
#define SHIFTED(col) ({ const f32x4 c_ = *(const f32x4*)(cur + (col)); const f32x4 p_ = first ? (f32x4){0.f, 0.f, 0.f, 0.f} : *(const f32x4*)(prv + (col)); const f32x4 m_ = *(const f32x4*)(mu + (col)); c_ + (p_ - c_) * m_; })
#pragma unroll
    for (int pp = 0; pp < 2; ++pp) {
        f32x4 cu[2][3], pr[2][3], mm[2][3], kkw[2];
#pragma unroll
        for (int q = 0; q < 2; ++q) { const int c = (2 * pp + q) * 256 + lane * 4;
#pragma unroll
            for (int s_ = 0; s_ < 3; ++s_) { cu[q][s_] = *(const f32x4*)(cur + s_ * 1024 + c); pr[q][s_] = first ? (f32x4){0.f, 0.f, 0.f, 0.f} : *(const f32x4*)(prv + s_ * 1024 + c); mm[q][s_] = *(const f32x4*)(mu + s_ * 1024 + c); }
            kkw[q] = *(const f32x4*)(p.in[14] + c); }
#pragma unroll
        for (int q = 0; q < 2; ++q) { const int c = (2 * pp + q) * 256 + lane * 4;
            *(f32x4*)(R + c) = cu[q][0] + (pr[q][0] - cu[q][0]) * mm[q][0];
            *(f32x4*)(V32 + c) = cu[q][2] + (pr[q][2] - cu[q][2]) * mm[q][2];
            const f32x4 ks = cu[q][1] + (pr[q][1] - cu[q][1]) * mm[q][1]; *(f32x4*)(KS + c) = ks;
            const f32x4 kv = ks * kkw[q];
            const float nn = rowsum16((kv[0] * kv[0] + kv[1] * kv[1]) + (kv[2] * kv[2] + kv[3] * kv[3]));
            const float inv = 1.f / fmaxf(sqrtf(nn), 1e-12f);
            *(f32x4*)(KK + c) = kv * inv; }
    }
    bf16_t* AC = (bf16_t*)(ws + WS_ACAT) + (size_t)t * 512;
    if (lane < 32) {
        f32x4 a = {0.f, 0.f, 0.f, 0.f}, b = {0.f, 0.f, 0.f, 0.f};
        if (lane < 24) { const f32x4 xw = SHIFTED(3072 + lane * 4); b = SHIFTED(3168 + lane * 4);
#pragma unroll
            for (int i = 0; i < 4; ++i) { const float e = __expf(-2.f * fabsf(xw[i])); const float th = (1.f - e) / (1.f + e); a[i] = xw[i] < 0.f ? -th : th; } }
        u32x2 wa, wb; wa.x = pk2(a[0], a[1]); wa.y = pk2(a[2], a[3]); wb.x = pk2(b[0], b[1]); wb.y = pk2(b[2], b[3]);
        *(u32x2*)(AC + lane * 4) = wa; *(u32x2*)(AC + 128 + lane * 4) = wb; }
    { const f32x4 xg = SHIFTED(3264 + lane * 4); u32x2 w; w.x = pk2(sigm(xg[0]), sigm(xg[1])); w.y = pk2(sigm(xg[2]), sigm(xg[3])); *(u32x2*)(AC + 256 + lane * 4) = w; }
#undef SHIFTED
}

__device__ __forceinline__ void rwkv_job(LAS unsigned char* lds, int job, const float* KK, const float* WD, const float* BB, const float* KS, const float* R, const float* V32, float* Y, int tid, int wave, int lane) {
    const int bh = job >> 1, half = job & 1, b = bh >> 4, h = bh & 15;
    const size_t tok0 = (size_t)b * SEQ;
    constexpr int TC = 32, CHF = TC * 384, NCH = SEQ / TC;
    LAS float* buf = (LAS float*)lds;
    const int lt = tid & 255, lrow = lt >> 4, piece = lt & 15;
    const size_t goff = (tok0 + lrow) * 1024 + h * 64 + piece * 4;
    const size_t goffk = (tok0 + lrow) * KSP + h * 64 + piece * 4;
    f32x4 rg[12];
#define RW_LOAD(c) do { const size_t o_ = goff + (size_t)(c) * TC * 1024, ok_ = goffk + (size_t)(c) * TC * KSP; \
        rg[0] = *(const f32x4*)(KK + o_); rg[1] = *(const f32x4*)(KK + o_ + 16 * 1024); rg[2] = *(const f32x4*)(WD + o_); rg[3] = *(const f32x4*)(WD + o_ + 16 * 1024); \
        rg[4] = *(const f32x4*)(BB + o_); rg[5] = *(const f32x4*)(BB + o_ + 16 * 1024); rg[6] = *(const f32x4*)(KS + ok_); rg[7] = *(const f32x4*)(KS + ok_ + 16 * KSP); \
        rg[8] = *(const f32x4*)(R + o_); rg[9] = *(const f32x4*)(R + o_ + 16 * 1024); rg[10] = *(const f32x4*)(V32 + o_); rg[11] = *(const f32x4*)(V32 + o_ + 16 * 1024); } while (0)
#define RW_WRITE(c) do { LAS float* d_ = buf + ((c) & 1) * CHF + lrow * 384 + piece * 4; \
        _Pragma("unroll") for (int s_ = 0; s_ < 6; ++s_) { *(LAS f32x4*)(d_ + s_ * 64) = rg[2 * s_]; *(LAS f32x4*)(d_ + 16 * 384 + s_ * 64) = rg[2 * s_ + 1]; } } while (0)
    if (wave >= 4) { RW_LOAD(0); RW_WRITE(0); RW_LOAD(1); }
    __syncthreads();
    const int rw = lane >> 3, j = lane & 7, rl = wave * 8 + rw;
    f32x2 S[4] = {{0.f, 0.f}, {0.f, 0.f}, {0.f, 0.f}, {0.f, 0.f}};
#define RW_STEP(dst, dv, st_) do { const LAS float* sp_ = cb + (st_) * 384; \
        _Pragma("unroll") for (int s_ = 0; s_ < 5; ++s_) { dst[2 * s_] = *(const LAS f32x4*)(sp_ + s_ * 64); dst[2 * s_ + 1] = *(const LAS f32x4*)(sp_ + s_ * 64 + 4); } \
        dv = vb[(st_) * 384]; } while (0)
    for (int c = 0; c < NCH; ++c) {
        if (wave >= 4) { if (c + 1 < NCH) { RW_WRITE(c + 1); if (c + 2 < NCH) RW_LOAD(c + 2); } }
        else {
            const LAS float* cb = buf + (c & 1) * CHF + 8 * j;
            const LAS float* vb = buf + (c & 1) * CHF + 320 + half * 32 + rl;
            float* yp = Y + (tok0 + (size_t)c * TC) * 1024 + h * 64 + half * 32 + rl;
            f32x4 q[10]; float vv;
            RW_STEP(q, vv, 0);
#pragma unroll 4
            for (int st = 0; st < TC; ++st) {
                f32x4 n[10]; float nv; const int ns = st + 1 < TC ? st + 1 : st;
                RW_STEP(n, nv, ns);
                f32x2 ta = S[0] * q[0].lo, tb = S[1] * q[0].hi; ta = S[2] * q[1].lo + ta; tb = S[3] * q[1].hi + tb; ta = ta + tb;
                float d = ta[0] + ta[1];
                d += dppf<0xB1>(d); d += dppf<0x4E>(d); d += dppf<0x141>(d);
                S[0] = S[0] * q[2].lo - q[4].lo * d + q[6].lo * vv;
                S[1] = S[1] * q[2].hi - q[4].hi * d + q[6].hi * vv;
                S[2] = S[2] * q[3].lo - q[5].lo * d + q[7].lo * vv;
                S[3] = S[3] * q[3].hi - q[5].hi * d + q[7].hi * vv;
                f32x2 ua = S[0] * q[8].lo, ub = S[1] * q[8].hi; ua = S[2] * q[9].lo + ua; ub = S[3] * q[9].hi + ub; ua = ua + ub;
                float y = ua[0] + ua[1];
                y += dppf<0xB1>(y); y += dppf<0x4E>(y); y += dppf<0x141>(y);
                yp[(size_t)st * 1024] = y;
#pragma unroll
                for (int i = 0; i < 10; ++i) q[i] = n[i];
                vv = nv;
            }
        }
        __syncthreads();
    }
#undef RW_STEP
#undef RW_LOAD
#undef RW_WRITE
}

__device__ __forceinline__ void post_row(const Params& p, int t, int lane) {
    unsigned char* ws = p.ws;
    const float* Y = (const float*)(ws + WS_YRAW) + (size_t)t * 1024; const float* R = p.out + (size_t)t * 1024; const float* V32 = p.out + (size_t)MT * 1024 + (size_t)t * 1024;
    const float* KS = (const float*)(ws + WS_PBF) + (size_t)t * KSP; const bf16_t* G = (const bf16_t*)(ws + WS_G) + (size_t)t * 1024;
    bf16_t* YB = (bf16_t*)(ws + WS_KN) + (size_t)t * 1024;
#pragma unroll
    for (int pp = 0; pp < 2; ++pp) {
        f32x4 y_[2], r_[2], k_[2], v_[2], rk_[2], lg_[2], lb_[2]; u32x2 g_[2];
#pragma unroll
        for (int q = 0; q < 2; ++q) { const int c = (2 * pp + q) * 256 + lane * 4;
            y_[q] = *(const f32x4*)(Y + c); r_[q] = *(const f32x4*)(R + c); k_[q] = *(const f32x4*)(KS + c); v_[q] = *(const f32x4*)(V32 + c);
            rk_[q] = *(const f32x4*)(p.in[16] + c); lg_[q] = *(const f32x4*)(p.in[17] + c); lb_[q] = *(const f32x4*)(p.in[18] + c); g_[q] = *(const u32x2*)(G + c); }
#pragma unroll
        for (int q = 0; q < 2; ++q) { const int c = (2 * pp + q) * 256 + lane * 4;
            const f32x4 y = y_[q];
            const float mean = rowsum16((y[0] + y[1]) + (y[2] + y[3])) * (1.f / 64.f);
            const f32x4 d = y - mean;
            const float var = rowsum16((d[0] * d[0] + d[1] * d[1]) + (d[2] * d[2] + d[3] * d[3])) * (1.f / 64.f);
            const float rs = 1.f / sqrtf(var + LNX_EPS);
            const f32x4 yn = d * rs * lg_[q] + lb_[q];
            const f32x4 pr = r_[q] * k_[q] * rk_[q];
            const float bs = rowsum16((pr[0] + pr[1]) + (pr[2] + pr[3]));
            const u32x2 gw = g_[q];
            const f32x4 o = (yn + v_[q] * bs) * (f32x4){bflo(gw.x), bfhi(gw.x), bflo(gw.y), bfhi(gw.y)};
            u32x2 w; w.x = pk2(o[0], o[1]); w.y = pk2(o[2], o[3]); *(u32x2*)(YB + c) = w; }
    }
}

__device__ __forceinline__ void og_row(const Params& p, int t, int lane) {
    unsigned char* ws = p.ws;
    bf16_t* O = (bf16_t*)(ws + WS_O) + (size_t)t * 1024; const bf16_t* SG = (const bf16_t*)(ws + WS_PBF) + (size_t)t * PBP + 3072;
    u32x4 o8[2], s8[2];
#pragma unroll
    for (int ps = 0; ps < 2; ++ps) { o8[ps] = *(const u32x4*)(O + ps * 512 + lane * 8); s8[ps] = *(const u32x4*)(SG + ps * 512 + lane * 8); }
#pragma unroll
    for (int ps = 0; ps < 2; ++ps) { const int c = ps * 512 + lane * 8;
        const u32x4 o = o8[ps], s = s8[ps]; u32x4 w;
        w.x = pk2(bflo(o.x) * bflo(s.x), bfhi(o.x) * bfhi(s.x)); w.y = pk2(bflo(o.y) * bflo(s.y), bfhi(o.y) * bfhi(s.y));
        w.z = pk2(bflo(o.z) * bflo(s.z), bfhi(o.z) * bfhi(s.z)); w.w = pk2(bflo(o.w) * bflo(s.w), bfhi(o.w) * bfhi(s.w));
        *(u32x4*)(O + c) = w; }
}

typedef __hip_bfloat16 fabt;
__device__ __forceinline__ fa::BlockRef<fabt, fabt> fa_ref(int L, int pass, const fabt* Qn, const fabt* Kn, const fabt* Vb, fabt* O, const float* CUM) {
    const int bh = (L & 127) >> 2, x = L & 3, qb = pass ? 7 - x : x, b = bh >> 3, h = bh & 7; const size_t row0 = (size_t)b * SEQ;
    fa::BlockRef<fabt, fabt> r;
    r.Q = Qn + (row0 + (size_t)qb * 256) * 1024 + h * 128; r.O = O + (row0 + (size_t)qb * 256) * 1024 + h * 128;
    r.K = Kn + row0 * 1024 + h * 128; r.V = Vb + row0 * PBP + h * 128; r.SG = Vb + (row0 + (size_t)qb * 256) * PBP + 1024 + h * 128; r.CB = CUM + bh * SEQ; r.P0 = qb * 256;
    return r;
}
#define RLX_AGENT __ATOMIC_RELAXED, __HIP_MEMORY_SCOPE_AGENT
#define XB_TMO      128
#define XB_XCNT(j)  (256  + 64 * (j))
#define XB_XSUB(j)  (1280 + 64 * (j))
#define XB_XGEN(j)  (2304 + 64 * (j))
#define XB_TOP      3328
#define XB_TOPGEN   3392
#define XCD_BAR_WORDS 3456
#define XB_SPIN_CAP (1u << 18)

__device__ __forceinline__ unsigned xb_ld(unsigned* p)              { return __hip_atomic_load(p, __ATOMIC_RELAXED, __HIP_MEMORY_SCOPE_AGENT); }
__device__ __forceinline__ unsigned xb_add(unsigned* p, unsigned v) { return __hip_atomic_fetch_add(p, v, __ATOMIC_RELAXED, __HIP_MEMORY_SCOPE_AGENT); }
__device__ __forceinline__ unsigned xb_xcc_id() { return (unsigned)__builtin_amdgcn_s_getreg((3 << 11) | 20) & 0xFu; }
#define XB_SPIN(cond, bar) do { unsigned _sp = 0; while (cond) { __builtin_amdgcn_s_sleep(1); \
    if ((++_sp & 255u) == 0u) { if (xb_ld(&(bar)[XB_TMO])) break; if (_sp > XB_SPIN_CAP) { atomicAdd(&(bar)[XB_TMO], 1u); break; } } } } while (0)

struct XcdBarrier {
    unsigned* bar; unsigned x;
    volatile LAS unsigned* st;
};

__device__ __forceinline__ XcdBarrier xcd_barrier_post(unsigned* bar, volatile LAS unsigned* st) {
    XcdBarrier b; b.bar = bar; b.x = xb_xcc_id(); b.st = st;
    if (threadIdx.x == 0) (void)xb_add(&bar[XB_XCNT(b.x)], 1u);
    return b;
}
__device__ __forceinline__ void xcd_barrier_complete(unsigned* bar, unsigned x, unsigned& nloc, unsigned& nx) {
    const unsigned G = gridDim.x * gridDim.y * gridDim.z;
    unsigned sum, cnt, mine, sp = 0u;
    for (;;) {
        sum = 0u; cnt = 0u; mine = 0u;
#pragma unroll
        for (unsigned j = 0; j < 16; ++j) { const unsigned c = xb_ld(&bar[XB_XCNT(j)]); sum += c; cnt += (c > 0u) ? 1u : 0u; mine = (j == x) ? c : mine; }
        if (sum == G) break;
        __builtin_amdgcn_s_sleep(1);
        if ((++sp & 255u) == 0u) { if (xb_ld(&bar[XB_TMO])) break; if (sp > XB_SPIN_CAP) { atomicAdd(&bar[XB_TMO], 1u); break; } }
    }
    nloc = mine > 0u ? mine : 1u; nx = cnt > 0u ? cnt : 1u;
}

__device__ __forceinline__ void xcd_barrier(const XcdBarrier& b) {
    asm volatile("s_waitcnt vmcnt(0)" ::: "memory");
    __syncthreads();
    if (threadIdx.x == 0) {
        unsigned* bar = b.bar;
        __builtin_amdgcn_s_waitcnt(0);
        unsigned nloc = b.st[0], nx = b.st[1];
        if (nloc == 0u) { xcd_barrier_complete(bar, b.x, nloc, nx); b.st[0] = nloc; b.st[1] = nx; }
        const unsigned old = xb_add(&bar[XB_XSUB(b.x)], 1u);
        const unsigned gen = old / nloc;
        if (old + 1u == (gen + 1u) * nloc) {
            __builtin_amdgcn_fence(__ATOMIC_RELEASE, "agent");
            asm volatile("s_waitcnt vmcnt(0)" ::: "memory");
            const unsigned og = xb_add(&bar[XB_TOP], 1u);
            const unsigned tg = og / nx;
            if (og + 1u == (tg + 1u) * nx) xb_add(&bar[XB_TOPGEN], 1u);
            else XB_SPIN(xb_ld(&bar[XB_TOPGEN]) == tg, bar);
            __builtin_amdgcn_fence(__ATOMIC_ACQUIRE, "agent");
            xb_add(&bar[XB_XGEN(b.x)], 1u);
            asm volatile("s_waitcnt vmcnt(0)" ::: "memory");
        } else {
            XB_SPIN(xb_ld(&bar[XB_XGEN(b.x)]) == gen, bar);
            __builtin_amdgcn_fence(__ATOMIC_ACQUIRE, "agent");
            asm volatile("s_waitcnt vmcnt(0)" ::: "memory");
        }
    }
    __syncthreads();
}
#ifndef REP_P0
#define REP_P0 1
#endif
#ifndef REP_P3
#define REP_P3 1
#endif
#ifndef REP_REC
#define REP_REC 1
#endif
#ifndef REP_P10
#define REP_P10 1
#endif
#ifndef REP_P2
#define REP_P2 1
#endif
#ifndef REP_ATT
#define REP_ATT 1
#endif
#ifndef REP_SYNC
#define REP_SYNC 0
#endif
__global__ void __launch_bounds__(512) mk_fwd(Params p) {
    extern __shared__ __attribute__((aligned(16))) unsigned char lds_raw[];
    cg::grid_group grid = cg::this_grid();
    LAS unsigned char* lds = (LAS unsigned char*)lds_raw;
    if (threadIdx.x < 2) ((LAS unsigned*)(lds + 131072))[threadIdx.x] = 0u;
    __syncthreads();
    const XcdBarrier bar = xcd_barrier_post((unsigned*)(p.ws + WS_BAR), (volatile LAS unsigned*)(lds + 131072));
    const int G = gridDim.x, blk = blockIdx.x, NGW = G * 8;
#define PHASE_IDS() int tid = threadIdx.x; asm volatile("" : "+v"(tid)); const int lane = tid & 63, wave = __builtin_amdgcn_readfirstlane(tid >> 6), gw = blk * 8 + wave; (void)gw; (void)lane; LAS float* scr = (LAS float*)(lds + wave * 8704); (void)scr
    unsigned char* ws = p.ws;
    float* MOD = (float*)(ws + WS_MOD); float* CUM = (float*)(ws + WS_CUM); float* PART = (float*)(ws + WS_PART);
    bf16_t* XN = (bf16_t*)(ws + WS_XN); bf16_t* PBF = (bf16_t*)(ws + WS_PBF); float* PF32 = (float*)(ws + WS_PF32);

    for (int rep_ = 0; rep_ < REP_P0; ++rep_) {
        PHASE_IDS();
        __syncthreads();
        LAS float* sl = (LAS float*)(lds + 73728);
        for (int i = tid; i < NB * DM; i += 512) { const float v = p.in[1][i]; sl[i] = v * sigm(v); }
        __syncthreads();
        constexpr int I_MOD = 16 * 48, I_IN = 32 * (NPROJ / 32), I_OUT = 32 * 64, I_A = 16 * 64;
        const int vgw = wave * G + blk, ntr = I_IN + I_OUT + 2 * I_A;
        for (int r = vgw; r < I_MOD; r += 8 * G) {
            const int ks = r / 48, cc = r % 48;
            const float* wp = p.in[2] + (size_t)(ks * 128) * NMOD + cc * 256 + lane * 4;
            f32x4 a0 = {0.f, 0.f, 0.f, 0.f}, a1 = a0, a2 = a0, a3 = a0;
#pragma unroll 16
            for (int rr = 0; rr < 128; ++rr) { const f32x4 w = __builtin_nontemporal_load((const f32x4*)(wp + (size_t)rr * NMOD)); const int d = ks * 128 + rr;
                a0 += w * sl[d]; a1 += w * sl[DM + d]; a2 += w * sl[2 * DM + d]; a3 += w * sl[3 * DM + d]; }
            float* pp = PART + (size_t)(ks * 4) * NMOD + cc * 256 + lane * 4;
            *(f32x4*)pp = a0; *(f32x4*)(pp + NMOD) = a1; *(f32x4*)(pp + 2 * NMOD) = a2; *(f32x4*)(pp + 3 * NMOD) = a3;
        }
        const bool bal = (G == 256);
        const int t_lo = bal ? (vgw < 768 ? 3 * vgw : 2304 + 11 * (vgw - 768)) : vgw, t_n = bal ? (vgw < 768 ? 3 : 11) : ntr, t_st = bal ? 1 : 8 * G;
        for (int k = 0; k < t_n; ++k) {
            int r = t_lo + k * t_st; if (r >= ntr) break;
            if (r < I_IN) { transpose_item(p.in[4], 11720, (bf16_t*)(ws + WS_WIN), DM, r / (NPROJ / 32), r % (NPROJ / 32), scr, lane, MapWin()); continue; } r -= I_IN;
            if (r < I_OUT) { transpose_item(p.in[21], DM, (bf16_t*)(ws + WS_WOUT), DM, r / 64, r % 64, scr, lane, MapId()); continue; } r -= I_OUT;
            if (r < I_A) { transpose_item(p.in[19], DM, (bf16_t*)(ws + WS_WA), 1024, r / 64, r % 64, scr, lane, MapId()); continue; } r -= I_A;
            transpose_item(p.in[20], DM, (bf16_t*)(ws + WS_WB), 1024, r / 64, r % 64, scr, lane, MapId());
        }
        bf16_t* WL = (bf16_t*)(ws + WS_WLORA);
        for (int idx = blk * 512 + tid; idx < 3072 * 64; idx += G * 512) {
            const int n = idx % 3072, kc = idx / 3072, k0 = kc * 8; float v[8];
#pragma unroll
            for (int i = 0; i < 8; ++i) { const int k = k0 + i; float x = 0.f;
                if (n < 1024) { if (k < 96) x = p.in[10][(size_t)k * 1024 + n]; }
                else if (n < 2048) { if (k >= 128 && k < 224) x = p.in[12][(size_t)(k - 128) * 1024 + (n - 1024)]; }
                else { if (k >= 256) x = p.in[13][(size_t)(k - 256) * 1024 + (n - 2048)]; }
                v[i] = x; }
            u32x4 o; o.x = pk2(v[0], v[1]); o.y = pk2(v[2], v[3]); o.z = pk2(v[4], v[5]); o.w = pk2(v[6], v[7]);
            *(u32x4*)(WL + (size_t)n * 512 + k0) = o;
        }
    }
    grid.sync();
    for (int rep_ = 0; rep_ < REP_SYNC; ++rep_) xcd_barrier(bar);

    {
        PHASE_IDS();
        LAS float* lsm = (LAS float*)lds;
        for (int rb = blk; rb < MT / 32; rb += G) {
            const int b = rb / 64;
            __syncthreads();
            for (int i = tid; i < 2 * DM; i += 512) { float s = p.in[3][i];
#pragma unroll
                for (int ks = 0; ks < 16; ++ks) s += PART[(size_t)(ks * 4 + b) * NMOD + i];
                lsm[i] = s; }
            __syncthreads();
            for (int rr = wave; rr < 32; rr += 16) { const int row = rb * 32 + rr, row2 = row + 8;
                const float* xr = p.in[0] + (size_t)row * DM + lane * 4; const float* xr2 = p.in[0] + (size_t)row2 * DM + lane * 4; f32x4 v[8], u[8];
#pragma unroll
                for (int j = 0; j < 8; ++j) { v[j] = __builtin_nontemporal_load((const f32x4*)(xr + j * 256)); u[j] = __builtin_nontemporal_load((const f32x4*)(xr2 + j * 256)); }
                float mean, rstd, mean2, rstd2; ln_stats(v, mean, rstd); ln_stats(u, mean2, rstd2);
                bf16_t* orow = XN + (size_t)row * DM + lane * 4; bf16_t* orow2 = XN + (size_t)row2 * DM + lane * 4;
#pragma unroll
                for (int j = 0; j < 8; ++j) { const int c = j * 256 + lane * 4; const f32x4 sh = *(const LAS f32x4*)(lsm + c), sc = *(const LAS f32x4*)(lsm + DM + c);
                    const f32x4 o = (v[j] - mean) * rstd * (sc + 1.f) + sh; u32x2 w; w.x = pk2(o[0], o[1]); w.y = pk2(o[2], o[3]); *(u32x2*)(orow + j * 256) = w;
                    const f32x4 o2 = (u[j] - mean2) * rstd2 * (sc + 1.f) + sh; u32x2 w2; w2.x = pk2(o2[0], o2[1]); w2.y = pk2(o2[2], o2[3]); *(u32x2*)(orow2 + j * 256) = w2; } }
        }
        for (int i = blk * 512 + tid; i < NB * NMOD; i += G * 512) { const int b = i / NMOD, col = i % NMOD; float s = p.in[3][col];
#pragma unroll
            for (int ks = 0; ks < 16; ++ks) s += PART[(size_t)(ks * 4 + b) * NMOD + col];
            MOD[i] = s; }
    }
    xcd_barrier(bar);

    for (int rep_ = 0; rep_ < REP_P2; ++rep_) {
        {
        pg8::StaticOrder S; S.init(MT, NBF, G, blk);
        pg8::Gemm g{XN, (const bf16_t*)(ws + WS_WIN), MT, NBF, DM}; pg8::EpiProjBf E{PBF};
        pg8::gemm_phase<pg8::EpiProjBf, pg8::StaticOrder, false, true>(lds, g, S, E);
        }
        {
        pg8::StaticOrder S; S.init(MT, NF32, G, blk);
        pg8::Gemm g{XN, (const bf16_t*)(ws + WS_WIN) + (size_t)NBF * DM, MT, NF32, DM}; pg8::EpiF32 E{PF32, NF32};
        pg8::gemm_phase<pg8::EpiF32, pg8::StaticOrder, false, true>(lds, g, S, E);
        }
    }
    xcd_barrier(bar);

    for (int rep_ = 0; rep_ < REP_P3; ++rep_) {
        PHASE_IDS();
        __syncthreads();
        LAS float* wsum = (LAS float*)lds;
        for (int job = blk; job < 32; job += G) {
            const int b = job >> 3, h = job & 7; const float bias = p.in[5][h]; const int t0 = tid * 4; float l[4];
#pragma unroll
            for (int i = 0; i < 4; ++i) { const float x = PF32[(size_t)(b * SEQ + t0 + i) * NF32 + 3520 + h] + bias; l[i] = fminf(x, 0.f) - log1pf(expf(-fabsf(x))); }
            l[1] += l[0]; l[2] += l[1]; l[3] += l[2];
            const float tot = l[3]; float sc = tot;
#pragma unroll
            for (int o = 1; o < 64; o <<= 1) { const float n = __shfl_up(sc, o); if (lane >= o) sc += n; }
            __syncthreads();
            if (lane == 63) wsum[wave] = sc;
            __syncthreads();
            float woff = 0.f;
            for (int w = 0; w < wave; ++w) woff += wsum[w];
            const float base = woff + sc - tot;
            *(f32x4*)(CUM + (size_t)job * SEQ + t0) = (f32x4){base + l[0], base + l[1], base + l[2], base + l[3]};
        }
        for (int row = gw; row < MT; row += NGW) prep_row(p, row, lane);
    }
    xcd_barrier(bar);

    {
        pg8::StaticOrder S; S.init(MT, 3072, G, blk);
        pg8::Gemm g{(const bf16_t*)(ws + WS_ACAT), (const bf16_t*)(ws + WS_WLORA), MT, 3072, 512};
        pg8::EpiLora E{p.in[9], p.in[11], p.in[15], (float*)(ws + WS_WD), (float*)(ws + WS_BB), (float*)(ws + WS_PBF), (const float*)(ws + WS_KK), (bf16_t*)(ws + WS_G)};
        pg8::gemm_phase<pg8::EpiLora, pg8::StaticOrder, true, true>(lds, g, S, E);
    }
    xcd_barrier(bar);

    {
        PHASE_IDS();
        const int NREC = G / 2;
        if (blk < NREC) {
            for (int rep_ = 0; rep_ < REP_REC; ++rep_)
            for (int job = blk; job < 128; job += NREC)
                rwkv_job(lds, job, (const float*)(ws + WS_KK), (const float*)(ws + WS_WD), (const float*)(ws + WS_BB), (const float*)(ws + WS_PBF), p.out, p.out + (size_t)MT * 1024, (float*)(ws + WS_YRAW), tid, wave, lane);
        } else {
            const int AW = G - NREC, total = 128 * REP_ATT; int L = blk - NREC;
            if (L < total) {
                const fabt* Qn = (const fabt*)(ws + WS_QN); const fabt* Kn = (const fabt*)(ws + WS_KN); const fabt* Vb = (const fabt*)(ws + WS_PBF) + 2048; fabt* O = (fabt*)(ws + WS_O);
                constexpr int W = 1 << 20; char* ldsc = (char*)lds_raw;
                int pass = 0; fa::BlockRef<fabt, fabt> cur = fa_ref(L, 0, Qn, Kn, Vb, O, CUM);
                fa::Seam<fabt> S;
                fa::causal_swa_prime<fabt, fabt, 1024, 1024, PBP>(cur, W, ldsc, S);
                for (;;) {
                    const bool more_pass = pass == 0, more_item = L + AW < total, last = !more_pass && !more_item;
                    int passn = pass + 1, Ln = L;
                    if (!more_pass) { passn = 0; Ln = more_item ? L + AW : L; }
                    const fa::BlockRef<fabt, fabt> nxt = last ? cur : fa_ref(Ln, passn, Qn, Kn, Vb, O, CUM);
                    fa::causal_swa_block<fabt, fabt, 1024, 1024, PBP>(cur, nxt, SEQ, W, ldsc, S);
                    if (last) break;
                    cur = nxt; pass = passn; L = Ln;
                }
            }
            __syncthreads();
            const int aw = (blk - NREC) * 8 + wave, AWV = AW * 8;
            for (int r = aw; r < (DFF / 64) * 64; r += AWV) transpose_item(p.in[25], DM, (bf16_t*)(ws + WS_WDOWN), DFF, r / 64, r % 64, scr, lane, MapId());
            for (int r = aw; r < 32 * (2 * DFF / 32); r += AWV) transpose_item(p.in[24], 2 * DFF, (bf16_t*)(ws + WS_WGU), DM, r / (2 * DFF / 32), r % (2 * DFF / 32), scr, lane, MapGu());
        }
    }
    xcd_barrier(bar);

    {
        PHASE_IDS();
        for (int row = gw; row < MT; row += NGW) post_row(p, row, lane);
    }
    xcd_barrier(bar);

    {
        pg8::StaticOrder S; S.init(MT, DM, G, blk);
        { pg8::Gemm g{(const bf16_t*)(ws + WS_O), (const bf16_t*)(ws + WS_WA), MT, DM, 1024}; pg8::EpiMerge<1> E{PBF + 4096, p.out, (bf16_t*)(ws + WS_MERGED)};
          pg8::gemm_phase<pg8::EpiMerge<1>, pg8::StaticOrder, true, true>(lds, g, S, E); }
        { pg8::Gemm g{(const bf16_t*)(ws + WS_KN), (const bf16_t*)(ws + WS_WB), MT, DM, 1024}; pg8::EpiMerge<2> E{PBF + 6144, p.out, (bf16_t*)(ws + WS_MERGED)};
          pg8::gemm_phase<pg8::EpiMerge<2>, pg8::StaticOrder, true, true>(lds, g, S, E); }
    }
    xcd_barrier(bar);

    {
        pg8::StaticOrder S; S.init(MT, DM, G, blk);
        pg8::Gemm g{(const bf16_t*)(ws + WS_MERGED), (const bf16_t*)(ws + WS_WOUT), MT, DM, DM}; pg8::EpiRes E{p.in[0], p.out, MOD + 2 * DM};
        pg8::gemm_phase<pg8::EpiRes, pg8::StaticOrder, true, true>(lds, g, S, E);
    }
    xcd_barrier(bar);

    { PHASE_IDS();
    for (int row = gw; row < MT; row += 2 * NGW) {
        const int row2 = row + NGW < MT ? row + NGW : row;
        float* xr = p.out + (size_t)row * DM + lane * 4; float* xr2 = p.out + (size_t)row2 * DM + lane * 4; f32x4 v[8], u[8];
#pragma unroll
        for (int j = 0; j < 8; ++j) { v[j] = *(const f32x4*)(xr + j * 256); u[j] = *(const f32x4*)(xr2 + j * 256); }
        float mean, rstd, mean2, rstd2; ln_stats(v, mean, rstd); ln_stats(u, mean2, rstd2);
#pragma unroll
        for (int j = 0; j < 8; ++j) { const int c = j * 256 + lane * 4; const f32x4 g = *(const f32x4*)(p.in[22] + c), b = *(const f32x4*)(p.in[23] + c);
            v[j] = (v[j] - mean) * rstd * g + b; u[j] = (u[j] - mean2) * rstd2 * g + b; *(f32x4*)(xr + j * 256) = v[j]; if (row2 != row) *(f32x4*)(xr2 + j * 256) = u[j]; }
        ln_stats(v, mean, rstd); ln_stats(u, mean2, rstd2);
        const float* mb = MOD + (size_t)(row / SEQ) * NMOD; const float* mb2 = MOD + (size_t)(row2 / SEQ) * NMOD;
        bf16_t* orow = XN + (size_t)row * DM + lane * 4; bf16_t* orow2 = XN + (size_t)row2 * DM + lane * 4;
#pragma unroll
        for (int j = 0; j < 8; ++j) { const int c = j * 256 + lane * 4;
            { const f32x4 sh = *(const f32x4*)(mb + 3 * DM + c), sc = *(const f32x4*)(mb + 4 * DM + c);
              const f32x4 o = (v[j] - mean) * rstd * (sc + 1.f) + sh; u32x2 w; w.x = pk2(o[0], o[1]); w.y = pk2(o[2], o[3]); *(u32x2*)(orow + j * 256) = w; }
            if (row2 != row) { const f32x4 sh = *(const f32x4*)(mb2 + 3 * DM + c), sc = *(const f32x4*)(mb2 + 4 * DM + c);
              const f32x4 o = (u[j] - mean2) * rstd2 * (sc + 1.f) + sh; u32x2 w; w.x = pk2(o[0], o[1]); w.y = pk2(o[2], o[3]); *(u32x2*)(orow2 + j * 256) = w; } }
    } }
    xcd_barrier(bar);

    for (int rep_ = 0; rep_ < REP_P10; ++rep_) {
        pg8::StaticOrder S; S.init(MT, 2 * DFF, G, blk);
        pg8::Gemm g{XN, (const bf16_t*)(ws + WS_WGU), MT, 2 * DFF, DM}; pg8::EpiSwiGLU E{PBF};
        pg8::gemm_phase<pg8::EpiSwiGLU, pg8::StaticOrder, false, true>(lds, g, S, E);
    }
    xcd_barrier(bar);

    {
        pg8::StaticOrder S; S.init(MT, DM, G, blk);
        pg8::Gemm g{PBF, (const bf16_t*)(ws + WS_WDOWN), MT, DM, DFF}; pg8::EpiRes E{p.out, p.out, MOD + 5 * DM};
        pg8::gemm_phase<pg8::EpiRes, pg8::StaticOrder, true, true>(lds, g, S, E);
    }
    xcd_barrier(bar);

    { PHASE_IDS();
    for (int row = gw; row < MT; row += 2 * NGW) {
        const int row2 = row + NGW < MT ? row + NGW : row;
        float* xr = p.out + (size_t)row * DM + lane * 4; float* xr2 = p.out + (size_t)row2 * DM + lane * 4; f32x4 v[8], u[8];
#pragma unroll
        for (int j = 0; j < 8; ++j) { v[j] = *(const f32x4*)(xr + j * 256); u[j] = *(const f32x4*)(xr2 + j * 256); }
        float mean, rstd, mean2, rstd2; ln_stats(v, mean, rstd); ln_stats(u, mean2, rstd2);
#pragma unroll
        for (int j = 0; j < 8; ++j) { const int c = j * 256 + lane * 4; const f32x4 g = *(const f32x4*)(p.in[26] + c), b = *(const f32x4*)(p.in[27] + c);
            *(f32x4*)(xr + j * 256) = (v[j] - mean) * rstd * g + b; if (row2 != row) *(f32x4*)(xr2 + j * 256) = (u[j] - mean2) * rstd2 * g + b; }
    } }
}

extern "C" void kernel_launch(void* const* d_in, const int* in_sizes, int n_in, void* d_out, int out_size, void* d_ws, size_t ws_size, hipStream_t stream) {
    static int grid_blocks = 0;
    if (grid_blocks == 0) {
        if (n_in != 28 || out_size != MT * DM || ws_size < WS_END) { fprintf(stderr, "kernel_launch: unexpected shapes (n_in %d out %d ws %zu, need %zu)\n", n_in, out_size, ws_size, (size_t)WS_END); grid_blocks = -1; return; }
        int dev = 0, cus = 0, per_cu = 0;
        hipGetDevice(&dev);
        hipDeviceGetAttribute(&cus, hipDeviceAttributeMultiprocessorCount, dev);
        hipFuncSetAttribute((const void*)mk_fwd, hipFuncAttributeMaxDynamicSharedMemorySize, LDS_BYTES);
        hipOccupancyMaxActiveBlocksPerMultiprocessor(&per_cu, (const void*)mk_fwd, 512, LDS_BYTES);
        if (per_cu < 1 || cus < 1) { fprintf(stderr, "kernel_launch: occupancy query failed (%d x %d)\n", cus, per_cu); grid_blocks = -1; return; }
        grid_blocks = cus * per_cu;
        if (grid_blocks > 256) grid_blocks = 256;
    }
    if (grid_blocks < 0) return;
    if (hipMemsetAsync((char*)d_ws + WS_BAR, 0, 65536, stream) != hipSuccess) { fprintf(stderr, "kernel_launch: memset of the barrier words failed\n"); return; }
    Params p{};
    for (int i = 0; i < 28; ++i) p.in[i] = (const float*)d_in[i];
    p.out = (float*)d_out; p.ws = (unsigned char*)d_ws;
    void* args[] = {&p};
    hipError_t e = hipLaunchCooperativeKernel((const void*)mk_fwd, dim3(grid_blocks), dim3(512), args, LDS_BYTES, stream);
    if (e != hipSuccess) fprintf(stderr, "cooperative launch failed: %s (grid %d)\n", hipGetErrorString(e), grid_blocks);
}
```

```cpp
#include <hip/hip_runtime.h>
#include <hip/hip_bf16.h>
#include <hip/hip_cooperative_groups.h>
#include <cstdio>
#include <cstdint>
namespace cg = cooperative_groups;

namespace pg8 {
#define PG8_LAS __attribute__((address_space(3)))
typedef unsigned short bf16_t;
typedef short bf16x8 __attribute__((ext_vector_type(8)));
typedef float f32x4 __attribute__((ext_vector_type(4)));
typedef unsigned u32x4 __attribute__((ext_vector_type(4)));
constexpr int BM = 256, BK = 64, HALF = 128, HTB = HALF * BK * 2  , STAGE_BYTES = 8 * HTB, NXCD = 8, WGM = 8;

__host__ __device__ __forceinline__ int lds_byte(int r, int c) { const int st = (r >> 4) * 2 + (c >> 5), rr = r & 15, cc = c & 31, ob = rr * 64 + cc * 2; return st * 1024 + (ob ^ (((ob >> 9) & 1) << 5)); }
__host__ __device__ __forceinline__ void stage_rc(int b, int& R, int& C) { const int st = b / 1024, sb = b % 1024, swz = sb ^ (((sb >> 9) & 1) << 5); R = (st >> 1) * 16 + swz / 64; C = (st & 1) * 32 + (swz % 64) / 2; }
__host__ __device__ __forceinline__ int perm32(int rho) { const int n = rho >> 4, i = rho & 15; return 8 * (i >> 2) + 4 * n + (i & 3); }

struct Unit { int pm, pn; };
struct Gemm { const bf16_t* A; const bf16_t* Bt; int M, N, K; const bf16_t* A2 = nullptr; const bf16_t* Bt2 = nullptr; };

struct StaticOrder {
    int nM, nN, nwg, G, c;
    __host__ __device__ void init(int M, int N, int G_, int c_) { nM = M / BM; nN = N / BM; nwg = nM * nN; G = G_; c = c_; }
    __host__ __device__ bool next(int i, Unit& u) const {
        const long L = (long)i * G + c; if (L >= nwg) return false;
        int wgid = (int)L; { const int q = nwg / NXCD, r = nwg % NXCD, xcd = wgid % NXCD, off = wgid / NXCD; wgid = (xcd < r ? xcd * (q + 1) : r * (q + 1) + (xcd - r) * q) + off; }
        const int nig = WGM * nN, gid = wgid / nig, fm = gid * WGM, gsz = (nM - fm) < WGM ? (nM - fm) : WGM;
        u.pm = fm + ((wgid % nig) % gsz); u.pn = (wgid % nig) / gsz; return true;
    }
    __device__ __forceinline__ void a_ready(const Unit&) const {}
    __device__ __forceinline__ void done(const Unit&) const {}
};
__device__ __forceinline__ unsigned cvt_pk_bf16(float lo, float hi) { unsigned r; asm volatile("v_cvt_pk_bf16_f32 %0, %1, %2" : "=v"(r) : "v"(lo), "v"(hi)); return r; }
typedef float f32x2 __attribute__((ext_vector_type(2)));
template <class Epi, class Sched, bool ALIGN_EPI = false, bool SP2 = false, bool DUAL = false>
__device__ __forceinline__ void gemm_phase(PG8_LAS unsigned char* lds, const Gemm g, const Sched& S, const Epi& E) {
    int tid = threadIdx.x; asm volatile("" : "+v"(tid));
    const int wid = __builtin_amdgcn_readfirstlane(tid >> 6), lane = tid & 63, wr = wid >> 2, wc = wid & 3, fr = lane & 15, fq = lane >> 4;
    const int K = g.K, HT = K / BK, nt = DUAL ? 2 * HT : HT;
    unsigned voffA[2], voffB[2];
#pragma unroll
    for (int i = 0; i < 2; ++i) { int R, C; stage_rc(tid * 16 + i * 8192, R, C); const int Rb = Epi::PERM ? ((R & ~31) + perm32(R & 31)) : R;
        voffA[i] = (unsigned)(R * K + C) * 2u; voffB[i] = (unsigned)(Rb * K + C) * 2u; }
    const size_t kstep = (size_t)(BK * 2);
    const size_t hstep = (size_t)HALF * K * 2;
    const size_t tstep = 2 * hstep;
    const unsigned ldsw = (unsigned)wid * 1024u;
    const int aoff = lds_byte(wr * 64 + fr, fq * 8), boff = lds_byte(wc * 32 + fr, fq * 8);
#define PG8_SA(b, h) (((b) * 2 + (h)) * HTB)
#define PG8_SB(b, h) ((4 + (b) * 2 + (h)) * HTB)
#define PG8_STAGE(bufoff, gbase, voff) do { _Pragma("unroll") for (int _i = 0; _i < 2; ++_i) \
        __builtin_amdgcn_global_load_lds((const unsigned*)((const char*)(gbase) + (voff)[_i]), (PG8_LAS unsigned*)(lds + (bufoff) + ldsw + _i * 8192), 16, 0, 0); } while (0)
#define PG8_LDA(dst, b, h) do { _Pragma("unroll") for (int m = 0; m < 4; ++m) _Pragma("unroll") for (int k = 0; k < 2; ++k) dst[m][k] = *(const PG8_LAS bf16x8*)(lds + PG8_SA(b, h) + aoff + m * 2048 + k * 1024); } while (0)
#define PG8_LDB(dst, b, h) do { _Pragma("unroll") for (int n = 0; n < 2; ++n) _Pragma("unroll") for (int k = 0; k < 2; ++k) dst[n][k] = *(const PG8_LAS bf16x8*)(lds + PG8_SB(b, h) + boff + n * 2048 + k * 1024); } while (0)
#define PG8_MMA(ai, bj, At, Bt) do { __builtin_amdgcn_s_setprio(1); _Pragma("unroll") for (int m = 0; m < 4; ++m) _Pragma("unroll") for (int n = 0; n < 2; ++n) _Pragma("unroll") for (int k = 0; k < 2; ++k) \
        acc[ai][bj][m][n] = __builtin_amdgcn_mfma_f32_16x16x32_bf16(Bt[n][k], At[m][k], acc[ai][bj][m][n], 0, 0, 0); __builtin_amdgcn_s_setprio(0); } while (0)
#define PG8_WAIT_V(n) asm volatile("s_waitcnt vmcnt(" #n ")" ::: "memory")
#define PG8_WAIT_L(n) asm volatile("s_waitcnt lgkmcnt(" #n ")" ::: "memory")
#define PG8_BAR __builtin_amdgcn_s_barrier()
#define PG8_SCHED __builtin_amdgcn_sched_barrier(0)
    Unit cur, nxt; int ui = 0;
    if (!S.next(0, cur)) return;
    f32x4 acc[2][2][4][2];
#pragma unroll
    for (int a = 0; a < 2; ++a)
#pragma unroll
        for (int b = 0; b < 2; ++b)
#pragma unroll
            for (int m = 0; m < 4; ++m)
#pragma unroll
                for (int n = 0; n < 2; ++n) acc[a][b][m][n] = (f32x4){0.f, 0.f, 0.f, 0.f};
    bf16x8 At[4][2], B0[2][2], B1[2][2];
    const char* cA = (const char*)g.A + (size_t)cur.pm * tstep; const char* cB = (const char*)g.Bt + (size_t)cur.pn * tstep;
    S.a_ready(cur);
    if constexpr (SP2) {
        PG8_STAGE(PG8_SB(0, 0), cB, voffB); PG8_STAGE(PG8_SB(0, 1), cB + hstep, voffB); PG8_STAGE(PG8_SA(0, 0), cA, voffA); PG8_STAGE(PG8_SA(0, 1), cA + hstep, voffA);
        if (wr == 1) PG8_BAR;
        PG8_WAIT_V(2); PG8_BAR;
        PG8_STAGE(PG8_SB(1, 0), cB + kstep, voffB); PG8_STAGE(PG8_SA(1, 0), cA + kstep, voffA); PG8_STAGE(PG8_SB(1, 1), cB + hstep + kstep, voffB);
        PG8_WAIT_V(6); PG8_BAR;
    } else {
        PG8_STAGE(PG8_SB(0, 0), cB, voffB); PG8_STAGE(PG8_SA(0, 0), cA, voffA); PG8_STAGE(PG8_SB(0, 1), cB + hstep, voffB); PG8_STAGE(PG8_SA(0, 1), cA + hstep, voffA);
        if (wr == 1) PG8_BAR;
        PG8_WAIT_V(4); PG8_BAR;
        PG8_STAGE(PG8_SB(1, 0), cB + kstep, voffB); PG8_STAGE(PG8_SA(1, 0), cA + kstep, voffA); PG8_STAGE(PG8_SB(1, 1), cB + hstep + kstep, voffB);
        PG8_WAIT_V(6); PG8_BAR;
    }
    for (;;) {
        const bool has_next = S.next(ui + 1, nxt);
        const char* cA2 = DUAL ? (const char*)g.A2 + (size_t)cur.pm * tstep - (size_t)HT * kstep : cA; const char* cB2 = DUAL ? (const char*)g.Bt2 + (size_t)cur.pn * tstep - (size_t)HT * kstep : cB;
        const char* nA = has_next ? (const char*)g.A + (size_t)nxt.pm * tstep : cA; const char* nB = has_next ? (const char*)g.Bt + (size_t)nxt.pn * tstep : cB;
        for (int t = 0; t < nt; t += 2) {
            const bool last = (t == nt - 2);
            const char* bA0 = (DUAL && t >= HT) ? cA2 : cA; const char* bA2 = (DUAL && t + 2 >= HT) ? cA2 : cA; const char* bB2 = (DUAL && t + 2 >= HT) ? cB2 : cB;
            if constexpr (DUAL) { if (t == HT) E.mid(acc, cur, wr, wc, fr, fq); }
            const char* a1 = bA0 + (size_t)(t + 1) * kstep;
            const char* a2 = last ? nA : bA2 + (size_t)(t + 2) * kstep; const char* b2 = last ? nB : bB2 + (size_t)(t + 2) * kstep;
            const char* a3 = a2 + kstep; const char* b3 = b2 + kstep;
            if (last && has_next) S.a_ready(nxt);
            if constexpr (SP2) {
            PG8_LDB(B0, 0, 0); PG8_LDB(B1, 0, 1); PG8_SCHED; PG8_LDA(At, 0, 0); PG8_STAGE(PG8_SA(1, 1), a1 + hstep, voffA);
            PG8_WAIT_V(8); PG8_WAIT_L(0); PG8_BAR; PG8_MMA(0, 0, At, B0); PG8_MMA(0, 1, At, B1); PG8_BAR; PG8_SCHED;
            PG8_LDA(At, 0, 1); PG8_STAGE(PG8_SB(0, 0), b2, voffB); PG8_STAGE(PG8_SB(0, 1), b2 + hstep, voffB); PG8_STAGE(PG8_SA(0, 0), a2, voffA);
            PG8_WAIT_V(8); PG8_WAIT_L(0); PG8_BAR; PG8_MMA(1, 0, At, B0); PG8_MMA(1, 1, At, B1); PG8_BAR; PG8_SCHED;
            PG8_LDB(B0, 1, 0); PG8_LDB(B1, 1, 1); PG8_SCHED; PG8_LDA(At, 1, 0); PG8_STAGE(PG8_SA(0, 1), a2 + hstep, voffA);
            PG8_WAIT_V(8); PG8_WAIT_L(0); PG8_BAR; PG8_MMA(0, 0, At, B0); PG8_MMA(0, 1, At, B1); PG8_BAR; PG8_SCHED;
            PG8_LDA(At, 1, 1); PG8_STAGE(PG8_SB(1, 0), b3, voffB); PG8_STAGE(PG8_SB(1, 1), b3 + hstep, voffB); PG8_STAGE(PG8_SA(1, 0), a3, voffA);
            PG8_WAIT_V(8); PG8_WAIT_L(0); PG8_BAR; PG8_MMA(1, 0, At, B0); PG8_MMA(1, 1, At, B1); PG8_BAR; PG8_SCHED;
            } else {
            PG8_LDB(B0, 0, 0); PG8_SCHED; PG8_LDA(At, 0, 0); PG8_STAGE(PG8_SA(1, 1), a1 + hstep, voffA);
            PG8_WAIT_L(8); PG8_BAR; PG8_WAIT_L(0); PG8_MMA(0, 0, At, B0); PG8_BAR; PG8_SCHED;
            PG8_LDB(B1, 0, 1); PG8_STAGE(PG8_SB(0, 0), b2, voffB);
            PG8_BAR; PG8_WAIT_L(0); PG8_MMA(0, 1, At, B1); PG8_BAR;
            PG8_LDA(At, 0, 1); PG8_STAGE(PG8_SA(0, 0), a2, voffA);
            PG8_BAR; PG8_WAIT_L(0); PG8_MMA(1, 0, At, B0); PG8_BAR; PG8_SCHED;
            PG8_STAGE(PG8_SB(0, 1), b2 + hstep, voffB);
            PG8_WAIT_V(6); PG8_BAR; PG8_MMA(1, 1, At, B1); PG8_BAR;
            PG8_LDB(B0, 1, 0); PG8_SCHED; PG8_LDA(At, 1, 0); PG8_STAGE(PG8_SA(0, 1), a2 + hstep, voffA);
            PG8_WAIT_L(8); PG8_BAR; PG8_WAIT_L(0); PG8_MMA(0, 0, At, B0); PG8_BAR; PG8_SCHED;
            PG8_LDB(B1, 1, 1); PG8_STAGE(PG8_SB(1, 0), b3, voffB);
            PG8_BAR; PG8_WAIT_L(0); PG8_MMA(0, 1, At, B1); PG8_BAR;
            PG8_LDA(At, 1, 1); PG8_STAGE(PG8_SA(1, 0), a3, voffA);
            PG8_BAR; PG8_WAIT_L(0); PG8_MMA(1, 0, At, B0); PG8_BAR; PG8_SCHED;
            PG8_STAGE(PG8_SB(1, 1), b3 + hstep, voffB);
            PG8_WAIT_V(6); PG8_BAR; PG8_MMA(1, 1, At, B1); PG8_BAR;
            }
        }
        if constexpr (ALIGN_EPI) { if (wr == 0) PG8_BAR; }
        if constexpr (!Epi::AFTER_DRAIN) { E(acc, cur, wr, wc, fr, fq); S.done(cur); }
        if (!has_next) break;
#pragma unroll
        for (int a = 0; a < 2; ++a)
#pragma unroll
            for (int b = 0; b < 2; ++b)
#pragma unroll
                for (int m = 0; m < 4; ++m)
#pragma unroll
                    for (int n = 0; n < 2; ++n) acc[a][b][m][n] = (f32x4){0.f, 0.f, 0.f, 0.f};
        cur = nxt; cA = nA; cB = nB; ++ui;
        if constexpr (ALIGN_EPI) { if (wr == 1) PG8_BAR; }
    }
    PG8_WAIT_V(0);
    if constexpr (!ALIGN_EPI) { if (wr == 0) PG8_BAR; }
    PG8_BAR;
    if constexpr (Epi::AFTER_DRAIN) { E.fused(acc, cur, wr, wc, fr, fq, lds, wid, lane); S.done(cur); }
#undef PG8_SA
#undef PG8_SB
#undef PG8_STAGE
#undef PG8_LDA
#undef PG8_LDB
#undef PG8_MMA
#undef PG8_WAIT_V
#undef PG8_WAIT_L
#undef PG8_BAR
#undef PG8_SCHED
}
}
namespace fa {
constexpr int D = 128; constexpr bool WSKIP = false; constexpr float THR = 8.f;
constexpr float SCALE = 0.08838834764831845f;
constexpr int NW = 8, QBLK = 32, KVBLK = 64, QB = NW * QBLK;
constexpr int SHM_V = KVBLK * D * 2, SHM_K = KVBLK * D * 2;
constexpr int LDS_BYTES = 2 * SHM_V + 2 * SHM_K + NW * 64 * 4;
constexpr int KB_OFF = LDS_BYTES;
constexpr int FA_LDS_BYTES = LDS_BYTES + 2 * 2048 * 4;
__device__ __forceinline__ void load_kbias(const float* CB, int P0, float* dst) {
    const float c0 = CB[P0]; const float inv = 1.0f / SCALE;
    for (int s = threadIdx.x; s < P0 + QB; s += 512) dst[s] = (c0 - CB[s]) * inv;
}
using bf16 = __hip_bfloat16;
typedef short bf16x8 __attribute__((ext_vector_type(8)));
typedef short s16x4 __attribute__((ext_vector_type(4)));
typedef float f32x16 __attribute__((ext_vector_type(16)));
typedef float f32x4 __attribute__((ext_vector_type(4)));
typedef unsigned u32x4 __attribute__((ext_vector_type(4)));
template <class A, class Bt> struct same_t { static constexpr bool v = false; };
template <class A> struct same_t<A, A> { static constexpr bool v = true; };

#define KSWZ(row, colB) ((row) * 256 + ((colB) ^ (((row) & 7) << 4)))
#define SBAR() __builtin_amdgcn_sched_barrier(0)
__device__ __forceinline__ int v_st(int k, int c) { const int kk = (k & ~0xC) | ((k & 4) << 1) | ((k & 8) >> 1); return ((kk >> 3) * 4 + (c >> 5)) * 512 + ((kk & 7) * 32 + (c & 31)) * 2; }
__device__ __forceinline__ int v_rd_base(int lane) { return ((lane & 3) << 3) | (((lane >> 2) & 3) << 6) | (((lane >> 4) & 1) << 5) | (((lane >> 5) & 1) << 8); }
constexpr int v_rd_off(int d0, int ks, int half) { return d0 * 512 + ks * 4096 + half * 2048; }
__device__ __forceinline__ int crow(int r, int hi) { return (r & 3) + 8 * (r >> 2) + 4 * hi; }
__device__ __forceinline__ unsigned cvtpk(float lo, float hi) {
    unsigned r; asm volatile("v_cvt_pk_bf16_f32 %0, %1, %2" : "=v"(r) : "v"(lo), "v"(hi)); return r;
}
__device__ __forceinline__ bf16x8 pack8(f32x4 a, f32x4 b) {
    u32x4 w = {cvtpk(a[0], a[1]), cvtpk(a[2], a[3]), cvtpk(b[0], b[1]), cvtpk(b[2], b[3])};
    return *reinterpret_cast<bf16x8*>(&w);
}
template <class T> __device__ __forceinline__ bf16x8 load8(const T* p) {
    if constexpr (same_t<T, float>::v) { return pack8(*(const f32x4*)p, *(const f32x4*)(p + 4)); }
    else { return *reinterpret_cast<const bf16x8*>(p); }
}
__device__ __forceinline__ void mask_tile(f32x16& p0, f32x16& p1, int dq, unsigned W) {
    const float NEG = -__builtin_inff();
#pragma unroll
    for (int r = 0; r < 16; ++r) {
        const int c = (r & 3) + 8 * (r >> 2);
        if ((unsigned)(dq - c) >= W) p0[r] = NEG;
        if ((unsigned)(dq - c - 32) >= W) p1[r] = NEG;
    }
}
__device__ __forceinline__ void partialSM(f32x16& p0, f32x16& p1, float& m_reg, float& mn, float& alpha) {
    float pmax = p0[0]; for (int r = 1; r < 16; ++r) pmax = fmaxf(pmax, p0[r]); for (int r = 0; r < 16; ++r) pmax = fmaxf(pmax, p1[r]);
    { auto rr = __builtin_amdgcn_permlane32_swap(__float_as_uint(pmax), __float_as_uint(pmax), false, false);
      pmax = fmaxf(__uint_as_float(rr[0]), __uint_as_float(rr[1])); }
    constexpr float C2 = 1.4426950408889634f * SCALE;
    if (__builtin_expect(__all((pmax - m_reg) * SCALE <= THR), 1)) { mn = m_reg; alpha = 1.f; }
    else { mn = fmaxf(m_reg, pmax); alpha = __builtin_amdgcn_exp2f((m_reg - mn) * C2); m_reg = mn; }
    const float mnL = -mn * C2;
    for (int r = 0; r < 16; ++r) p0[r] = fmaf(p0[r], C2, mnL); for (int r = 0; r < 16; ++r) p1[r] = fmaf(p1[r], C2, mnL);
    for (int r = 0; r < 16; ++r) p0[r] = __builtin_amdgcn_exp2f(p0[r]);
}
__device__ __forceinline__ void finishSM(f32x16& p0, f32x16& p1, float alpha, float& l_reg, bf16x8& pa0, bf16x8& pa1, bf16x8& pa2, bf16x8& pa3) {
    for (int r = 0; r < 16; ++r) p1[r] = __builtin_amdgcn_exp2f(p1[r]);
    float ps = 0; for (int r = 0; r < 16; ++r) ps += p0[r]; for (int r = 0; r < 16; ++r) ps += p1[r];
    { auto rr = __builtin_amdgcn_permlane32_swap(__float_as_uint(ps), __float_as_uint(ps), false, false);
      ps = __uint_as_float(rr[0]) + __uint_as_float(rr[1]); }
    l_reg = l_reg * alpha + ps;
#define PK4(P, B_, OUT) do { unsigned a0 = cvtpk(P[B_+0], P[B_+1]), a1 = cvtpk(P[B_+2], P[B_+3]);                          \
        unsigned b0 = cvtpk(P[B_+4], P[B_+5]), b1 = cvtpk(P[B_+6], P[B_+7]);                                             \
        auto r0 = __builtin_amdgcn_permlane32_swap(a0, b0, false, false); auto r1 = __builtin_amdgcn_permlane32_swap(a1, b1, false, false); \
        u32x4 w = {r0[0], r1[0], r0[1], r1[1]}; OUT = *reinterpret_cast<bf16x8*>(&w); } while (0)
    PK4(p0, 0, pa0); PK4(p0, 8, pa1); PK4(p1, 0, pa2); PK4(p1, 8, pa3);
#undef PK4
}
template <int KB, bool SK>
__device__ __forceinline__ void qkt(f32x16& p0, f32x16& p1, const char* K_lds, int r32, int hi, const bf16x8* qr, bool act, const float* kbp) {
    if (SK && !act) { const float NEG = -__builtin_inff();
#pragma unroll
        for (int r = 0; r < 16; ++r) { p0[r] = NEG; p1[r] = NEG; } return; }
    p0 = f32x16{}; p1 = f32x16{};
    const char* kb[4];
#pragma unroll
    for (int dd = 0; dd < 4; ++dd) kb[dd] = K_lds + KB * SHM_K + KSWZ(r32, (dd * 16 + hi * 8) * 2);
#pragma unroll
    for (int d0 = 0; d0 < 8; ++d0) { const char* a = kb[d0 & 3] + (d0 >> 2) * 128;
        bf16x8 b0 = *reinterpret_cast<const bf16x8*>(a);
        bf16x8 b1 = *reinterpret_cast<const bf16x8*>(a + 32 * 256);
        p0 = __builtin_amdgcn_mfma_f32_32x32x16_bf16(b0, qr[d0], p0, 0, 0, 0);
        p1 = __builtin_amdgcn_mfma_f32_32x32x16_bf16(b1, qr[d0], p1, 0, 0, 0); }
    {
        const float c0_ = hi ? 0.f : kbp[r32], c1_ = hi ? 0.f : kbp[32 + r32];
        const unsigned hp = cvtpk(c0_, c1_); const float r0_ = c0_ - __uint_as_float(hp << 16), r1_ = c1_ - __uint_as_float(hp & 0xffff0000u);
        const unsigned mp = cvtpk(r0_, r1_); const unsigned lp = cvtpk(r0_ - __uint_as_float(mp << 16), r1_ - __uint_as_float(mp & 0xffff0000u));
        u32x4 k0_ = {(hp & 0xffffu) | (mp << 16), lp & 0xffffu, 0u, 0u}, k1_ = {(hp >> 16) | (mp & 0xffff0000u), lp >> 16, 0u, 0u};
        const u32x4 q1_ = {0x3F803F80u, 0x00003F80u, 0u, 0u};
        p0 = __builtin_amdgcn_mfma_f32_32x32x16_bf16(*reinterpret_cast<bf16x8*>(&k0_), *reinterpret_cast<const bf16x8*>(&q1_), p0, 0, 0, 0);
        p1 = __builtin_amdgcn_mfma_f32_32x32x16_bf16(*reinterpret_cast<bf16x8*>(&k1_), *reinterpret_cast<const bf16x8*>(&q1_), p1, 0, 0, 0); }
}
template <int VB, bool SK>
__device__ __forceinline__ void pv_tile(f32x16* o, int vb0, bf16x8 pa0, bf16x8 pa1, bf16x8 pa2, bf16x8 pa3, bool act) {
    if (SK && !act) return;
#define TRRD(dst, off) asm volatile("ds_read_b64_tr_b16 %0, %1 offset:%2" : "=&v"(dst) : "v"(vb0), "i"(off) : "memory")
#define PV_D0(d0) do { s16x4 l0, l1, l2, l3, h0, h1, h2, h3; constexpr int b_ = VB * SHM_V + v_rd_off(d0, 0, 0);     \
        TRRD(l0, b_); TRRD(h0, b_ + 2048); TRRD(l1, b_ + 4096); TRRD(h1, b_ + 6144); TRRD(l2, b_ + 8192); TRRD(h2, b_ + 10240); TRRD(l3, b_ + 12288); TRRD(h3, b_ + 14336); \
        asm volatile("s_waitcnt lgkmcnt(0)" ::: "memory"); SBAR();                 \
        o[d0] = __builtin_amdgcn_mfma_f32_32x32x16_bf16(pa0, (bf16x8){l0[0], l0[1], l0[2], l0[3], h0[0], h0[1], h0[2], h0[3]}, o[d0], 0, 0, 0);   \
        o[d0] = __builtin_amdgcn_mfma_f32_32x32x16_bf16(pa1, (bf16x8){l1[0], l1[1], l1[2], l1[3], h1[0], h1[1], h1[2], h1[3]}, o[d0], 0, 0, 0);   \
        o[d0] = __builtin_amdgcn_mfma_f32_32x32x16_bf16(pa2, (bf16x8){l2[0], l2[1], l2[2], l2[3], h2[0], h2[1], h2[2], h2[3]}, o[d0], 0, 0, 0);   \
        o[d0] = __builtin_amdgcn_mfma_f32_32x32x16_bf16(pa3, (bf16x8){l3[0], l3[1], l3[2], l3[3], h3[0], h3[1], h3[2], h3[3]}, o[d0], 0, 0, 0); } while (0)
    PV_D0(0); PV_D0(1); PV_D0(2); PV_D0(3);
#undef PV_D0
#undef TRRD
}
template <class TIn, class TOut> struct BlockRef { const TIn* Q; const TIn* K; const TIn* V; TOut* O; const TOut* SG; const float* CB; int P0; };
template <class TIn> struct Seam {
    bf16x8 qr[8];
    bf16x8 st_v0, st_v1, st_k0, st_k1; f32x4 sf0, sf1, sf2, sf3;
    int kbsel;
};
__device__ __forceinline__ int swa_jlo(int P0, int W) { const int lowk = P0 - W + 1; return lowk > 0 ? lowk / KVBLK : 0; }
#define ROW(p, k0, rr) ((p) + (size_t)((k0) + (rr)) * D + sc)
#define VMW() asm volatile("s_waitcnt vmcnt(0)" ::: "memory")
#define VMWN(n) asm volatile("s_waitcnt vmcnt(%0)" :: "i"(n) : "memory")
#define ROWK(p, k0, rr) ((p) + (size_t)((k0) + (rr)) * KP + sc)
#define ROWV(p, k0, rr) ((p) + (size_t)((k0) + (rr)) * VP + sc)
#define SLOAD_H(Kp, Vp, k0) do { S.st_v0 = load8<TIn>(ROWV(Vp, k0, sr)); S.st_v1 = load8<TIn>(ROWV(Vp, k0, 32 + sr));              \
                         S.st_k0 = load8<TIn>(ROWK(Kp, k0, sr)); S.st_k1 = load8<TIn>(ROWK(Kp, k0, 32 + sr)); } while (0)
#define SWRITE_HK(bf) do { *(bf16x8*)(K_lds + (bf) * SHM_K + kws) = S.st_k0; *(bf16x8*)(K_lds + (bf) * SHM_K + kws + 32 * 256) = S.st_k1; } while (0)
#define SWRITE_HV(bf) do { *(bf16x8*)(V_lds + (bf) * SHM_V + vst0) = S.st_v0; *(bf16x8*)(V_lds + (bf) * SHM_V + vst1) = S.st_v1; } while (0)
#define SWRITE_H(bf) do { SWRITE_HV(bf); SWRITE_HK(bf); } while (0)
#define SLOAD_F(p, k0) do { S.sf0 = *(const f32x4*)ROW(p, k0, sr); S.sf1 = *(const f32x4*)(ROW(p, k0, sr) + 4);                \
                            S.sf2 = *(const f32x4*)ROW(p, k0, 32 + sr); S.sf3 = *(const f32x4*)(ROW(p, k0, 32 + sr) + 4); } while (0)
#define SWRITE_KF(bf) do { *(bf16x8*)(K_lds + (bf) * SHM_K + kws) = pack8(S.sf0, S.sf1); *(bf16x8*)(K_lds + (bf) * SHM_K + kws + 32 * 256) = pack8(S.sf2, S.sf3); } while (0)
#define SWRITE_VF(bf) do { *(bf16x8*)(V_lds + (bf) * SHM_V + vst0) = pack8(S.sf0, S.sf1); *(bf16x8*)(V_lds + (bf) * SHM_V + vst1) = pack8(S.sf2, S.sf3); } while (0)
template <class TIn, class TOut, int QP, int KP, int VP>
__device__ __forceinline__ void causal_swa_prime(const BlockRef<TIn, TOut>& cur, int W, char* lds, Seam<TIn>& S) {
    constexpr bool F32 = same_t<TIn, float>::v;
    int tid = threadIdx.x; asm volatile("" : "+v"(tid));
    const int wid = __builtin_amdgcn_readfirstlane(tid >> 6), lane = tid & 63, r32 = lane & 31, hi = lane >> 5;
    const int sr = tid >> 4, sc = (tid & 15) * 8, kws = KSWZ(sr, sc * 2); char* K_lds = lds + 2 * SHM_V;
    const int kb0 = swa_jlo(cur.P0, W) * KVBLK;
    for (int d0 = 0; d0 < 8; ++d0) S.qr[d0] = load8<TIn>(cur.Q + (size_t)(wid * QBLK + r32) * QP + d0 * 16 + hi * 8);
    if constexpr (F32) { SLOAD_F((const float*)cur.K, kb0); VMW(); SWRITE_KF(0); SBAR(); SLOAD_F((const float*)cur.V, kb0); }
    else { SLOAD_H(cur.K, cur.V, kb0); VMW(); SWRITE_HK(0); }
    load_kbias(cur.CB, cur.P0, (float*)(lds + KB_OFF)); S.kbsel = 0;
    __syncthreads();
}
template <class TIn, class TOut, int QP, int KP, int VP>
__device__ __forceinline__ void causal_swa_block(const BlockRef<TIn, TOut>& cur, const BlockRef<TIn, TOut>& nxt, int skv, int W, char* lds, Seam<TIn>& S) {
    constexpr bool F32 = same_t<TIn, float>::v;
    int tid = threadIdx.x; asm volatile("" : "+v"(tid));
    const int wid = __builtin_amdgcn_readfirstlane(tid >> 6), lane = tid & 63, r32 = lane & 31, hi = lane >> 5;
    const int j_lo = swa_jlo(cur.P0, W);
    int j_hi = (cur.P0 + QB - 1) / KVBLK + 1; if (j_hi > skv / KVBLK) j_hi = skv / KVBLK;
    const int NT = j_hi - j_lo;
    const int kbn = swa_jlo(nxt.P0, W) * KVBLK;
    const int qlo = cur.P0 + wid * QBLK, qm = qlo + r32 - 4 * hi;
    char* V_lds = lds; char* K_lds = lds + 2 * SHM_V; const float* kbl = (const float*)(lds + KB_OFF) + S.kbsel * 2048;
    float* ws = (float*)(lds + 2 * SHM_V + 2 * SHM_K) + wid * 64; float* li_l = ws, * al_l = ws + 32;
    float m_reg = -1e30f, l_reg = 0; f32x16 o[4] = {};
    const int sr = tid >> 4, sc = (tid & 15) * 8, vst0 = v_st(sr, sc), vst1 = v_st(32 + sr, sc), kws = KSWZ(sr, sc * 2);
    const int vb0 = (int)(uintptr_t)V_lds + v_rd_base(lane);
    const TIn* Kh = cur.K; const TIn* Vh = cur.V;
#define RESC(a) do { if (__any((a) < 1.f)) { if (hi == 0) al_l[r32] = (a); asm volatile("s_waitcnt lgkmcnt(0)" ::: "memory");              \
                     for (int d_ = 0; d_ < 4; ++d_) for (int r = 0; r < 16; ++r) o[d_][r] *= al_l[crow(r, hi)]; } } while (0)
#define KBASE(t) ((j_lo + (t)) * KVBLK)
#define KBP(t) (kbl + KBASE(t))
#define ACT(t) (KBASE(t) <= qlo + QBLK - 1 && KBASE(t) + KVBLK - 1 >= qlo - W + 1)
#define MASKT(P0_, P1_, t) do { const int kb_ = KBASE(t); if ((!SK || ACT(t)) && (kb_ + KVBLK - 1 > qlo || kb_ <= qlo + QBLK - 1 - W)) mask_tile(P0_, P1_, qm - kb_, (unsigned)W); } while (0)
    constexpr int NQL = F32 ? 16 : 8;
    constexpr bool SK = WSKIP && !F32;
#define SEAM_K0() do { VMWN(NQL); if constexpr (F32) { SWRITE_KF(0); SBAR(); SLOAD_F((const float*)nxt.V, kbn); } else { SWRITE_HK(0); } SBAR(); } while (0)
    f32x16 pA0, pA1, pB0, pB1; float mnA, mnB, alA, alB; bf16x8 pa0, pa1, pa2, pa3;
    if constexpr (F32) { VMW(); SWRITE_VF(0); SBAR(); } else { SWRITE_HV(0); SBAR(); }
    if (NT > 1) { if constexpr (F32) SLOAD_F((const float*)Kh, KBASE(1)); else SLOAD_H(Kh, Vh, KBASE(1)); }
    SBAR(); qkt<0, SK>(pA0, pA1, K_lds, r32, hi, S.qr, ACT(0), KBP(0));
    if constexpr (F32) { if (NT > 1) { VMW(); SWRITE_KF(1); SBAR(); SLOAD_F((const float*)Vh, KBASE(1)); } }
    MASKT(pA0, pA1, 0); partialSM(pA0, pA1, m_reg, mnA, alA);
    if (NT > 1) { VMW(); if constexpr (F32) { SWRITE_VF(1); SBAR(); if (NT > 2) SLOAD_F((const float*)Kh, KBASE(2)); } else SWRITE_H(1); }
    __syncthreads();
#define HALF_STEP(PX0, PX1, mnX, alX, PY0, PY1, alY, t, KB, VB, SB) do {                                                      \
        SBAR(); qkt<KB, SK>(PX0, PX1, K_lds, r32, hi, S.qr, ACT(t), KBP(t));                                             \
        finishSM(PY0, PY1, alY, l_reg, pa0, pa1, pa2, pa3); SBAR();                                                           \
        if ((t) + 1 < NT) { if constexpr (F32) { VMW(); SWRITE_KF(SB); SBAR(); SLOAD_F((const float*)Vh, KBASE((t) + 1)); }  \
                            else { SLOAD_H(Kh, Vh, KBASE((t) + 1)); } SBAR(); }                                               \
        pv_tile<VB, SK>(o, vb0, pa0, pa1, pa2, pa3, ACT((t) - 1)); MASKT(PX0, PX1, (t)); partialSM(PX0, PX1, m_reg, mnX, alX);                                        \
        __syncthreads();                                                                                                      \
        if ((t) + 1 < NT) { VMW(); if constexpr (F32) { SWRITE_VF(SB); SBAR(); if ((t) + 2 < NT) SLOAD_F((const float*)Kh, KBASE((t) + 2)); } \
                            else { SWRITE_H(SB); } }                                                                          \
        RESC(alX); __syncthreads(); } while (0)
    for (int t = 1; t + 1 < NT; t += 2) {
        HALF_STEP(pB0, pB1, mnB, alB, pA0, pA1, alA, t, 1, 0, 0);
        HALF_STEP(pA0, pA1, mnA, alA, pB0, pB1, alB, t + 1, 0, 1, 1);
    }
    const bool even = (NT & 1) == 0;
    if (even) { SBAR(); qkt<1, SK>(pB0, pB1, K_lds, r32, hi, S.qr, ACT(NT - 1), KBP(NT - 1)); SBAR(); }
#define QROW(e) (nxt.Q + (size_t)(wid * QBLK + r32) * D + ((e) >> 1) * 16 + hi * 8 + ((e) & 1) * 4)
    if constexpr (F32) { SLOAD_F((const float*)nxt.K, kbn); SBAR();
#pragma unroll
        for (int e = 0; e < 8; ++e) (void)0; }
    else { SLOAD_H(nxt.K, nxt.V, kbn); SBAR();
#pragma unroll
        for (int d0 = 0; d0 < 8; ++d0) S.qr[d0] = load8<TIn>(nxt.Q + (size_t)(wid * QBLK + r32) * QP + d0 * 16 + hi * 8); }
    SBAR();
    finishSM(pA0, pA1, alA, l_reg, pa0, pa1, pa2, pa3); SBAR();
    if constexpr (F32) {
#pragma unroll
        for (int e = 8; e < 16; ++e) (void)0; SBAR(); }
#undef QROW
    pv_tile<0, SK>(o, vb0, pa0, pa1, pa2, pa3, ACT(even ? NT - 2 : NT - 1));
    if (even) { MASKT(pB0, pB1, NT - 1); partialSM(pB0, pB1, m_reg, mnB, alB); __syncthreads(); RESC(alB);
        finishSM(pB0, pB1, alB, l_reg, pa0, pa1, pa2, pa3); SBAR(); pv_tile<1, SK>(o, vb0, pa0, pa1, pa2, pa3, ACT(NT - 1)); }
    SBAR(); SEAM_K0();
    if (hi == 0) li_l[r32] = l_reg; asm volatile("s_waitcnt lgkmcnt(0)" ::: "memory");
    float rli[16];
#pragma unroll
    for (int r = 0; r < 16; ++r) rli[r] = __builtin_amdgcn_rcpf(li_l[crow(r, hi)]);
    TOut* Ow = cur.O + (size_t)(wid * QBLK) * QP; const TOut* SGw = cur.SG + (size_t)(wid * QBLK) * VP;
#pragma unroll
    for (int r = 0; r < 16; ++r) { const int orow = crow(r, hi);
#pragma unroll
        for (int d0 = 0; d0 < 4; ++d0) { const float v = o[d0][r] * rli[r] * __bfloat162float(SGw[(size_t)orow * VP + d0 * 32 + r32]);
            if constexpr (same_t<TOut, float>::v) { Ow[(size_t)orow * QP + d0 * 32 + r32] = v; }
            else { const float vn = __shfl_xor(v, 1);
                   if ((r32 & 1) == 0) *(unsigned*)(Ow + (size_t)orow * QP + d0 * 32 + r32) = cvtpk(v, vn); } } }
    if constexpr (F32) {
#pragma unroll
        for (int d0 = 0; d0 < 8; ++d0) (void)0; }
    load_kbias(nxt.CB, nxt.P0, (float*)(lds + KB_OFF) + (S.kbsel ^ 1) * 2048);
    __syncthreads();
    S.kbsel ^= 1;
#undef RESC
#undef KBASE
#undef KBP
#undef ACT
#undef MASKT
#undef SEAM_K0
#undef HALF_STEP
}
#undef ROW
#undef VMW
#undef VMWN
#undef SLOAD_H
#undef SWRITE_HK
#undef SWRITE_HV
#undef SWRITE_H
#undef SLOAD_F
#undef SWRITE_KF
#undef SWRITE_VF

}
#define LAS __attribute__((address_space(3)))
typedef unsigned short bf16_t;
typedef float f32x4 __attribute__((ext_vector_type(4)));
typedef float f32x2 __attribute__((ext_vector_type(2)));
typedef unsigned u32x4 __attribute__((ext_vector_type(4)));
typedef unsigned u32x2 __attribute__((ext_vector_type(2)));
constexpr int DM = 2048, NB = 4, SEQ = 2048, MT = NB * SEQ;
constexpr int DFF = 5632, NMOD = 12288;
constexpr int NBF = 8192, NF32 = 3584, NPROJ = NBF + NF32;
constexpr int PBP = NBF + 64;
constexpr float ALPHA = 1.189207115002721f, LN_EPS = 1e-5f, RMS_EPS = 1e-6f, LNX_EPS = 64e-5f;
constexpr size_t MiB = 1u << 20;
constexpr size_t WS_MOD = 0, WS_CUM = 1 * MiB, WS_PART = 2 * MiB, WS_BAR = 5 * MiB;
constexpr size_t WS_WOUT = 8 * MiB, WS_WA = 16 * MiB, WS_WB = 20 * MiB, WS_WLORA = 24 * MiB;
constexpr size_t WS_WIN = 28 * MiB;
constexpr size_t WS_ACAT = 60 * MiB, WS_MERGED = 235 * MiB;
constexpr int KSP = PBP / 2;
constexpr size_t WS_XN = 74 * MiB;
constexpr size_t WS_QN = 74 * MiB, WS_KN = 90 * MiB;
constexpr size_t WS_PBF = 106 * MiB;
constexpr size_t WS_PF32 = 235 * MiB;
constexpr size_t WS_WD = 235 * MiB, WS_BB = 267 * MiB, WS_G = 299 * MiB, WS_YRAW = 315 * MiB, WS_WGU = 28 * MiB;
constexpr size_t WS_KK = 347 * MiB;
constexpr size_t WS_O = 379 * MiB;
constexpr size_t WS_WDOWN = 395 * MiB;
constexpr size_t WS_END = 417 * MiB;
constexpr int LDS_BYTES = 131072 + 64;

struct Params { const float* in[28]; float* out; unsigned char* ws; };

__device__ __forceinline__ unsigned f2bf(float f) { unsigned u = __builtin_bit_cast(unsigned, f); return (u + 0x7fffu + ((u >> 16) & 1u)) >> 16; }
__device__ __forceinline__ unsigned pk2(float lo, float hi) { return pg8::cvt_pk_bf16(lo, hi); }
__device__ __forceinline__ float bflo(unsigned w) { return __builtin_bit_cast(float, w << 16); }
__device__ __forceinline__ float bfhi(unsigned w) { return __builtin_bit_cast(float, w & 0xffff0000u); }
__device__ __forceinline__ float sigm(float x) { return __builtin_amdgcn_rcpf(1.f + __builtin_amdgcn_exp2f(-1.4426950408889634f * x)); }
__device__ __forceinline__ float wave_sum(float v) {
#pragma unroll
    for (int o = 1; o < 64; o <<= 1) v += __shfl_xor(v, o);
    return v;
}
template <int CTRL> __device__ __forceinline__ float dppf(float x) { return __builtin_bit_cast(float, __builtin_amdgcn_mov_dpp(__builtin_bit_cast(int, x), CTRL, 0xf, 0xf, true)); }
__device__ __forceinline__ float rowsum16(float v) { v += dppf<0xB1>(v); v += dppf<0x4E>(v); v += dppf<0x141>(v); v += dppf<0x128>(v); return v; }
#define LDS_WAIT() asm volatile("s_waitcnt lgkmcnt(0)" ::: "memory")

namespace pg8 {
__device__ __forceinline__ f32x4 sig4(f32x4 v) { f32x4 r; r[0] = sigm(v[0]); r[1] = sigm(v[1]); r[2] = sigm(v[2]); r[3] = sigm(v[3]); return r; }
__device__ __forceinline__ u32x4 pack8(f32x4 a, f32x4 b) { u32x4 w; w.x = cvt_pk_bf16(a[0], a[1]); w.y = cvt_pk_bf16(a[2], a[3]); w.z = cvt_pk_bf16(b[0], b[1]); w.w = cvt_pk_bf16(b[2], b[3]); return w; }
struct EpiProjBf { static constexpr bool PERM = true, AFTER_DRAIN = false; bf16_t* O;
    __device__ __forceinline__ void operator()(const f32x4 (&acc)[2][2][4][2], const Unit& u, int wr, int wc, int fr, int fq) const {
        const int row0 = u.pm * BM + wr * 64 + fr, col0 = u.pn * BM + wc * 32 + 8 * fq; const bool sg = u.pn >= 12;
#pragma unroll
        for (int ai = 0; ai < 2; ++ai)
#pragma unroll
            for (int m = 0; m < 4; ++m) { bf16_t* rowp = O + (size_t)(row0 + ai * HALF + m * 16) * PBP + col0;
#pragma unroll
                for (int bj = 0; bj < 2; ++bj) { f32x4 v0 = acc[ai][bj][m][0], v1 = acc[ai][bj][m][1];
                    if (sg) { v0 = sig4(v0); v1 = sig4(v1); }
                    *(u32x4*)(rowp + bj * HALF) = pack8(v0, v1); } }
    }
};
struct EpiF32 { static constexpr bool PERM = false, AFTER_DRAIN = false; float* O; int ldc;
    __device__ __forceinline__ void operator()(const f32x4 (&acc)[2][2][4][2], const Unit& u, int wr, int wc, int fr, int fq) const {
        const int row0 = u.pm * BM + wr * 64 + fr, col0 = u.pn * BM + wc * 32 + 4 * fq;
#pragma unroll
        for (int ai = 0; ai < 2; ++ai)
#pragma unroll
            for (int m = 0; m < 4; ++m) { float* rowp = O + (size_t)(row0 + ai * HALF + m * 16) * ldc + col0;
#pragma unroll
                for (int bj = 0; bj < 2; ++bj)
#pragma unroll
                    for (int n = 0; n < 2; ++n) *(f32x4*)(rowp + bj * HALF + n * 16) = acc[ai][bj][m][n]; }
    }
};
struct EpiLora { static constexpr bool PERM = false, AFTER_DRAIN = false;
    const float* w0; const float* a0; const float* k_a; float* WD; float* BB; float* KS; const float* KK; bf16_t* G;
    __device__ __forceinline__ void operator()(const f32x4 (&acc)[2][2][4][2], const Unit& u, int wr, int wc, int fr, int fq) const {
        const int row0 = u.pm * BM + wr * 64 + fr, sel = u.pn >> 2, cb = (u.pn & 3) * BM + wc * 32 + 4 * fq;
#pragma unroll
        for (int bj = 0; bj < 2; ++bj)
#pragma unroll
            for (int n = 0; n < 2; ++n) { const int c = cb + bj * HALF + n * 16;
                if (sel == 0) { const f32x4 wv = *(const f32x4*)(w0 + c);
#pragma unroll
                    for (int ai = 0; ai < 2; ++ai)
#pragma unroll
                        for (int m = 0; m < 4; ++m) { const size_t off = (size_t)(row0 + ai * HALF + m * 16) * 1024 + c; f32x4 o;
#pragma unroll
                            for (int i = 0; i < 4; ++i) { const float x = wv[i] + acc[ai][bj][m][n][i];
                                const float wraw = fminf(x, 0.f) - __logf(1.f + __expf(-fabsf(x))) - 0.5f; o[i] = __expf(-__expf(wraw)); }
                            *(f32x4*)(WD + off) = o; }
                } else if (sel == 1) { const f32x4 av = *(const f32x4*)(a0 + c), kav = *(const f32x4*)(k_a + c);
#pragma unroll
                    for (int ai = 0; ai < 2; ++ai)
#pragma unroll
                        for (int m = 0; m < 4; ++m) { const size_t off = (size_t)(row0 + ai * HALF + m * 16) * 1024 + c;
                            const size_t offk = (size_t)(row0 + ai * HALF + m * 16) * KSP + c; const f32x4 kk = *(const f32x4*)(KK + off), ks = *(const f32x4*)(KS + offk); f32x4 ob, ok;
#pragma unroll
                            for (int i = 0; i < 4; ++i) { const float a = sigm(av[i] + acc[ai][bj][m][n][i]); ob[i] = kk[i] * a; ok[i] = ks[i] * (1.f + (a - 1.f) * kav[i]); }
                            *(f32x4*)(BB + off) = ob; *(f32x4*)(KS + offk) = ok; }
                } else {
#pragma unroll
                    for (int ai = 0; ai < 2; ++ai)
#pragma unroll
                        for (int m = 0; m < 4; ++m) { const size_t off = (size_t)(row0 + ai * HALF + m * 16) * 1024 + c; const f32x4 v = acc[ai][bj][m][n];
                            u32x2 w; w.x = cvt_pk_bf16(v[0], v[1]); w.y = cvt_pk_bf16(v[2], v[3]); *(u32x2*)(G + off) = w; }
                } }
    }
};
template <int PASS> struct EpiMerge { static constexpr bool PERM = true, AFTER_DRAIN = false; const bf16_t* SG; float* TMP; bf16_t* MG;
    __device__ __forceinline__ void operator()(const f32x4 (&acc)[2][2][4][2], const Unit& u, int wr, int wc, int fr, int fq) const {
        const int row0 = u.pm * BM + wr * 64 + fr, col0 = u.pn * BM + wc * 32 + 8 * fq;
#pragma unroll
        for (int ai = 0; ai < 2; ++ai)
#pragma unroll
            for (int m = 0; m < 4; ++m) { const int row = row0 + ai * HALF + m * 16;
#pragma unroll
                for (int bj = 0; bj < 2; ++bj) { const int c = col0 + bj * HALF; const u32x4 s = *(const u32x4*)(SG + (size_t)row * PBP + c);
                    f32x4 v0 = acc[ai][bj][m][0], v1 = acc[ai][bj][m][1];
                    v0 = v0 * (f32x4){bflo(s.x), bfhi(s.x), bflo(s.y), bfhi(s.y)}; v1 = v1 * (f32x4){bflo(s.z), bfhi(s.z), bflo(s.w), bfhi(s.w)};
                    float* tp = TMP + (size_t)row * DM + c;
                    if (PASS == 1) { *(f32x4*)tp = v0; *(f32x4*)(tp + 4) = v1; }
                    else { v0 = v0 + *(const f32x4*)tp; v1 = v1 + *(const f32x4*)(tp + 4); *(u32x4*)(MG + (size_t)row * DM + c) = pack8(v0, v1); } } }
    }
};
struct EpiMergeDual { static constexpr bool PERM = true, AFTER_DRAIN = false; const bf16_t* SGA; const bf16_t* SGB; bf16_t* MG;
    __device__ __forceinline__ void mid(f32x4 (&acc)[2][2][4][2], const Unit& u, int wr, int wc, int fr, int fq) const {
        int row0 = u.pm * BM + wr * 64 + fr, col0 = u.pn * BM + wc * 32 + 8 * fq;
        asm volatile("" : "+v"(row0), "+v"(col0));
#pragma unroll
        for (int ai = 0; ai < 2; ++ai)
#pragma unroll
            for (int m = 0; m < 4; ++m) { const size_t ro = (size_t)(row0 + ai * HALF + m * 16) * PBP;
#pragma unroll
                for (int bj = 0; bj < 2; ++bj) { const int c = col0 + bj * HALF; const u32x4 a = *(const u32x4*)(SGA + ro + c), b = *(const u32x4*)(SGB + ro + c);
#define MRG_R(x, y) ((x) * __builtin_amdgcn_rcpf(fmaxf((y), 1e-20f)))
                    acc[ai][bj][m][0] = acc[ai][bj][m][0] * (f32x4){MRG_R(bflo(a.x), bflo(b.x)), MRG_R(bfhi(a.x), bfhi(b.x)), MRG_R(bflo(a.y), bflo(b.y)), MRG_R(bfhi(a.y), bfhi(b.y))};
                    acc[ai][bj][m][1] = acc[ai][bj][m][1] * (f32x4){MRG_R(bflo(a.z), bflo(b.z)), MRG_R(bfhi(a.z), bfhi(b.z)), MRG_R(bflo(a.w), bflo(b.w)), MRG_R(bfhi(a.w), bfhi(b.w))};
#undef MRG_R
                }
                asm volatile("" ::: "memory"); }
    }
    __device__ __forceinline__ void operator()(const f32x4 (&acc)[2][2][4][2], const Unit& u, int wr, int wc, int fr, int fq) const {
        const int row0 = u.pm * BM + wr * 64 + fr, col0 = u.pn * BM + wc * 32 + 8 * fq;
#pragma unroll
        for (int ai = 0; ai < 2; ++ai)
#pragma unroll
            for (int m = 0; m < 4; ++m) { const int row = row0 + ai * HALF + m * 16;
#pragma unroll
                for (int bj = 0; bj < 2; ++bj) { const int c = col0 + bj * HALF; const u32x4 s = *(const u32x4*)(SGB + (size_t)row * PBP + c);
                    const f32x4 v0 = acc[ai][bj][m][0] * (f32x4){bflo(s.x), bfhi(s.x), bflo(s.y), bfhi(s.y)}, v1 = acc[ai][bj][m][1] * (f32x4){bflo(s.z), bfhi(s.z), bflo(s.w), bfhi(s.w)};
                    *(u32x4*)(MG + (size_t)row * DM + c) = pack8(v0, v1); } }
    }
};
struct EpiRes { static constexpr bool PERM = false, AFTER_DRAIN = false; const float* X; float* OUT; const float* gate;
    __device__ __forceinline__ void operator()(const f32x4 (&acc)[2][2][4][2], const Unit& u, int wr, int wc, int fr, int fq) const {
        const int row0 = u.pm * BM + wr * 64 + fr, col0 = u.pn * BM + wc * 32 + 4 * fq; const float* gp = gate + (size_t)(u.pm >> 3) * NMOD;
#pragma unroll
        for (int bj = 0; bj < 2; ++bj)
#pragma unroll
            for (int n = 0; n < 2; ++n) { const int c = col0 + bj * HALF + n * 16; const f32x4 gv = *(const f32x4*)(gp + c);
#pragma unroll
                for (int ai = 0; ai < 2; ++ai)
#pragma unroll
                    for (int m = 0; m < 4; ++m) { const size_t off = (size_t)(row0 + ai * HALF + m * 16) * DM + c;
                        const f32x4 xv = *(const f32x4*)(X + off); *(f32x4*)(OUT + off) = xv * ALPHA + gv * acc[ai][bj][m][n]; } }
    }
};
struct EpiSwiGLU { static constexpr bool PERM = true, AFTER_DRAIN = false; bf16_t* ACT;
    __device__ __forceinline__ void operator()(const f32x4 (&acc)[2][2][4][2], const Unit& u, int wr, int wc, int fr, int fq) const {
        const int row0 = u.pm * BM + wr * 64 + fr, col0 = u.pn * HALF + wc * 32 + 8 * fq;
#pragma unroll
        for (int ai = 0; ai < 2; ++ai)
#pragma unroll
            for (int m = 0; m < 4; ++m) { const f32x4 g0 = acc[ai][0][m][0], g1 = acc[ai][0][m][1], u0 = acc[ai][1][m][0], u1 = acc[ai][1][m][1];
                const f32x4 a0 = g0 * sig4(g0) * u0, a1 = g1 * sig4(g1) * u1;
                *(u32x4*)(ACT + (size_t)(row0 + ai * HALF + m * 16) * DFF + col0) = pack8(a0, a1); }
    }
};
}
__device__ __forceinline__ int q_pop(unsigned* ctr, int lane) { unsigned v = 0u; if (lane == 0) v = __hip_atomic_fetch_add(ctr, 1u, __ATOMIC_RELAXED, __HIP_MEMORY_SCOPE_AGENT); return (int)__builtin_amdgcn_readfirstlane(v); }
struct MapId { __device__ __forceinline__ int operator()(int n) const { return n; } };
struct MapWin { __device__ __forceinline__ int operator()(int n) const {
    return n < 4096 ? n : n < 8192 ? 7624 + (n - 4096) : n < 11712 ? 4104 + (n - 8192) : n < 11720 ? 4096 + (n - 11712) : -1; } };
struct MapGu { __device__ __forceinline__ int operator()(int n) const { const int pn = n >> 8, j = n & 255; return j < 128 ? 128 * pn + j : DFF + 128 * pn + (j - 128); } };
template <class Map>
__device__ __forceinline__ void transpose_item(const float* W, int ldw, bf16_t* WT, int Kd, int kb, int nb, LAS float* scr, int lane, Map map) {
    const int k0 = 64 * kb, n0 = 32 * nb; const int src = map(n0 + (lane & 31));
    const float* wp = W + (size_t)(k0 + (lane >> 5)) * ldw + (src >= 0 ? src : 0);
    float tv[32];
#pragma unroll
    for (int i = 0; i < 32; ++i) tv[i] = src >= 0 ? __builtin_nontemporal_load(wp + (size_t)(2 * i) * ldw) : 0.f;
#pragma unroll
    for (int i = 0; i < 32; ++i) scr[(2 * i + (lane >> 5)) * 33 + (lane & 31)] = tv[i];
    LDS_WAIT();
    const int c = lane & 7;
#pragma unroll
    for (int j = 0; j < 4; ++j) { const int n = (lane >> 3) + 8 * j; const LAS float* s = scr + (8 * c) * 33 + n;
        u32x4 o; o.x = pk2(s[0 * 33], s[1 * 33]); o.y = pk2(s[2 * 33], s[3 * 33]); o.z = pk2(s[4 * 33], s[5 * 33]); o.w = pk2(s[6 * 33], s[7 * 33]);
        *(u32x4*)(WT + (size_t)(n0 + n) * Kd + k0 + 8 * c) = o; }
    LDS_WAIT();
}
__device__ __forceinline__ void ln_stats(const f32x4 (&v)[8], float& mean, float& rstd) {
    float s = 0.f;
#pragma unroll
    for (int j = 0; j < 8; ++j) s += (v[j][0] + v[j][1]) + (v[j][2] + v[j][3]);
    mean = wave_sum(s) * (1.f / DM); float q = 0.f;
#pragma unroll
    for (int j = 0; j < 8; ++j) { const f32x4 d = v[j] - mean; q += (d[0] * d[0] + d[1] * d[1]) + (d[2] * d[2] + d[3] * d[3]); }
    rstd = 1.f / sqrtf(wave_sum(q) * (1.f / DM) + LN_EPS);
}

__device__ __forceinline__ void prep_row(const Params& p, int t, int lane) {
    unsigned char* ws = p.ws;
    const bf16_t* PBF = (const bf16_t*)(ws + WS_PBF) + (size_t)t * PBP;
    bf16_t* QN = (bf16_t*)(ws + WS_QN) + (size_t)t * 1024; bf16_t* KN = (bf16_t*)(ws + WS_KN) + (size_t)t * 1024;
    u32x4 qk4[4];
#pragma unroll
    for (int ps = 0; ps < 4; ++ps) qk4[ps] = *(const u32x4*)(PBF + (ps >> 1) * 1024 + (ps & 1) * 512 + lane * 8);
#pragma unroll
    for (int ps = 0; ps < 4; ++ps) {
        const int isk = ps >> 1, c = (ps & 1) * 512 + lane * 8;
        const u32x4 w = qk4[ps];
        float x[8] = {bflo(w.x), bfhi(w.x), bflo(w.y), bfhi(w.y), bflo(w.z), bfhi(w.z), bflo(w.w), bfhi(w.w)};
        float ss = 0.f;
#pragma unroll
        for (int i = 0; i < 8; ++i) ss += x[i] * x[i];
        ss = rowsum16(ss);
        const float rs = 1.f / sqrtf(ss * (1.f / 128.f) + RMS_EPS);
        const float* gp = (isk ? p.in[7] : p.in[6]) + (c & 127);
        const f32x4 g0 = *(const f32x4*)gp, g1 = *(const f32x4*)(gp + 4);
        u32x4 o; o.x = pk2(x[0] * rs * g0[0], x[1] * rs * g0[1]); o.y = pk2(x[2] * rs * g0[2], x[3] * rs * g0[3]);
        o.z = pk2(x[4] * rs * g1[0], x[5] * rs * g1[1]); o.w = pk2(x[6] * rs * g1[2], x[7] * rs * g1[3]);
        *(u32x4*)((isk ? KN : QN) + c) = o;
    }
    const float* cur = (const float*)(ws + WS_PF32) + (size_t)t * NF32; const float* prv = cur - NF32;
    const bool first = (t & (SEQ - 1)) == 0; const float* mu = p.in[8];
    float* R = p.out + (size_t)t * 1024; float* V32 = p.out + (size_t)MT * 1024 + (size_t)t * 1024;
    float* KS = (float*)(ws + WS_PBF) + (size_t)t * KSP; float* KK = (float*)(ws + WS_KK) + (size_t)t * 1024;
    asm volatile("" ::: "memory");
#define SHIFTED(col) ({ const f32x4 c_ = *(const f32x4*)(cur + (col)); const f32x4 p_ = first ? (f32x4){0.f, 0.f, 0.f, 0.f} : *(const f32x4*)(prv + (col)); const f32x4 m_ = *(const f32x4*)(mu + (col)); c_ + (p_ - c_) * m_; })
#pragma unroll
    for (int pp = 0; pp < 2; ++pp) {
        f32x4 cu[2][3], pr[2][3], mm[2][3], kkw[2];
#pragma unroll
        for (int q = 0; q < 2; ++q) { const int c = (2 * pp + q) * 256 + lane * 4;
#pragma unroll
            for (int s_ = 0; s_ < 3; ++s_) { cu[q][s_] = *(const f32x4*)(cur + s_ * 1024 + c); pr[q][s_] = first ? (f32x4){0.f, 0.f, 0.f, 0.f} : *(const f32x4*)(prv + s_ * 1024 + c); mm[q][s_] = *(const f32x4*)(mu + s_ * 1024 + c); }
            kkw[q] = *(const f32x4*)(p.in[14] + c); }
#pragma unroll
        for (int q = 0; q < 2; ++q) { const int c = (2 * pp + q) * 256 + lane * 4;
            *(f32x4*)(R + c) = cu[q][0] + (pr[q][0] - cu[q][0]) * mm[q][0];
            *(f32x4*)(V32 + c) = cu[q][2] + (pr[q][2] - cu[q][2]) * mm[q][2];
            const f32x4 ks = cu[q][1] + (pr[q][1] - cu[q][1]) * mm[q][1]; *(f32x4*)(KS + c) = ks;
            const f32x4 kv = ks * kkw[q];
            const float nn = rowsum16((kv[0] * kv[0] + kv[1] * kv[1]) + (kv[2] * kv[2] + kv[3] * kv[3]));
            const float inv = 1.f / fmaxf(sqrtf(nn), 1e-12f);
            *(f32x4*)(KK + c) = kv * inv; }
    }
    bf16_t* AC = (bf16_t*)(ws + WS_ACAT) + (size_t)t * 512;
    if (lane < 32) {
        f32x4 a = {0.f, 0.f, 0.f, 0.f}, b = {0.f, 0.f, 0.f, 0.f};
        if (lane < 24) { const f32x4 xw = SHIFTED(3072 + lane * 4); b = SHIFTED(3168 + lane * 4);
#pragma unroll
            for (int i = 0; i < 4; ++i) { const float e = __expf(-2.f * fabsf(xw[i])); const float th = (1.f - e) / (1.f + e); a[i] = xw[i] < 0.f ? -th : th; } }
        u32x2 wa, wb; wa.x = pk2(a[0], a[1]); wa.y = pk2(a[2], a[3]); wb.x = pk2(b[0], b[1]); wb.y = pk2(b[2], b[3]);
        *(u32x2*)(AC + lane * 4) = wa; *(u32x2*)(AC + 128 + lane * 4) = wb; }
    { const f32x4 xg = SHIFTED(3264 + lane * 4); u32x2 w; w.x = pk2(sigm(xg[0]), sigm(xg[1])); w.y = pk2(sigm(xg[2]), sigm(xg[3])); *(u32x2*)(AC + 256 + lane * 4) = w; }
#undef SHIFTED
}

__device__ __forceinline__ void rwkv_job(LAS unsigned char* lds, int job, const float* KK, const float* WD, const float* BB, const float* KS, const float* R, const float* V32, float* Y, int tid, int wave, int lane) {
    const int bh = job >> 1, half = job & 1, b = bh >> 4, h = bh & 15;
    const size_t tok0 = (size_t)b * SEQ;
    constexpr int TC = 32, CHF = TC * 384, NCH = SEQ / TC;
    LAS float* buf = (LAS float*)lds;
    const int lt = tid & 255, lrow = lt >> 4, piece = lt & 15;
    const size_t goff = (tok0 + lrow) * 1024 + h * 64 + piece * 4;
    const size_t goffk = (tok0 + lrow) * KSP + h * 64 + piece * 4;
    f32x4 rg[12];
#define RW_LOAD(c) do { const size_t o_ = goff + (size_t)(c) * TC * 1024, ok_ = goffk + (size_t)(c) * TC * KSP; \
        rg[0] = *(const f32x4*)(KK + o_); rg[1] = *(const f32x4*)(KK + o_ + 16 * 1024); rg[2] = *(const f32x4*)(WD + o_); rg[3] = *(const f32x4*)(WD + o_ + 16 * 1024); \
        rg[4] = *(const f32x4*)(BB + o_); rg[5] = *(const f32x4*)(BB + o_ + 16 * 1024); rg[6] = *(const f32x4*)(KS + ok_); rg[7] = *(const f32x4*)(KS + ok_ + 16 * KSP); \
        rg[8] = *(const f32x4*)(R + o_); rg[9] = *(const f32x4*)(R + o_ + 16 * 1024); rg[10] = *(const f32x4*)(V32 + o_); rg[11] = *(const f32x4*)(V32 + o_ + 16 * 1024); } while (0)
#define RW_WRITE(c) do { LAS float* d_ = buf + ((c) & 1) * CHF + lrow * 384 + piece * 4; \
        _Pragma("unroll") for (int s_ = 0; s_ < 6; ++s_) { *(LAS f32x4*)(d_ + s_ * 64) = rg[2 * s_]; *(LAS f32x4*)(d_ + 16 * 384 + s_ * 64) = rg[2 * s_ + 1]; } } while (0)
    if (wave >= 4) { RW_LOAD(0); RW_WRITE(0); RW_LOAD(1); }
    __syncthreads();
    const int rw = lane >> 3, j = lane & 7, rl = wave * 8 + rw;
    f32x2 S[4] = {{0.f, 0.f}, {0.f, 0.f}, {0.f, 0.f}, {0.f, 0.f}};
#define RW_STEP(dst, dv, st_) do { const LAS float* sp_ = cb + (st_) * 384; \
        _Pragma("unroll") for (int s_ = 0; s_ < 5; ++s_) { dst[2 * s_] = *(const LAS f32x4*)(sp_ + s_ * 64); dst[2 * s_ + 1] = *(const LAS f32x4*)(sp_ + s_ * 64 + 4); } \
        dv = vb[(st_) * 384]; } while (0)
    for (int c = 0; c < NCH; ++c) {
        if (wave >= 4) { if (c + 1 < NCH) { RW_WRITE(c + 1); if (c + 2 < NCH) RW_LOAD(c + 2); } }
        else {
            const LAS float* cb = buf + (c & 1) * CHF + 8 * j;
            const LAS float* vb = buf + (c & 1) * CHF + 320 + half * 32 + rl;
            float* yp = Y + (tok0 + (size_t)c * TC) * 1024 + h * 64 + half * 32 + rl;
            f32x4 q[10]; float vv;
            RW_STEP(q, vv, 0);
#pragma unroll 4
            for (int st = 0; st < TC; ++st) {
                f32x4 n[10]; float nv; const int ns = st + 1 < TC ? st + 1 : st;
                RW_STEP(n, nv, ns);
                f32x2 ta = S[0] * q[0].lo, tb = S[1] * q[0].hi; ta = S[2] * q[1].lo + ta; tb = S[3] * q[1].hi + tb; ta = ta + tb;
                float d = ta[0] + ta[1];
                d += dppf<0xB1>(d); d += dppf<0x4E>(d); d += dppf<0x141>(d);
                S[0] = S[0] * q[2].lo - q[4].lo * d + q[6].lo * vv;
                S[1] = S[1] * q[2].hi - q[4].hi * d + q[6].hi * vv;
                S[2] = S[2] * q[3].lo - q[5].lo * d + q[7].lo * vv;
                S[3] = S[3] * q[3].hi - q[5].hi * d + q[7].hi * vv;
                f32x2 ua = S[0] * q[8].lo, ub = S[1] * q[8].hi; ua = S[2] * q[9].lo + ua; ub = S[3] * q[9].hi + ub; ua = ua + ub;
                float y = ua[0] + ua[1];
                y += dppf<0xB1>(y); y += dppf<0x4E>(y); y += dppf<0x141>(y);
                yp[(size_t)st * 1024] = y;
#pragma unroll
                for (int i = 0; i < 10; ++i) q[i] = n[i];
                vv = nv;
            }
        }
        __syncthreads();
    }
#undef RW_STEP
#undef RW_LOAD
#undef RW_WRITE
}

__device__ __forceinline__ void post_row(const Params& p, int t, int lane) {
    unsigned char* ws = p.ws;
    const float* Y = (const float*)(ws + WS_YRAW) + (size_t)t * 1024; const float* R = p.out + (size_t)t * 1024; const float* V32 = p.out + (size_t)MT * 1024 + (size_t)t * 1024;
    const float* KS = (const float*)(ws + WS_PBF) + (size_t)t * KSP; const bf16_t* G = (const bf16_t*)(ws + WS_G) + (size_t)t * 1024;
    bf16_t* YB = (bf16_t*)(ws + WS_KN) + (size_t)t * 1024;
#pragma unroll
    for (int pp = 0; pp < 2; ++pp) {
        f32x4 y_[2], r_[2], k_[2], v_[2], rk_[2], lg_[2], lb_[2]; u32x2 g_[2];
#pragma unroll
        for (int q = 0; q < 2; ++q) { const int c = (2 * pp + q) * 256 + lane * 4;
            y_[q] = *(const f32x4*)(Y + c); r_[q] = *(const f32x4*)(R + c); k_[q] = *(const f32x4*)(KS + c); v_[q] = *(const f32x4*)(V32 + c);
            rk_[q] = *(const f32x4*)(p.in[16] + c); lg_[q] = *(const f32x4*)(p.in[17] + c); lb_[q] = *(const f32x4*)(p.in[18] + c); g_[q] = *(const u32x2*)(G + c); }
#pragma unroll
        for (int q = 0; q < 2; ++q) { const int c = (2 * pp + q) * 256 + lane * 4;
            const f32x4 y = y_[q];
            const float mean = rowsum16((y[0] + y[1]) + (y[2] + y[3])) * (1.f / 64.f);
            const f32x4 d = y - mean;
            const float var = rowsum16((d[0] * d[0] + d[1] * d[1]) + (d[2] * d[2] + d[3] * d[3])) * (1.f / 64.f);
            const float rs = 1.f / sqrtf(var + LNX_EPS);
            const f32x4 yn = d * rs * lg_[q] + lb_[q];
            const f32x4 pr = r_[q] * k_[q] * rk_[q];
            const float bs = rowsum16((pr[0] + pr[1]) + (pr[2] + pr[3]));
            const u32x2 gw = g_[q];
            const f32x4 o = (yn + v_[q] * bs) * (f32x4){bflo(gw.x), bfhi(gw.x), bflo(gw.y), bfhi(gw.y)};
            u32x2 w; w.x = pk2(o[0], o[1]); w.y = pk2(o[2], o[3]); *(u32x2*)(YB + c) = w; }
    }
}

__device__ __forceinline__ void og_row(const Params& p, int t, int lane) {
    unsigned char* ws = p.ws;
    bf16_t* O = (bf16_t*)(ws + WS_O) + (size_t)t * 1024; const bf16_t* SG = (const bf16_t*)(ws + WS_PBF) + (size_t)t * PBP + 3072;
    u32x4 o8[2], s8[2];
#pragma unroll
    for (int ps = 0; ps < 2; ++ps) { o8[ps] = *(const u32x4*)(O + ps * 512 + lane * 8); s8[ps] = *(const u32x4*)(SG + ps * 512 + lane * 8); }
#pragma unroll
    for (int ps = 0; ps < 2; ++ps) { const int c = ps * 512 + lane * 8;
        const u32x4 o = o8[ps], s = s8[ps]; u32x4 w;
        w.x = pk2(bflo(o.x) * bflo(s.x), bfhi(o.x) * bfhi(s.x)); w.y = pk2(bflo(o.y) * bflo(s.y), bfhi(o.y) * bfhi(s.y));
        w.z = pk2(bflo(o.z) * bflo(s.z), bfhi(o.z) * bfhi(s.z)); w.w = pk2(bflo(o.w) * bflo(s.w), bfhi(o.w) * bfhi(s.w));
        *(u32x4*)(O + c) = w; }
}

typedef __hip_bfloat16 fabt;
__device__ __forceinline__ fa::BlockRef<fabt, fabt> fa_ref(int L, int pass, const fabt* Qn, const fabt* Kn, const fabt* Vb, fabt* O, const float* CUM) {
    const int bh = (L & 127) >> 2, x = L & 3, qb = pass ? 7 - x : x, b = bh >> 3, h = bh & 7; const size_t row0 = (size_t)b * SEQ;
    fa::BlockRef<fabt, fabt> r;
    r.Q = Qn + (row0 + (size_t)qb * 256) * 1024 + h * 128; r.O = O + (row0 + (size_t)qb * 256) * 1024 + h * 128;
    r.K = Kn + row0 * 1024 + h * 128; r.V = Vb + row0 * PBP + h * 128; r.SG = Vb + (row0 + (size_t)qb * 256) * PBP + 1024 + h * 128; r.CB = CUM + bh * SEQ; r.P0 = qb * 256;
    return r;
}
#define RLX_AGENT __ATOMIC_RELAXED, __HIP_MEMORY_SCOPE_AGENT
#define XB_TMO      128
#define XB_XCNT(j)  (256  + 64 * (j))
#define XB_XSUB(j)  (1280 + 64 * (j))
#define XB_XGEN(j)  (2304 + 64 * (j))
#define XB_TOP      3328
#define XB_TOPGEN   3392
#define XCD_BAR_WORDS 3456
#define XB_SPIN_CAP (1u << 18)

__device__ __forceinline__ unsigned xb_ld(unsigned* p)              { return __hip_atomic_load(p, __ATOMIC_RELAXED, __HIP_MEMORY_SCOPE_AGENT); }
__device__ __forceinline__ unsigned xb_add(unsigned* p, unsigned v) { return __hip_atomic_fetch_add(p, v, __ATOMIC_RELAXED, __HIP_MEMORY_SCOPE_AGENT); }
__device__ __forceinline__ unsigned xb_xcc_id() { return (unsigned)__builtin_amdgcn_s_getreg((3 << 11) | 20) & 0xFu; }
#define XB_SPIN(cond, bar) do { unsigned _sp = 0; while (cond) { __builtin_amdgcn_s_sleep(1); \
    if ((++_sp & 255u) == 0u) { if (xb_ld(&(bar)[XB_TMO])) break; if (_sp > XB_SPIN_CAP) { atomicAdd(&(bar)[XB_TMO], 1u); break; } } } } while (0)

struct XcdBarrier {
    unsigned* bar; unsigned x;
    volatile LAS unsigned* st;
};

__device__ __forceinline__ XcdBarrier xcd_barrier_post(unsigned* bar, volatile LAS unsigned* st) {
    XcdBarrier b; b.bar = bar; b.x = xb_xcc_id(); b.st = st;
    if (threadIdx.x == 0) (void)xb_add(&bar[XB_XCNT(b.x)], 1u);
    return b;
}
__device__ __forceinline__ void xcd_barrier_complete(unsigned* bar, unsigned x, unsigned& nloc, unsigned& nx) {
    const unsigned G = gridDim.x * gridDim.y * gridDim.z;
    unsigned sum, cnt, mine, sp = 0u;
    for (;;) {
        sum = 0u; cnt = 0u; mine = 0u;
#pragma unroll
        for (unsigned j = 0; j < 16; ++j) { const unsigned c = xb_ld(&bar[XB_XCNT(j)]); sum += c; cnt += (c > 0u) ? 1u : 0u; mine = (j == x) ? c : mine; }
        if (sum == G) break;
        __builtin_amdgcn_s_sleep(1);
        if ((++sp & 255u) == 0u) { if (xb_ld(&bar[XB_TMO])) break; if (sp > XB_SPIN_CAP) { atomicAdd(&bar[XB_TMO], 1u); break; } }
    }
    nloc = mine > 0u ? mine : 1u; nx = cnt > 0u ? cnt : 1u;
}

__device__ __forceinline__ void xcd_barrier(const XcdBarrier& b) {
    asm volatile("s_waitcnt vmcnt(0)" ::: "memory");
    __syncthreads();
    if (threadIdx.x == 0) {
        unsigned* bar = b.bar;
        __builtin_amdgcn_s_waitcnt(0);
        unsigned nloc = b.st[0], nx = b.st[1];
        if (nloc == 0u) { xcd_barrier_complete(bar, b.x, nloc, nx); b.st[0] = nloc; b.st[1] = nx; }
        const unsigned old = xb_add(&bar[XB_XSUB(b.x)], 1u);
        const unsigned gen = old / nloc;
        if (old + 1u == (gen + 1u) * nloc) {
            __builtin_amdgcn_fence(__ATOMIC_RELEASE, "agent");
            asm volatile("s_waitcnt vmcnt(0)" ::: "memory");
            const unsigned og = xb_add(&bar[XB_TOP], 1u);
            const unsigned tg = og / nx;
            if (og + 1u == (tg + 1u) * nx) xb_add(&bar[XB_TOPGEN], 1u);
            else XB_SPIN(xb_ld(&bar[XB_TOPGEN]) == tg, bar);
            __builtin_amdgcn_fence(__ATOMIC_ACQUIRE, "agent");
            xb_add(&bar[XB_XGEN(b.x)], 1u);
            asm volatile("s_waitcnt vmcnt(0)" ::: "memory");
        } else {
            XB_SPIN(xb_ld(&bar[XB_XGEN(b.x)]) == gen, bar);
            __builtin_amdgcn_fence(__ATOMIC_ACQUIRE, "agent");
            asm volatile("s_waitcnt vmcnt(0)" ::: "memory");
        }
    }
    __syncthreads();
}
#ifndef REP_P0
#define REP_P0 1
#endif
#ifndef REP_P3
#define REP_P3 1
#endif
#ifndef REP_REC
#define REP_REC 1
#endif
#ifndef REP_P10
#define REP_P10 1
#endif
#ifndef REP_P2
#define REP_P2 1
#endif
#ifndef REP_ATT
#define REP_ATT 1
#endif
#ifndef REP_P7B
#define REP_P7B 1
#endif
#ifndef REP_P8
#define REP_P8 1
#endif
#ifndef REP_SYNC
#define REP_SYNC 0
#endif
__global__ void __launch_bounds__(512) mk_fwd(Params p) {
    extern __shared__ __attribute__((aligned(16))) unsigned char lds_raw[];
    cg::grid_group grid = cg::this_grid();
    LAS unsigned char* lds = (LAS unsigned char*)lds_raw;
    if (threadIdx.x < 2) ((LAS unsigned*)(lds + 131072))[threadIdx.x] = 0u;
    __syncthreads();
    const XcdBarrier bar = xcd_barrier_post((unsigned*)(p.ws + WS_BAR), (volatile LAS unsigned*)(lds + 131072));
    const int G = gridDim.x, blk = blockIdx.x, NGW = G * 8;
#define PHASE_IDS() int tid = threadIdx.x; asm volatile("" : "+v"(tid)); const int lane = tid & 63, wave = __builtin_amdgcn_readfirstlane(tid >> 6), gw = blk * 8 + wave; (void)gw; (void)lane; LAS float* scr = (LAS float*)(lds + wave * 8704); (void)scr
    unsigned char* ws = p.ws;
    float* MOD = (float*)(ws + WS_MOD); float* CUM = (float*)(ws + WS_CUM); float* PART = (float*)(ws + WS_PART);
    bf16_t* XN = (bf16_t*)(ws + WS_XN); bf16_t* PBF = (bf16_t*)(ws + WS_PBF); float* PF32 = (float*)(ws + WS_PF32);

    for (int rep_ = 0; rep_ < REP_P0; ++rep_) {
        PHASE_IDS();
        __syncthreads();
        LAS float* sl = (LAS float*)(lds + 73728);
        for (int i = tid; i < NB * DM; i += 512) { const float v = p.in[1][i]; sl[i] = v * sigm(v); }
        __syncthreads();
        constexpr int I_MOD = 16 * 48, I_IN = 32 * (NPROJ / 32), I_OUT = 32 * 64, I_A = 16 * 64;
        const int vgw = wave * G + blk, ntr = I_IN + I_OUT + 2 * I_A;
        for (int r = vgw; r < I_MOD; r += 8 * G) {
            const int ks = r / 48, cc = r % 48;
            const float* wp = p.in[2] + (size_t)(ks * 128) * NMOD + cc * 256 + lane * 4;
            f32x4 a0 = {0.f, 0.f, 0.f, 0.f}, a1 = a0, a2 = a0, a3 = a0;
#pragma unroll 16
            for (int rr = 0; rr < 128; ++rr) { const f32x4 w = __builtin_nontemporal_load((const f32x4*)(wp + (size_t)rr * NMOD)); const int d = ks * 128 + rr;
                a0 += w * sl[d]; a1 += w * sl[DM + d]; a2 += w * sl[2 * DM + d]; a3 += w * sl[3 * DM + d]; }
            float* pp = PART + (size_t)(ks * 4) * NMOD + cc * 256 + lane * 4;
            *(f32x4*)pp = a0; *(f32x4*)(pp + NMOD) = a1; *(f32x4*)(pp + 2 * NMOD) = a2; *(f32x4*)(pp + 3 * NMOD) = a3;
        }
        const bool bal = (G == 256);
        const int t_lo = bal ? (vgw < 768 ? 3 * vgw : 2304 + 11 * (vgw - 768)) : vgw, t_n = bal ? (vgw < 768 ? 3 : 11) : ntr, t_st = bal ? 1 : 8 * G;
        for (int k = 0; k < t_n; ++k) {
            int r = t_lo + k * t_st; if (r >= ntr) break;
            if (r < I_IN) { transpose_item(p.in[4], 11720, (bf16_t*)(ws + WS_WIN), DM, r / (NPROJ / 32), r % (NPROJ / 32), scr, lane, MapWin()); continue; } r -= I_IN;
            if (r < I_OUT) { transpose_item(p.in[21], DM, (bf16_t*)(ws + WS_WOUT), DM, r / 64, r % 64, scr, lane, MapId()); continue; } r -= I_OUT;
            if (r < I_A) { transpose_item(p.in[19], DM, (bf16_t*)(ws + WS_WA), 1024, r / 64, r % 64, scr, lane, MapId()); continue; } r -= I_A;
            transpose_item(p.in[20], DM, (bf16_t*)(ws + WS_WB), 1024, r / 64, r % 64, scr, lane, MapId());
        }
        bf16_t* WL = (bf16_t*)(ws + WS_WLORA);
        for (int idx = blk * 512 + tid; idx < 3072 * 64; idx += G * 512) {
            const int n = idx % 3072, kc = idx / 3072, k0 = kc * 8; float v[8];
#pragma unroll
            for (int i = 0; i < 8; ++i) { const int k = k0 + i; float x = 0.f;
                if (n < 1024) { if (k < 96) x = p.in[10][(size_t)k * 1024 + n]; }
                else if (n < 2048) { if (k >= 128 && k < 224) x = p.in[12][(size_t)(k - 128) * 1024 + (n - 1024)]; }
                else { if (k >= 256) x = p.in[13][(size_t)(k - 256) * 1024 + (n - 2048)]; }
                v[i] = x; }
            u32x4 o; o.x = pk2(v[0], v[1]); o.y = pk2(v[2], v[3]); o.z = pk2(v[4], v[5]); o.w = pk2(v[6], v[7]);
            *(u32x4*)(WL + (size_t)n * 512 + k0) = o;
        }
    }
    grid.sync();
    for (int rep_ = 0; rep_ < REP_SYNC; ++rep_) xcd_barrier(bar);

    {
        PHASE_IDS();
        LAS float* lsm = (LAS float*)lds;
        for (int rb = blk; rb < MT / 32; rb += G) {
            const int b = rb / 64;
            __syncthreads();
            for (int i = tid; i < 2 * DM; i += 512) { float s = p.in[3][i];
#pragma unroll
                for (int ks = 0; ks < 16; ++ks) s += PART[(size_t)(ks * 4 + b) * NMOD + i];
                lsm[i] = s; }
            __syncthreads();
            for (int rr = wave; rr < 32; rr += 16) { const int row = rb * 32 + rr, row2 = row + 8;
                const float* xr = p.in[0] + (size_t)row * DM + lane * 4; const float* xr2 = p.in[0] + (size_t)row2 * DM + lane * 4; f32x4 v[8], u[8];
#pragma unroll
                for (int j = 0; j < 8; ++j) { v[j] = __builtin_nontemporal_load((const f32x4*)(xr + j * 256)); u[j] = __builtin_nontemporal_load((const f32x4*)(xr2 + j * 256)); }
                float mean, rstd, mean2, rstd2; ln_stats(v, mean, rstd); ln_stats(u, mean2, rstd2);
                bf16_t* orow = XN + (size_t)row * DM + lane * 4; bf16_t* orow2 = XN + (size_t)row2 * DM + lane * 4;
#pragma unroll
                for (int j = 0; j < 8; ++j) { const int c = j * 256 + lane * 4; const f32x4 sh = *(const LAS f32x4*)(lsm + c), sc = *(const LAS f32x4*)(lsm + DM + c);
                    const f32x4 o = (v[j] - mean) * rstd * (sc + 1.f) + sh; u32x2 w; w.x = pk2(o[0], o[1]); w.y = pk2(o[2], o[3]); *(u32x2*)(orow + j * 256) = w;
                    const f32x4 o2 = (u[j] - mean2) * rstd2 * (sc + 1.f) + sh; u32x2 w2; w2.x = pk2(o2[0], o2[1]); w2.y = pk2(o2[2], o2[3]); *(u32x2*)(orow2 + j * 256) = w2; } }
        }
        for (int i = blk * 512 + tid; i < NB * NMOD; i += G * 512) { const int b = i / NMOD, col = i % NMOD; float s = p.in[3][col];
#pragma unroll
            for (int ks = 0; ks < 16; ++ks) s += PART[(size_t)(ks * 4 + b) * NMOD + col];
            MOD[i] = s; }
    }
    xcd_barrier(bar);

    for (int rep_ = 0; rep_ < REP_P2; ++rep_) {
        {
        pg8::StaticOrder S; S.init(MT, NBF, G, blk);
        pg8::Gemm g{XN, (const bf16_t*)(ws + WS_WIN), MT, NBF, DM}; pg8::EpiProjBf E{PBF};
        pg8::gemm_phase<pg8::EpiProjBf, pg8::StaticOrder, true, true>(lds, g, S, E);
        }
        {
        pg8::StaticOrder S; S.init(MT, NF32, G, blk);
        pg8::Gemm g{XN, (const bf16_t*)(ws + WS_WIN) + (size_t)NBF * DM, MT, NF32, DM}; pg8::EpiF32 E{PF32, NF32};
        pg8::gemm_phase<pg8::EpiF32, pg8::StaticOrder, true, true>(lds, g, S, E);
        }
    }
    xcd_barrier(bar);

    for (int rep_ = 0; rep_ < REP_P3; ++rep_) {
        PHASE_IDS();
        __syncthreads();
        LAS float* wsum = (LAS float*)lds;
        for (int job = blk; job < 32; job += G) {
            const int b = job >> 3, h = job & 7; const float bias = p.in[5][h]; const int t0 = tid * 4; float l[4];
#pragma unroll
            for (int i = 0; i < 4; ++i) { const float x = PF32[(size_t)(b * SEQ + t0 + i) * NF32 + 3520 + h] + bias; l[i] = fminf(x, 0.f) - log1pf(expf(-fabsf(x))); }
            l[1] += l[0]; l[2] += l[1]; l[3] += l[2];
            const float tot = l[3]; float sc = tot;
#pragma unroll
            for (int o = 1; o < 64; o <<= 1) { const float n = __shfl_up(sc, o); if (lane >= o) sc += n; }
            __syncthreads();
            if (lane == 63) wsum[wave] = sc;
            __syncthreads();
            float woff = 0.f;
            for (int w = 0; w < wave; ++w) woff += wsum[w];
            const float base = woff + sc - tot;
            *(f32x4*)(CUM + (size_t)job * SEQ + t0) = (f32x4){base + l[0], base + l[1], base + l[2], base + l[3]};
        }
        for (int row = gw; row < MT; row += NGW) prep_row(p, row, lane);
    }
    xcd_barrier(bar);

    {
        pg8::StaticOrder S; S.init(MT, 3072, G, blk);
        pg8::Gemm g{(const bf16_t*)(ws + WS_ACAT), (const bf16_t*)(ws + WS_WLORA), MT, 3072, 512};
        pg8::EpiLora E{p.in[9], p.in[11], p.in[15], (float*)(ws + WS_WD), (float*)(ws + WS_BB), (float*)(ws + WS_PBF), (const float*)(ws + WS_KK), (bf16_t*)(ws + WS_G)};
        pg8::gemm_phase<pg8::EpiLora, pg8::StaticOrder, true, true>(lds, g, S, E);
    }
    xcd_barrier(bar);

    {
        PHASE_IDS();
        const int NREC = G / 2;
        if (blk < NREC) {
            for (int rep_ = 0; rep_ < REP_REC; ++rep_)
            for (int job = blk; job < 128; job += NREC)
                rwkv_job(lds, job, (const float*)(ws + WS_KK), (const float*)(ws + WS_WD), (const float*)(ws + WS_BB), (const float*)(ws + WS_PBF), p.out, p.out + (size_t)MT * 1024, (float*)(ws + WS_YRAW), tid, wave, lane);
        } else {
            const int AW = G - NREC, total = 128 * REP_ATT; int L = blk - NREC;
            if (L < total) {
                const fabt* Qn = (const fabt*)(ws + WS_QN); const fabt* Kn = (const fabt*)(ws + WS_KN); const fabt* Vb = (const fabt*)(ws + WS_PBF) + 2048; fabt* O = (fabt*)(ws + WS_O);
                constexpr int W = 1 << 20; char* ldsc = (char*)lds_raw;
                int pass = 0; fa::BlockRef<fabt, fabt> cur = fa_ref(L, 0, Qn, Kn, Vb, O, CUM);
                fa::Seam<fabt> S;
                fa::causal_swa_prime<fabt, fabt, 1024, 1024, PBP>(cur, W, ldsc, S);
                for (;;) {
                    const bool more_pass = pass == 0, more_item = L + AW < total, last = !more_pass && !more_item;
                    int passn = pass + 1, Ln = L;
                    if (!more_pass) { passn = 0; Ln = more_item ? L + AW : L; }
                    const fa::BlockRef<fabt, fabt> nxt = last ? cur : fa_ref(Ln, passn, Qn, Kn, Vb, O, CUM);
                    fa::causal_swa_block<fabt, fabt, 1024, 1024, PBP>(cur, nxt, SEQ, W, ldsc, S);
                    if (last) break;
                    cur = nxt; pass = passn; L = Ln;
                }
            }
            __syncthreads();
            const int aw = (blk - NREC) * 8 + wave, AWV = AW * 8;
            for (int r = aw; r < (DFF / 64) * 64; r += AWV) transpose_item(p.in[25], DM, (bf16_t*)(ws + WS_WDOWN), DFF, r / 64, r % 64, scr, lane, MapId());
            for (int r = aw; r < 32 * (2 * DFF / 32); r += AWV) transpose_item(p.in[24], 2 * DFF, (bf16_t*)(ws + WS_WGU), DM, r / (2 * DFF / 32), r % (2 * DFF / 32), scr, lane, MapGu());
        }
    }
    xcd_barrier(bar);

    {
        PHASE_IDS();
        for (int row = gw; row < MT; row += NGW) post_row(p, row, lane);
    }
    xcd_barrier(bar);

    for (int rep_ = 0; rep_ < REP_P7B; ++rep_) {
        pg8::StaticOrder S; S.init(MT, DM, G, blk);
        pg8::Gemm g{(const bf16_t*)(ws + WS_O), (const bf16_t*)(ws + WS_WA), MT, DM, 1024, (const bf16_t*)(ws + WS_KN), (const bf16_t*)(ws + WS_WB)};
        pg8::EpiMergeDual E{PBF + 4096, PBF + 6144, (bf16_t*)(ws + WS_MERGED)};
        pg8::gemm_phase<pg8::EpiMergeDual, pg8::StaticOrder, true, true, true>(lds, g, S, E);
    }
    xcd_barrier(bar);

    for (int rep_ = 0; rep_ < REP_P8; ++rep_) {
        pg8::StaticOrder S; S.init(MT, DM, G, blk);
        pg8::Gemm g{(const bf16_t*)(ws + WS_MERGED), (const bf16_t*)(ws + WS_WOUT), MT, DM, DM}; pg8::EpiRes E{p.in[0], p.out, MOD + 2 * DM};
        pg8::gemm_phase<pg8::EpiRes, pg8::StaticOrder, true, true>(lds, g, S, E);
    }
    xcd_barrier(bar);

    { PHASE_IDS();
    for (int row = gw; row < MT; row += 2 * NGW) {
        const int row2 = row + NGW < MT ? row + NGW : row;
        float* xr = p.out + (size_t)row * DM + lane * 4; float* xr2 = p.out + (size_t)row2 * DM + lane * 4; f32x4 v[8], u[8];
#pragma unroll
        for (int j = 0; j < 8; ++j) { v[j] = *(const f32x4*)(xr + j * 256); u[j] = *(const f32x4*)(xr2 + j * 256); }
        float mean, rstd, mean2, rstd2; ln_stats(v, mean, rstd); ln_stats(u, mean2, rstd2);
#pragma unroll
        for (int j = 0; j < 8; ++j) { const int c = j * 256 + lane * 4; const f32x4 g = *(const f32x4*)(p.in[22] + c), b = *(const f32x4*)(p.in[23] + c);
            v[j] = (v[j] - mean) * rstd * g + b; u[j] = (u[j] - mean2) * rstd2 * g + b; *(f32x4*)(xr + j * 256) = v[j]; if (row2 != row) *(f32x4*)(xr2 + j * 256) = u[j]; }
        ln_stats(v, mean, rstd); ln_stats(u, mean2, rstd2);
        const float* mb = MOD + (size_t)(row / SEQ) * NMOD; const float* mb2 = MOD + (size_t)(row2 / SEQ) * NMOD;
        bf16_t* orow = XN + (size_t)row * DM + lane * 4; bf16_t* orow2 = XN + (size_t)row2 * DM + lane * 4;
#pragma unroll
        for (int j = 0; j < 8; ++j) { const int c = j * 256 + lane * 4;
            { const f32x4 sh = *(const f32x4*)(mb + 3 * DM + c), sc = *(const f32x4*)(mb + 4 * DM + c);
              const f32x4 o = (v[j] - mean) * rstd * (sc + 1.f) + sh; u32x2 w; w.x = pk2(o[0], o[1]); w.y = pk2(o[2], o[3]); *(u32x2*)(orow + j * 256) = w; }
            if (row2 != row) { const f32x4 sh = *(const f32x4*)(mb2 + 3 * DM + c), sc = *(const f32x4*)(mb2 + 4 * DM + c);
              const f32x4 o = (u[j] - mean2) * rstd2 * (sc + 1.f) + sh; u32x2 w; w.x = pk2(o[0], o[1]); w.y = pk2(o[2], o[3]); *(u32x2*)(orow2 + j * 256) = w; } }
    } }
    xcd_barrier(bar);

    for (int rep_ = 0; rep_ < REP_P10; ++rep_) {
        pg8::StaticOrder S; S.init(MT, 2 * DFF, G, blk);
        pg8::Gemm g{XN, (const bf16_t*)(ws + WS_WGU), MT, 2 * DFF, DM}; pg8::EpiSwiGLU E{PBF};
        pg8::gemm_phase<pg8::EpiSwiGLU, pg8::StaticOrder, true, true>(lds, g, S, E);
    }
    xcd_barrier(bar);

    {
        pg8::StaticOrder S; S.init(MT, DM, G, blk);
        pg8::Gemm g{PBF, (const bf16_t*)(ws + WS_WDOWN), MT, DM, DFF}; pg8::EpiRes E{p.out, p.out, MOD + 5 * DM};
        pg8::gemm_phase<pg8::EpiRes, pg8::StaticOrder, true, true>(lds, g, S, E);
    }
    xcd_barrier(bar);

    { PHASE_IDS();
    for (int row = gw; row < MT; row += 2 * NGW) {
        const int row2 = row + NGW < MT ? row + NGW : row;
        float* xr = p.out + (size_t)row * DM + lane * 4; float* xr2 = p.out + (size_t)row2 * DM + lane * 4; f32x4 v[8], u[8];
#pragma unroll
        for (int j = 0; j < 8; ++j) { v[j] = *(const f32x4*)(xr + j * 256); u[j] = *(const f32x4*)(xr2 + j * 256); }
        float mean, rstd, mean2, rstd2; ln_stats(v, mean, rstd); ln_stats(u, mean2, rstd2);
#pragma unroll
        for (int j = 0; j < 8; ++j) { const int c = j * 256 + lane * 4; const f32x4 g = *(const f32x4*)(p.in[26] + c), b = *(const f32x4*)(p.in[27] + c);
            *(f32x4*)(xr + j * 256) = (v[j] - mean) * rstd * g + b; if (row2 != row) *(f32x4*)(xr2 + j * 256) = (u[j] - mean2) * rstd2 * g + b; }
    } }
}

extern "C" void kernel_launch(void* const* d_in, const int* in_sizes, int n_in, void* d_out, int out_size, void* d_ws, size_t ws_size, hipStream_t stream) {
    static int grid_blocks = 0;
    if (grid_blocks == 0) {
        if (n_in != 28 || out_size != MT * DM || ws_size < WS_END) { fprintf(stderr, "kernel_launch: unexpected shapes (n_in %d out %d ws %zu, need %zu)\n", n_in, out_size, ws_size, (size_t)WS_END); grid_blocks = -1; return; }
        int dev = 0, cus = 0, per_cu = 0;
        hipGetDevice(&dev);
        hipDeviceGetAttribute(&cus, hipDeviceAttributeMultiprocessorCount, dev);
        hipFuncSetAttribute((const void*)mk_fwd, hipFuncAttributeMaxDynamicSharedMemorySize, LDS_BYTES);
        hipOccupancyMaxActiveBlocksPerMultiprocessor(&per_cu, (const void*)mk_fwd, 512, LDS_BYTES);
        if (per_cu < 1 || cus < 1) { fprintf(stderr, "kernel_launch: occupancy query failed (%d x %d)\n", cus, per_cu); grid_blocks = -1; return; }
        grid_blocks = cus * per_cu;
        if (grid_blocks > 256) grid_blocks = 256;
    }
    if (grid_blocks < 0) return;
    if (hipMemsetAsync((char*)d_ws + WS_BAR, 0, 65536, stream) != hipSuccess) { fprintf(stderr, "kernel_launch: memset of the barrier words failed\n"); return; }
    Params p{};
    for (int i = 0; i < 28; ++i) p.in[i] = (const float*)d_in[i];
    p.out = (float*)d_out; p.ws = (unsigned char*)d_ws;
    void* args[] = {&p};
    hipError_t e = hipLaunchCooperativeKernel((const void*)mk_fwd, dim3(grid_blocks), dim3(512), args, LDS_BYTES, stream);
    if (e != hipSuccess) fprintf(stderr, "cooperative launch failed: %s (grid %d)\n", hipGetErrorString(e), grid_blocks);
}
```

```cpp
#include <hip/hip_runtime.h>
#include <hip/hip_bf16.h>
#include <hip/hip_cooperative_groups.h>
#include <cstdio>
#include <cstdint>
namespace cg = cooperative_groups;

namespace pg8 {
#define PG8_LAS __attribute__((address_space(3)))
typedef unsigned short bf16_t;
typedef short bf16x8 __attribute__((ext_vector_type(8)));
typedef float f32x4 __attribute__((ext_vector_type(4)));
typedef unsigned u32x4 __attribute__((ext_vector_type(4)));
constexpr int BM = 256, BK = 64, HALF = 128, HTB = HALF * BK * 2  , STAGE_BYTES = 8 * HTB, NXCD = 8, WGM = 8;

__host__ __device__ __forceinline__ int lds_byte(int r, int c) { const int st = (r >> 4) * 2 + (c >> 5), rr = r & 15, cc = c & 31, ob = rr * 64 + cc * 2; return st * 1024 + (ob ^ (((ob >> 9) & 1) << 5)); }
__host__ __device__ __forceinline__ void stage_rc(int b, int& R, int& C) { const int st = b / 1024, sb = b % 1024, swz = sb ^ (((sb >> 9) & 1) << 5); R = (st >> 1) * 16 + swz / 64; C = (st & 1) * 32 + (swz % 64) / 2; }
__host__ __device__ __forceinline__ int perm32(int rho) { const int n = rho >> 4, i = rho & 15; return 8 * (i >> 2) + 4 * n + (i & 3); }

struct Unit { int pm, pn; };
struct Gemm { const bf16_t* A; const bf16_t* Bt; int M, N, K; const bf16_t* A2 = nullptr; const bf16_t* Bt2 = nullptr; };

struct StaticOrder {
    int nM, nN, nwg, G, c;
    __host__ __device__ void init(int M, int N, int G_, int c_) { nM = M / BM; nN = N / BM; nwg = nM * nN; G = G_; c = c_; }
    __host__ __device__ bool next(int i, Unit& u) const {
        const long L = (long)i * G + c; if (L >= nwg) return false;
        int wgid = (int)L; { const int q = nwg / NXCD, r = nwg % NXCD, xcd = wgid % NXCD, off = wgid / NXCD; wgid = (xcd < r ? xcd * (q + 1) : r * (q + 1) + (xcd - r) * q) + off; }
        const int nig = WGM * nN, gid = wgid / nig, fm = gid * WGM, gsz = (nM - fm) < WGM ? (nM - fm) : WGM;
        u.pm = fm + ((wgid % nig) % gsz); u.pn = (wgid % nig) / gsz; return true;
    }
    __device__ __forceinline__ void a_ready(const Unit&) const {}
    __device__ __forceinline__ void done(const Unit&) const {}
};
__device__ __forceinline__ unsigned cvt_pk_bf16(float lo, float hi) { unsigned r; asm volatile("v_cvt_pk_bf16_f32 %0, %1, %2" : "=v"(r) : "v"(lo), "v"(hi)); return r; }
typedef float f32x2 __attribute__((ext_vector_type(2)));
template <class Epi, class Sched, bool ALIGN_EPI = false, bool SP2 = false, bool DUAL = false>
__device__ __forceinline__ void gemm_phase(PG8_LAS unsigned char* lds, const Gemm g, const Sched& S, const Epi& E) {
    int tid = threadIdx.x; asm volatile("" : "+v"(tid));
    const int wid = __builtin_amdgcn_readfirstlane(tid >> 6), lane = tid & 63, wr = wid >> 2, wc = wid & 3, fr = lane & 15, fq = lane >> 4;
    const int K = g.K, HT = K / BK, nt = DUAL ? 2 * HT : HT;
    unsigned voffA[2], voffB[2];
#pragma unroll
    for (int i = 0; i < 2; ++i) { int R, C; stage_rc(tid * 16 + i * 8192, R, C); const int Rb = Epi::PERM ? ((R & ~31) + perm32(R & 31)) : R;
        voffA[i] = (unsigned)(R * K + C) * 2u; voffB[i] = (unsigned)(Rb * K + C) * 2u; }
    const size_t kstep = (size_t)(BK * 2);
    const size_t hstep = (size_t)HALF * K * 2;
    const size_t tstep = 2 * hstep;
    const unsigned ldsw = (unsigned)wid * 1024u;
    const int aoff = lds_byte(wr * 64 + fr, fq * 8), boff = lds_byte(wc * 32 + fr, fq * 8);
#define PG8_SA(b, h) (((b) * 2 + (h)) * HTB)
#define PG8_SB(b, h) ((4 + (b) * 2 + (h)) * HTB)
#define PG8_STAGE(bufoff, gbase, voff) do { _Pragma("unroll") for (int _i = 0; _i < 2; ++_i) \
        __builtin_amdgcn_global_load_lds((const unsigned*)((const char*)(gbase) + (voff)[_i]), (PG8_LAS unsigned*)(lds + (bufoff) + ldsw + _i * 8192), 16, 0, 0); } while (0)
#define PG8_LDA(dst, b, h) do { _Pragma("unroll") for (int m = 0; m < 4; ++m) _Pragma("unroll") for (int k = 0; k < 2; ++k) dst[m][k] = *(const PG8_LAS bf16x8*)(lds + PG8_SA(b, h) + aoff + m * 2048 + k * 1024); } while (0)
#define PG8_LDB(dst, b, h) do { _Pragma("unroll") for (int n = 0; n < 2; ++n) _Pragma("unroll") for (int k = 0; k < 2; ++k) dst[n][k] = *(const PG8_LAS bf16x8*)(lds + PG8_SB(b, h) + boff + n * 2048 + k * 1024); } while (0)
#define PG8_MMA(ai, bj, At, Bt) do { __builtin_amdgcn_s_setprio(1); _Pragma("unroll") for (int m = 0; m < 4; ++m) _Pragma("unroll") for (int n = 0; n < 2; ++n) _Pragma("unroll") for (int k = 0; k < 2; ++k) \
        acc[ai][bj][m][n] = __builtin_amdgcn_mfma_f32_16x16x32_bf16(Bt[n][k], At[m][k], acc[ai][bj][m][n], 0, 0, 0); __builtin_amdgcn_s_setprio(0); } while (0)
#define PG8_WAIT_V(n) asm volatile("s_waitcnt vmcnt(" #n ")" ::: "memory")
#define PG8_WAIT_L(n) asm volatile("s_waitcnt lgkmcnt(" #n ")" ::: "memory")
#define PG8_BAR __builtin_amdgcn_s_barrier()
#define PG8_SCHED __builtin_amdgcn_sched_barrier(0)
    Unit cur, nxt; int ui = 0;
    if (!S.next(0, cur)) return;
    f32x4 acc[2][2][4][2];
#pragma unroll
    for (int a = 0; a < 2; ++a)
#pragma unroll
        for (int b = 0; b < 2; ++b)
#pragma unroll
            for (int m = 0; m < 4; ++m)
#pragma unroll
                for (int n = 0; n < 2; ++n) acc[a][b][m][n] = (f32x4){0.f, 0.f, 0.f, 0.f};
    bf16x8 At[4][2], B0[2][2], B1[2][2];
    const char* cA = (const char*)g.A + (size_t)cur.pm * tstep; const char* cB = (const char*)g.Bt + (size_t)cur.pn * tstep;
    S.a_ready(cur);
    if constexpr (SP2) {
        PG8_STAGE(PG8_SB(0, 0), cB, voffB); PG8_STAGE(PG8_SB(0, 1), cB + hstep, voffB); PG8_STAGE(PG8_SA(0, 0), cA, voffA); PG8_STAGE(PG8_SA(0, 1), cA + hstep, voffA);
        if (wr == 1) PG8_BAR;
        PG8_WAIT_V(2); PG8_BAR;
        PG8_STAGE(PG8_SB(1, 0), cB + kstep, voffB); PG8_STAGE(PG8_SA(1, 0), cA + kstep, voffA); PG8_STAGE(PG8_SB(1, 1), cB + hstep + kstep, voffB);
        PG8_WAIT_V(6); PG8_BAR;
    } else {
        PG8_STAGE(PG8_SB(0, 0), cB, voffB); PG8_STAGE(PG8_SA(0, 0), cA, voffA); PG8_STAGE(PG8_SB(0, 1), cB + hstep, voffB); PG8_STAGE(PG8_SA(0, 1), cA + hstep, voffA);
        if (wr == 1) PG8_BAR;
        PG8_WAIT_V(4); PG8_BAR;
        PG8_STAGE(PG8_SB(1, 0), cB + kstep, voffB); PG8_STAGE(PG8_SA(1, 0), cA + kstep, voffA); PG8_STAGE(PG8_SB(1, 1), cB + hstep + kstep, voffB);
        PG8_WAIT_V(6); PG8_BAR;
    }
    for (;;) {
        const bool has_next = S.next(ui + 1, nxt);
        const char* cA2 = DUAL ? (const char*)g.A2 + (size_t)cur.pm * tstep - (size_t)HT * kstep : cA; const char* cB2 = DUAL ? (const char*)g.Bt2 + (size_t)cur.pn * tstep - (size_t)HT * kstep : cB;
        const char* nA = has_next ? (const char*)g.A + (size_t)nxt.pm * tstep : cA; const char* nB = has_next ? (const char*)g.Bt + (size_t)nxt.pn * tstep : cB;
        for (int t = 0; t < nt; t += 2) {
            const bool last = (t == nt - 2);
            const char* bA0 = (DUAL && t >= HT) ? cA2 : cA; const char* bA2 = (DUAL && t + 2 >= HT) ? cA2 : cA; const char* bB2 = (DUAL && t + 2 >= HT) ? cB2 : cB;
            if constexpr (DUAL) { if (t == HT) E.mid(acc, cur, wr, wc, fr, fq); }
            const char* a1 = bA0 + (size_t)(t + 1) * kstep;
            const char* a2 = last ? nA : bA2 + (size_t)(t + 2) * kstep; const char* b2 = last ? nB : bB2 + (size_t)(t + 2) * kstep;
            const char* a3 = a2 + kstep; const char* b3 = b2 + kstep;
            if (last && has_next) S.a_ready(nxt);
            if constexpr (SP2) {
            PG8_LDB(B0, 0, 0); PG8_LDB(B1, 0, 1); PG8_SCHED; PG8_LDA(At, 0, 0); PG8_STAGE(PG8_SA(1, 1), a1 + hstep, voffA);
            PG8_WAIT_V(8); PG8_WAIT_L(0); PG8_BAR; PG8_MMA(0, 0, At, B0); PG8_MMA(0, 1, At, B1); PG8_BAR; PG8_SCHED;
            PG8_LDA(At, 0, 1); PG8_STAGE(PG8_SB(0, 0), b2, voffB); PG8_STAGE(PG8_SB(0, 1), b2 + hstep, voffB); PG8_STAGE(PG8_SA(0, 0), a2, voffA);
            PG8_WAIT_V(8); PG8_WAIT_L(0); PG8_BAR; PG8_MMA(1, 0, At, B0); PG8_MMA(1, 1, At, B1); PG8_BAR; PG8_SCHED;
            PG8_LDB(B0, 1, 0); PG8_LDB(B1, 1, 1); PG8_SCHED; PG8_LDA(At, 1, 0); PG8_STAGE(PG8_SA(0, 1), a2 + hstep, voffA);
            PG8_WAIT_V(8); PG8_WAIT_L(0); PG8_BAR; PG8_MMA(0, 0, At, B0); PG8_MMA(0, 1, At, B1); PG8_BAR; PG8_SCHED;
            PG8_LDA(At, 1, 1); PG8_STAGE(PG8_SB(1, 0), b3, voffB); PG8_STAGE(PG8_SB(1, 1), b3 + hstep, voffB); PG8_STAGE(PG8_SA(1, 0), a3, voffA);
            PG8_WAIT_V(8); PG8_WAIT_L(0); PG8_BAR; PG8_MMA(1, 0, At, B0); PG8_MMA(1, 1, At, B1); PG8_BAR; PG8_SCHED;
            } else {
            PG8_LDB(B0, 0, 0); PG8_SCHED; PG8_LDA(At, 0, 0); PG8_STAGE(PG8_SA(1, 1), a1 + hstep, voffA);
            PG8_WAIT_L(8); PG8_BAR; PG8_WAIT_L(0); PG8_MMA(0, 0, At, B0); PG8_BAR; PG8_SCHED;
            PG8_LDB(B1, 0, 1); PG8_STAGE(PG8_SB(0, 0), b2, voffB);
            PG8_BAR; PG8_WAIT_L(0); PG8_MMA(0, 1, At, B1); PG8_BAR;
            PG8_LDA(At, 0, 1); PG8_STAGE(PG8_SA(0, 0), a2, voffA);
            PG8_BAR; PG8_WAIT_L(0); PG8_MMA(1, 0, At, B0); PG8_BAR; PG8_SCHED;
            PG8_STAGE(PG8_SB(0, 1), b2 + hstep, voffB);
            PG8_WAIT_V(6); PG8_BAR; PG8_MMA(1, 1, At, B1); PG8_BAR;
            PG8_LDB(B0, 1, 0); PG8_SCHED; PG8_LDA(At, 1, 0); PG8_STAGE(PG8_SA(0, 1), a2 + hstep, voffA);
            PG8_WAIT_L(8); PG8_BAR; PG8_WAIT_L(0); PG8_MMA(0, 0, At, B0); PG8_BAR; PG8_SCHED;
            PG8_LDB(B1, 1, 1); PG8_STAGE(PG8_SB(1, 0), b3, voffB);
            PG8_BAR; PG8_WAIT_L(0); PG8_MMA(0, 1, At, B1); PG8_BAR;
            PG8_LDA(At, 1, 1); PG8_STAGE(PG8_SA(1, 0), a3, voffA);
            PG8_BAR; PG8_WAIT_L(0); PG8_MMA(1, 0, At, B0); PG8_BAR; PG8_SCHED;
            PG8_STAGE(PG8_SB(1, 1), b3 + hstep, voffB);
            PG8_WAIT_V(6); PG8_BAR; PG8_MMA(1, 1, At, B1); PG8_BAR;
            }
        }
        if constexpr (ALIGN_EPI) { if (wr == 0) PG8_BAR; }
        if constexpr (!Epi::AFTER_DRAIN) { E(acc, cur, wr, wc, fr, fq); S.done(cur); }
        if (!has_next) break;
#pragma unroll
        for (int a = 0; a < 2; ++a)
#pragma unroll
            for (int b = 0; b < 2; ++b)
#pragma unroll
                for (int m = 0; m < 4; ++m)
#pragma unroll
                    for (int n = 0; n < 2; ++n) acc[a][b][m][n] = (f32x4){0.f, 0.f, 0.f, 0.f};
        cur = nxt; cA = nA; cB = nB; ++ui;
        if constexpr (ALIGN_EPI) { if (wr == 1) PG8_BAR; }
    }
    PG8_WAIT_V(0);
    if constexpr (!ALIGN_EPI) { if (wr == 0) PG8_BAR; }
    PG8_BAR;
    if constexpr (Epi::AFTER_DRAIN) { E.fused(acc, cur, wr, wc, fr, fq, lds, wid, lane); S.done(cur); }
#undef PG8_SA
#undef PG8_SB
#undef PG8_STAGE
#undef PG8_LDA
#undef PG8_LDB
#undef PG8_MMA
#undef PG8_WAIT_V
#undef PG8_WAIT_L
#undef PG8_BAR
#undef PG8_SCHED
}
}
namespace fa {
constexpr int D = 128; constexpr bool WSKIP = false; constexpr float THR = 8.f;
constexpr float SCALE = 0.08838834764831845f;
constexpr int NW = 8, QBLK = 32, KVBLK = 64, QB = NW * QBLK;
constexpr int SHM_V = KVBLK * D * 2, SHM_K = KVBLK * D * 2;
constexpr int LDS_BYTES = 2 * SHM_V + 2 * SHM_K + NW * 64 * 4;
constexpr int KB_OFF = LDS_BYTES;
constexpr int FA_LDS_BYTES = LDS_BYTES + 2 * 2048 * 4;
__device__ __forceinline__ void load_kbias(const float* CB, int P0, float* dst) {
    const float c0 = CB[P0]; const float inv = 1.0f / SCALE;
    for (int s = threadIdx.x; s < P0 + QB; s += 512) dst[s] = (c0 - CB[s]) * inv;
}
using bf16 = __hip_bfloat16;
typedef short bf16x8 __attribute__((ext_vector_type(8)));
typedef short s16x4 __attribute__((ext_vector_type(4)));
typedef float f32x16 __attribute__((ext_vector_type(16)));
typedef float f32x4 __attribute__((ext_vector_type(4)));
typedef unsigned u32x4 __attribute__((ext_vector_type(4)));
template <class A, class Bt> struct same_t { static constexpr bool v = false; };
template <class A> struct same_t<A, A> { static constexpr bool v = true; };

#define KSWZ(row, colB) ((row) * 256 + ((colB) ^ (((row) & 7) << 4)))
#define SBAR() __builtin_amdgcn_sched_barrier(0)
__device__ __forceinline__ int v_st(int k, int c) { const int kk = (k & ~0xC) | ((k & 4) << 1) | ((k & 8) >> 1); return ((kk >> 3) * 4 + (c >> 5)) * 512 + ((kk & 7) * 32 + (c & 31)) * 2; }
__device__ __forceinline__ int v_rd_base(int lane) { return ((lane & 3) << 3) | (((lane >> 2) & 3) << 6) | (((lane >> 4) & 1) << 5) | (((lane >> 5) & 1) << 8); }
constexpr int v_rd_off(int d0, int ks, int half) { return d0 * 512 + ks * 4096 + half * 2048; }
__device__ __forceinline__ int crow(int r, int hi) { return (r & 3) + 8 * (r >> 2) + 4 * hi; }
__device__ __forceinline__ unsigned cvtpk(float lo, float hi) {
    unsigned r; asm volatile("v_cvt_pk_bf16_f32 %0, %1, %2" : "=v"(r) : "v"(lo), "v"(hi)); return r;
}
__device__ __forceinline__ bf16x8 pack8(f32x4 a, f32x4 b) {
    u32x4 w = {cvtpk(a[0], a[1]), cvtpk(a[2], a[3]), cvtpk(b[0], b[1]), cvtpk(b[2], b[3])};
    return *reinterpret_cast<bf16x8*>(&w);
}
template <class T> __device__ __forceinline__ bf16x8 load8(const T* p) {
    if constexpr (same_t<T, float>::v) { return pack8(*(const f32x4*)p, *(const f32x4*)(p + 4)); }
    else { return *reinterpret_cast<const bf16x8*>(p); }
}
__device__ __forceinline__ void mask_tile(f32x16& p0, f32x16& p1, int dq, unsigned W) {
    const float NEG = -__builtin_inff();
#pragma unroll
    for (int r = 0; r < 16; ++r) {
        const int c = (r & 3) + 8 * (r >> 2);
        if ((unsigned)(dq - c) >= W) p0[r] = NEG;
        if ((unsigned)(dq - c - 32) >= W) p1[r] = NEG;
    }
}
__device__ __forceinline__ void partialSM(f32x16& p0, f32x16& p1, float& m_reg, float& mn, float& alpha) {
    float pmax = p0[0]; for (int r = 1; r < 16; ++r) pmax = fmaxf(pmax, p0[r]); for (int r = 0; r < 16; ++r) pmax = fmaxf(pmax, p1[r]);
    { auto rr = __builtin_amdgcn_permlane32_swap(__float_as_uint(pmax), __float_as_uint(pmax), false, false);
      pmax = fmaxf(__uint_as_float(rr[0]), __uint_as_float(rr[1])); }
    constexpr float C2 = 1.4426950408889634f * SCALE;
    if (__builtin_expect(__all((pmax - m_reg) * SCALE <= THR), 1)) { mn = m_reg; alpha = 1.f; }
    else { mn = fmaxf(m_reg, pmax); alpha = __builtin_amdgcn_exp2f((m_reg - mn) * C2); m_reg = mn; }
    const float mnL = -mn * C2;
    for (int r = 0; r < 16; ++r) p0[r] = fmaf(p0[r], C2, mnL); for (int r = 0; r < 16; ++r) p1[r] = fmaf(p1[r], C2, mnL);
    for (int r = 0; r < 16; ++r) p0[r] = __builtin_amdgcn_exp2f(p0[r]);
}
__device__ __forceinline__ void finishSM(f32x16& p0, f32x16& p1, float alpha, float& l_reg, bf16x8& pa0, bf16x8& pa1, bf16x8& pa2, bf16x8& pa3) {
    for (int r = 0; r < 16; ++r) p1[r] = __builtin_amdgcn_exp2f(p1[r]);
    float ps = 0; for (int r = 0; r < 16; ++r) ps += p0[r]; for (int r = 0; r < 16; ++r) ps += p1[r];
    { auto rr = __builtin_amdgcn_permlane32_swap(__float_as_uint(ps), __float_as_uint(ps), false, false);
      ps = __uint_as_float(rr[0]) + __uint_as_float(rr[1]); }
    l_reg = l_reg * alpha + ps;
#define PK4(P, B_, OUT) do { unsigned a0 = cvtpk(P[B_+0], P[B_+1]), a1 = cvtpk(P[B_+2], P[B_+3]);                          \
        unsigned b0 = cvtpk(P[B_+4], P[B_+5]), b1 = cvtpk(P[B_+6], P[B_+7]);                                             \
        auto r0 = __builtin_amdgcn_permlane32_swap(a0, b0, false, false); auto r1 = __builtin_amdgcn_permlane32_swap(a1, b1, false, false); \
        u32x4 w = {r0[0], r1[0], r0[1], r1[1]}; OUT = *reinterpret_cast<bf16x8*>(&w); } while (0)
    PK4(p0, 0, pa0); PK4(p0, 8, pa1); PK4(p1, 0, pa2); PK4(p1, 8, pa3);
#undef PK4
}
template <int KB, bool SK>
__device__ __forceinline__ void qkt(f32x16& p0, f32x16& p1, const char* K_lds, int r32, int hi, const bf16x8* qr, bool act, const float* kbp) {
    if (SK && !act) { const float NEG = -__builtin_inff();
#pragma unroll
        for (int r = 0; r < 16; ++r) { p0[r] = NEG; p1[r] = NEG; } return; }
    p0 = f32x16{}; p1 = f32x16{};
    const char* kb[4];
#pragma unroll
    for (int dd = 0; dd < 4; ++dd) kb[dd] = K_lds + KB * SHM_K + KSWZ(r32, (dd * 16 + hi * 8) * 2);
#pragma unroll
    for (int d0 = 0; d0 < 8; ++d0) { const char* a = kb[d0 & 3] + (d0 >> 2) * 128;
        bf16x8 b0 = *reinterpret_cast<const bf16x8*>(a);
        bf16x8 b1 = *reinterpret_cast<const bf16x8*>(a + 32 * 256);
        p0 = __builtin_amdgcn_mfma_f32_32x32x16_bf16(b0, qr[d0], p0, 0, 0, 0);
        p1 = __builtin_amdgcn_mfma_f32_32x32x16_bf16(b1, qr[d0], p1, 0, 0, 0); }
    {
        const float c0_ = hi ? 0.f : kbp[r32], c1_ = hi ? 0.f : kbp[32 + r32];
        const unsigned hp = cvtpk(c0_, c1_); const float r0_ = c0_ - __uint_as_float(hp << 16), r1_ = c1_ - __uint_as_float(hp & 0xffff0000u);
        const unsigned mp = cvtpk(r0_, r1_); const unsigned lp = cvtpk(r0_ - __uint_as_float(mp << 16), r1_ - __uint_as_float(mp & 0xffff0000u));
        u32x4 k0_ = {(hp & 0xffffu) | (mp << 16), lp & 0xffffu, 0u, 0u}, k1_ = {(hp >> 16) | (mp & 0xffff0000u), lp >> 16, 0u, 0u};
        const u32x4 q1_ = {0x3F803F80u, 0x00003F80u, 0u, 0u};
        p0 = __builtin_amdgcn_mfma_f32_32x32x16_bf16(*reinterpret_cast<bf16x8*>(&k0_), *reinterpret_cast<const bf16x8*>(&q1_), p0, 0, 0, 0);
        p1 = __builtin_amdgcn_mfma_f32_32x32x16_bf16(*reinterpret_cast<bf16x8*>(&k1_), *reinterpret_cast<const bf16x8*>(&q1_), p1, 0, 0, 0); }
}
template <int VB, bool SK>
__device__ __forceinline__ void pv_tile(f32x16* o, int vb0, bf16x8 pa0, bf16x8 pa1, bf16x8 pa2, bf16x8 pa3, bool act) {
    if (SK && !act) return;
#define TRRD(dst, off) asm volatile("ds_read_b64_tr_b16 %0, %1 offset:%2" : "=&v"(dst) : "v"(vb0), "i"(off) : "memory")
#define PV_D0(d0) do { s16x4 l0, l1, l2, l3, h0, h1, h2, h3; constexpr int b_ = VB * SHM_V + v_rd_off(d0, 0, 0);     \
        TRRD(l0, b_); TRRD(h0, b_ + 2048); TRRD(l1, b_ + 4096); TRRD(h1, b_ + 6144); TRRD(l2, b_ + 8192); TRRD(h2, b_ + 10240); TRRD(l3, b_ + 12288); TRRD(h3, b_ + 14336); \
        asm volatile("s_waitcnt lgkmcnt(0)" ::: "memory"); SBAR();                 \
        o[d0] = __builtin_amdgcn_mfma_f32_32x32x16_bf16(pa0, (bf16x8){l0[0], l0[1], l0[2], l0[3], h0[0], h0[1], h0[2], h0[3]}, o[d0], 0, 0, 0);   \
        o[d0] = __builtin_amdgcn_mfma_f32_32x32x16_bf16(pa1, (bf16x8){l1[0], l1[1], l1[2], l1[3], h1[0], h1[1], h1[2], h1[3]}, o[d0], 0, 0, 0);   \
        o[d0] = __builtin_amdgcn_mfma_f32_32x32x16_bf16(pa2, (bf16x8){l2[0], l2[1], l2[2], l2[3], h2[0], h2[1], h2[2], h2[3]}, o[d0], 0, 0, 0);   \
        o[d0] = __builtin_amdgcn_mfma_f32_32x32x16_bf16(pa3, (bf16x8){l3[0], l3[1], l3[2], l3[3], h3[0], h3[1], h3[2], h3[3]}, o[d0], 0, 0, 0); } while (0)
    PV_D0(0); PV_D0(1); PV_D0(2); PV_D0(3);
#undef PV_D0
#undef TRRD
}
template <class TIn, class TOut> struct BlockRef { const TIn* Q; const TIn* K; const TIn* V; TOut* O; const TOut* SG; const float* CB; int P0; };
template <class TIn> struct Seam {
    bf16x8 qr[8];
    bf16x8 st_v0, st_v1, st_k0, st_k1; f32x4 sf0, sf1, sf2, sf3;
    int kbsel;
};
__device__ __forceinline__ int swa_jlo(int P0, int W) { const int lowk = P0 - W + 1; return lowk > 0 ? lowk / KVBLK : 0; }
#define ROW(p, k0, rr) ((p) + (size_t)((k0) + (rr)) * D + sc)
#define VMW() asm volatile("s_waitcnt vmcnt(0)" ::: "memory")
#define VMWN(n) asm volatile("s_waitcnt vmcnt(%0)" :: "i"(n) : "memory")
#define ROWK(p, k0, rr) ((p) + (size_t)((k0) + (rr)) * KP + sc)
#define ROWV(p, k0, rr) ((p) + (size_t)((k0) + (rr)) * VP + sc)
#define SLOAD_H(Kp, Vp, k0) do { S.st_v0 = load8<TIn>(ROWV(Vp, k0, sr)); S.st_v1 = load8<TIn>(ROWV(Vp, k0, 32 + sr));              \
                         S.st_k0 = load8<TIn>(ROWK(Kp, k0, sr)); S.st_k1 = load8<TIn>(ROWK(Kp, k0, 32 + sr)); } while (0)
#define SWRITE_HK(bf) do { *(bf16x8*)(K_lds + (bf) * SHM_K + kws) = S.st_k0; *(bf16x8*)(K_lds + (bf) * SHM_K + kws + 32 * 256) = S.st_k1; } while (0)
#define SWRITE_HV(bf) do { *(bf16x8*)(V_lds + (bf) * SHM_V + vst0) = S.st_v0; *(bf16x8*)(V_lds + (bf) * SHM_V + vst1) = S.st_v1; } while (0)
#define SWRITE_H(bf) do { SWRITE_HV(bf); SWRITE_HK(bf); } while (0)
#define SLOAD_F(p, k0) do { S.sf0 = *(const f32x4*)ROW(p, k0, sr); S.sf1 = *(const f32x4*)(ROW(p, k0, sr) + 4);                \
                            S.sf2 = *(const f32x4*)ROW(p, k0, 32 + sr); S.sf3 = *(const f32x4*)(ROW(p, k0, 32 + sr) + 4); } while (0)
#define SWRITE_KF(bf) do { *(bf16x8*)(K_lds + (bf) * SHM_K + kws) = pack8(S.sf0, S.sf1); *(bf16x8*)(K_lds + (bf) * SHM_K + kws + 32 * 256) = pack8(S.sf2, S.sf3); } while (0)
#define SWRITE_VF(bf) do { *(bf16x8*)(V_lds + (bf) * SHM_V + vst0) = pack8(S.sf0, S.sf1); *(bf16x8*)(V_lds + (bf) * SHM_V + vst1) = pack8(S.sf2, S.sf3); } while (0)
template <class TIn, class TOut, int QP, int KP, int VP>
__device__ __forceinline__ void causal_swa_prime(const BlockRef<TIn, TOut>& cur, int W, char* lds, Seam<TIn>& S) {
    constexpr bool F32 = same_t<TIn, float>::v;
    int tid = threadIdx.x; asm volatile("" : "+v"(tid));
    const int wid = __builtin_amdgcn_readfirstlane(tid >> 6), lane = tid & 63, r32 = lane & 31, hi = lane >> 5;
    const int sr = tid >> 4, sc = (tid & 15) * 8, kws = KSWZ(sr, sc * 2); char* K_lds = lds + 2 * SHM_V;
    const int kb0 = swa_jlo(cur.P0, W) * KVBLK;
    for (int d0 = 0; d0 < 8; ++d0) S.qr[d0] = load8<TIn>(cur.Q + (size_t)(wid * QBLK + r32) * QP + d0 * 16 + hi * 8);
    if constexpr (F32) { SLOAD_F((const float*)cur.K, kb0); VMW(); SWRITE_KF(0); SBAR(); SLOAD_F((const float*)cur.V, kb0); }
    else { SLOAD_H(cur.K, cur.V, kb0); VMW(); SWRITE_HK(0); }
    load_kbias(cur.CB, cur.P0, (float*)(lds + KB_OFF)); S.kbsel = 0;
    __syncthreads();
}
template <class TIn, class TOut, int QP, int KP, int VP>
__device__ __forceinline__ void causal_swa_block(const BlockRef<TIn, TOut>& cur, const BlockRef<TIn, TOut>& nxt, int skv, int W, char* lds, Seam<TIn>& S) {
    constexpr bool F32 = same_t<TIn, float>::v;
    int tid = threadIdx.x; asm volatile("" : "+v"(tid));
    const int wid = __builtin_amdgcn_readfirstlane(tid >> 6), lane = tid & 63, r32 = lane & 31, hi = lane >> 5;
    const int j_lo = swa_jlo(cur.P0, W);
    int j_hi = (cur.P0 + QB - 1) / KVBLK + 1; if (j_hi > skv / KVBLK) j_hi = skv / KVBLK;
    const int NT = j_hi - j_lo;
    const int kbn = swa_jlo(nxt.P0, W) * KVBLK;
    const int qlo = cur.P0 + wid * QBLK, qm = qlo + r32 - 4 * hi;
    char* V_lds = lds; char* K_lds = lds + 2 * SHM_V; const float* kbl = (const float*)(lds + KB_OFF) + S.kbsel * 2048;
    float* ws = (float*)(lds + 2 * SHM_V + 2 * SHM_K) + wid * 64; float* li_l = ws, * al_l = ws + 32;
    float m_reg = -1e30f, l_reg = 0; f32x16 o[4] = {};
    const int sr = tid >> 4, sc = (tid & 15) * 8, vst0 = v_st(sr, sc), vst1 = v_st(32 + sr, sc), kws = KSWZ(sr, sc * 2);
    const int vb0 = (int)(uintptr_t)V_lds + v_rd_base(lane);
    const TIn* Kh = cur.K; const TIn* Vh = cur.V;
#define RESC(a) do { if (__any((a) < 1.f)) { if (hi == 0) al_l[r32] = (a); asm volatile("s_waitcnt lgkmcnt(0)" ::: "memory");              \
                     for (int d_ = 0; d_ < 4; ++d_) for (int r = 0; r < 16; ++r) o[d_][r] *= al_l[crow(r, hi)]; } } while (0)
#define KBASE(t) ((j_lo + (t)) * KVBLK)
#define KBP(t) (kbl + KBASE(t))
#define ACT(t) (KBASE(t) <= qlo + QBLK - 1 && KBASE(t) + KVBLK - 1 >= qlo - W + 1)
#define MASKT(P0_, P1_, t) do { const int kb_ = KBASE(t); if ((!SK || ACT(t)) && (kb_ + KVBLK - 1 > qlo || kb_ <= qlo + QBLK - 1 - W)) mask_tile(P0_, P1_, qm - kb_, (unsigned)W); } while (0)
    constexpr int NQL = F32 ? 16 : 8;
    constexpr bool SK = WSKIP && !F32;
#define SEAM_K0() do { VMWN(NQL); if constexpr (F32) { SWRITE_KF(0); SBAR(); SLOAD_F((const float*)nxt.V, kbn); } else { SWRITE_HK(0); } SBAR(); } while (0)
    f32x16 pA0, pA1, pB0, pB1; float mnA, mnB, alA, alB; bf16x8 pa0, pa1, pa2, pa3;
    if constexpr (F32) { VMW(); SWRITE_VF(0); SBAR(); } else { SWRITE_HV(0); SBAR(); }
    if (NT > 1) { if constexpr (F32) SLOAD_F((const float*)Kh, KBASE(1)); else SLOAD_H(Kh, Vh, KBASE(1)); }
    SBAR(); qkt<0, SK>(pA0, pA1, K_lds, r32, hi, S.qr, ACT(0), KBP(0));
    if constexpr (F32) { if (NT > 1) { VMW(); SWRITE_KF(1); SBAR(); SLOAD_F((const float*)Vh, KBASE(1)); } }
    MASKT(pA0, pA1, 0); partialSM(pA0, pA1, m_reg, mnA, alA);
    if (NT > 1) { VMW(); if constexpr (F32) { SWRITE_VF(1); SBAR(); if (NT > 2) SLOAD_F((const float*)Kh, KBASE(2)); } else SWRITE_H(1); }
    __syncthreads();
#define HALF_STEP(PX0, PX1, mnX, alX, PY0, PY1, alY, t, KB, VB, SB) do {                                                      \
        SBAR(); qkt<KB, SK>(PX0, PX1, K_lds, r32, hi, S.qr, ACT(t), KBP(t));                                             \
        finishSM(PY0, PY1, alY, l_reg, pa0, pa1, pa2, pa3); SBAR();                                                           \
        if ((t) + 1 < NT) { if constexpr (F32) { VMW(); SWRITE_KF(SB); SBAR(); SLOAD_F((const float*)Vh, KBASE((t) + 1)); }  \
                            else { SLOAD_H(Kh, Vh, KBASE((t) + 1)); } SBAR(); }                                               \
        pv_tile<VB, SK>(o, vb0, pa0, pa1, pa2, pa3, ACT((t) - 1)); MASKT(PX0, PX1, (t)); partialSM(PX0, PX1, m_reg, mnX, alX);                                        \
        __syncthreads();                                                                                                      \
        if ((t) + 1 < NT) { VMW(); if constexpr (F32) { SWRITE_VF(SB); SBAR(); if ((t) + 2 < NT) SLOAD_F((const float*)Kh, KBASE((t) + 2)); } \
                            else { SWRITE_H(SB); } }                                                                          \
        RESC(alX); __syncthreads(); } while (0)
    for (int t = 1; t + 1 < NT; t += 2) {
        HALF_STEP(pB0, pB1, mnB, alB, pA0, pA1, alA, t, 1, 0, 0);
        HALF_STEP(pA0, pA1, mnA, alA, pB0, pB1, alB, t + 1, 0, 1, 1);
    }
    const bool even = (NT & 1) == 0;
    if (even) { SBAR(); qkt<1, SK>(pB0, pB1, K_lds, r32, hi, S.qr, ACT(NT - 1), KBP(NT - 1)); SBAR(); }
#define QROW(e) (nxt.Q + (size_t)(wid * QBLK + r32) * D + ((e) >> 1) * 16 + hi * 8 + ((e) & 1) * 4)
    if constexpr (F32) { SLOAD_F((const float*)nxt.K, kbn); SBAR();
#pragma unroll
        for (int e = 0; e < 8; ++e) (void)0; }
    else { SLOAD_H(nxt.K, nxt.V, kbn); SBAR();
#pragma unroll
        for (int d0 = 0; d0 < 8; ++d0) S.qr[d0] = load8<TIn>(nxt.Q + (size_t)(wid * QBLK + r32) * QP + d0 * 16 + hi * 8); }
    SBAR();
    finishSM(pA0, pA1, alA, l_reg, pa0, pa1, pa2, pa3); SBAR();
    if constexpr (F32) {
#pragma unroll
        for (int e = 8; e < 16; ++e) (void)0; SBAR(); }
#undef QROW
    pv_tile<0, SK>(o, vb0, pa0, pa1, pa2, pa3, ACT(even ? NT - 2 : NT - 1));
    if (even) { MASKT(pB0, pB1, NT - 1); partialSM(pB0, pB1, m_reg, mnB, alB); __syncthreads(); RESC(alB);
        finishSM(pB0, pB1, alB, l_reg, pa0, pa1, pa2, pa3); SBAR(); pv_tile<1, SK>(o, vb0, pa0, pa1, pa2, pa3, ACT(NT - 1)); }
    SBAR(); SEAM_K0();
    if (hi == 0) li_l[r32] = l_reg; asm volatile("s_waitcnt lgkmcnt(0)" ::: "memory");
    float rli[16];
#pragma unroll
    for (int r = 0; r < 16; ++r) rli[r] = __builtin_amdgcn_rcpf(li_l[crow(r, hi)]);
    TOut* Ow = cur.O + (size_t)(wid * QBLK) * QP; const TOut* SGw = cur.SG + (size_t)(wid * QBLK) * VP;
#pragma unroll
    for (int r = 0; r < 16; ++r) { const int orow = crow(r, hi);
#pragma unroll
        for (int d0 = 0; d0 < 4; ++d0) { const float v = o[d0][r] * rli[r] * __bfloat162float(SGw[(size_t)orow * VP + d0 * 32 + r32]);
            if constexpr (same_t<TOut, float>::v) { Ow[(size_t)orow * QP + d0 * 32 + r32] = v; }
            else { const float vn = __shfl_xor(v, 1);
                   if ((r32 & 1) == 0) *(unsigned*)(Ow + (size_t)orow * QP + d0 * 32 + r32) = cvtpk(v, vn); } } }
    if constexpr (F32) {
#pragma unroll
        for (int d0 = 0; d0 < 8; ++d0) (void)0; }
    load_kbias(nxt.CB, nxt.P0, (float*)(lds + KB_OFF) + (S.kbsel ^ 1) * 2048);
    __syncthreads();
    S.kbsel ^= 1;
#undef RESC
#undef KBASE
#undef KBP
#undef ACT
#undef MASKT
#undef SEAM_K0
#undef HALF_STEP
}
#undef ROW
#undef VMW
#undef VMWN
#undef SLOAD_H
#undef SWRITE_HK
#undef SWRITE_HV
#undef SWRITE_H
#undef SLOAD_F
#undef SWRITE_KF
#undef SWRITE_VF

}
#ifndef LAS
#define LAS __attribute__((address_space(3)))
#endif
#define RLX_AGENT __ATOMIC_RELAXED, __HIP_MEMORY_SCOPE_AGENT
#define XB_TMO      128
#define XB_XCNT(j)  (256  + 64 * (j))
#define XB_XSUB(j)  (1280 + 64 * (j))
#define XB_XGEN(j)  (2304 + 64 * (j))
#define XB_TOP      3328
#define XB_TOPGEN   3392
#define XCD_BAR_WORDS 3456
#define XB_SPIN_CAP (1u << 18)

__device__ __forceinline__ unsigned xb_ld(unsigned* p)              { return __hip_atomic_load(p, __ATOMIC_RELAXED, __HIP_MEMORY_SCOPE_AGENT); }
__device__ __forceinline__ unsigned xb_add(unsigned* p, unsigned v) { return __hip_atomic_fetch_add(p, v, __ATOMIC_RELAXED, __HIP_MEMORY_SCOPE_AGENT); }
__device__ __forceinline__ unsigned xb_xcc_id() { return (unsigned)__builtin_amdgcn_s_getreg((3 << 11) | 20) & 0xFu; }
#define XB_SPIN(cond, bar) do { unsigned _sp = 0; while (cond) { __builtin_amdgcn_s_sleep(1); \
    if ((++_sp & 255u) == 0u) { if (xb_ld(&(bar)[XB_TMO])) break; if (_sp > XB_SPIN_CAP) { atomicAdd(&(bar)[XB_TMO], 1u); break; } } } } while (0)

struct XcdBarrier {
    unsigned* bar; unsigned x;
    volatile LAS unsigned* st;
};

__device__ __forceinline__ XcdBarrier xcd_barrier_post(unsigned* bar, volatile LAS unsigned* st) {
    XcdBarrier b; b.bar = bar; b.x = xb_xcc_id(); b.st = st;
    if (threadIdx.x == 0) (void)xb_add(&bar[XB_XCNT(b.x)], 1u);
    return b;
}
__device__ __forceinline__ void xcd_barrier_complete(unsigned* bar, unsigned x, unsigned& nloc, unsigned& nx) {
    const unsigned G = gridDim.x * gridDim.y * gridDim.z;
    unsigned sum, cnt, mine, sp = 0u;
    for (;;) {
        sum = 0u; cnt = 0u; mine = 0u;
#pragma unroll
        for (unsigned j = 0; j < 16; ++j) { const unsigned c = xb_ld(&bar[XB_XCNT(j)]); sum += c; cnt += (c > 0u) ? 1u : 0u; mine = (j == x) ? c : mine; }
        if (sum == G) break;
        __builtin_amdgcn_s_sleep(1);
        if ((++sp & 255u) == 0u) { if (xb_ld(&bar[XB_TMO])) break; if (sp > XB_SPIN_CAP) { atomicAdd(&bar[XB_TMO], 1u); break; } }
    }
    nloc = mine > 0u ? mine : 1u; nx = cnt > 0u ? cnt : 1u;
}

__device__ __forceinline__ void xcd_barrier(const XcdBarrier& b) {
    asm volatile("s_waitcnt vmcnt(0)" ::: "memory");
    __syncthreads();
    if (threadIdx.x == 0) {
        unsigned* bar = b.bar;
        __builtin_amdgcn_s_waitcnt(0);
        unsigned nloc = b.st[0], nx = b.st[1];
        if (nloc == 0u) { xcd_barrier_complete(bar, b.x, nloc, nx); b.st[0] = nloc; b.st[1] = nx; }
        const unsigned old = xb_add(&bar[XB_XSUB(b.x)], 1u);
        const unsigned gen = old / nloc;
        if (old + 1u == (gen + 1u) * nloc) {
            __builtin_amdgcn_fence(__ATOMIC_RELEASE, "agent");
            asm volatile("s_waitcnt vmcnt(0)" ::: "memory");
            const unsigned og = xb_add(&bar[XB_TOP], 1u);
            const unsigned tg = og / nx;
            if (og + 1u == (tg + 1u) * nx) xb_add(&bar[XB_TOPGEN], 1u);
            else XB_SPIN(xb_ld(&bar[XB_TOPGEN]) == tg, bar);
            __builtin_amdgcn_fence(__ATOMIC_ACQUIRE, "agent");
            xb_add(&bar[XB_XGEN(b.x)], 1u);
            asm volatile("s_waitcnt vmcnt(0)" ::: "memory");
        } else {
            XB_SPIN(xb_ld(&bar[XB_XGEN(b.x)]) == gen, bar);
            __builtin_amdgcn_fence(__ATOMIC_ACQUIRE, "agent");
            asm volatile("s_waitcnt vmcnt(0)" ::: "memory");
        }
    }
    __syncthreads();
}
#ifndef LAS
#define LAS __attribute__((address_space(3)))
#endif
typedef unsigned short bf16_t;
typedef float f32x4 __attribute__((ext_vector_type(4)));
typedef float f32x2 __attribute__((ext_vector_type(2)));
typedef unsigned u32x4 __attribute__((ext_vector_type(4)));
typedef unsigned u32x2 __attribute__((ext_vector_type(2)));
constexpr int DM = 2048, NB = 4, SEQ = 2048, MT = NB * SEQ;
constexpr int DFF = 5632, NMOD = 12288;
constexpr int NBF = 8192, NF32 = 3584, NPROJ = NBF + NF32;
constexpr int PBP = NBF + 64;
constexpr float ALPHA = 1.189207115002721f, LN_EPS = 1e-5f, RMS_EPS = 1e-6f, LNX_EPS = 64e-5f;
constexpr size_t MiB = 1u << 20;
constexpr size_t WS_MOD = 0, WS_CUM = 1 * MiB, WS_PART = 2 * MiB, WS_BAR = 5 * MiB, WS_SLOT = 6 * MiB;
constexpr size_t WS_WOUT = 8 * MiB, WS_WA = 16 * MiB, WS_WB = 20 * MiB, WS_WLORA = 24 * MiB;
constexpr size_t WS_WIN = 28 * MiB;
constexpr size_t WS_ACAT = 60 * MiB, WS_ACAT2 = 363 * MiB, WS_MERGED = 235 * MiB;
constexpr int KSP = PBP / 2;
constexpr size_t WS_XN = 74 * MiB;
constexpr size_t WS_QN = 74 * MiB, WS_KN = 90 * MiB;
constexpr size_t WS_PBF = 106 * MiB;
constexpr size_t WS_PRW = 235 * MiB, WS_LF = 291 * MiB;
constexpr size_t WS_PF32 = 235 * MiB;
constexpr size_t WS_G = 347 * MiB, WS_YRAW = 299 * MiB, WS_WGU = 28 * MiB;
constexpr size_t WS_KK = 347 * MiB;
constexpr size_t WS_O = 379 * MiB;
constexpr size_t WS_WDOWN = 395 * MiB;
constexpr size_t WS_END = 417 * MiB;
constexpr int LDS_BYTES = 131072 + 64;

struct Params { const float* in[28]; float* out; unsigned char* ws; };

__device__ __forceinline__ unsigned f2bf(float f) { unsigned u = __builtin_bit_cast(unsigned, f); return (u + 0x7fffu + ((u >> 16) & 1u)) >> 16; }
__device__ __forceinline__ unsigned pk2(float lo, float hi) { return pg8::cvt_pk_bf16(lo, hi); }
__device__ __forceinline__ float bflo(unsigned w) { return __builtin_bit_cast(float, w << 16); }
__device__ __forceinline__ float bfhi(unsigned w) { return __builtin_bit_cast(float, w & 0xffff0000u); }
__device__ __forceinline__ f32x4 ld4bf(const bf16_t* p) { const u32x2 w = *(const u32x2*)p; return (f32x4){bflo(w.x), bfhi(w.x), bflo(w.y), bfhi(w.y)}; }
__device__ __forceinline__ float sigm(float x) { return __builtin_amdgcn_rcpf(1.f + __builtin_amdgcn_exp2f(-1.4426950408889634f * x)); }
__device__ __forceinline__ float wave_sum(float v) {
#pragma unroll
    for (int o = 1; o < 64; o <<= 1) v += __shfl_xor(v, o);
    return v;
}
template <int CTRL> __device__ __forceinline__ float dppf(float x) { return __builtin_bit_cast(float, __builtin_amdgcn_mov_dpp(__builtin_bit_cast(int, x), CTRL, 0xf, 0xf, true)); }
__device__ __forceinline__ float rowsum16(float v) { v += dppf<0xB1>(v); v += dppf<0x4E>(v); v += dppf<0x141>(v); v += dppf<0x128>(v); return v; }
#define LDS_WAIT() asm volatile("s_waitcnt lgkmcnt(0)" ::: "memory")

namespace pg8 {
__device__ __forceinline__ f32x4 sig4(f32x4 v) { f32x4 r; r[0] = sigm(v[0]); r[1] = sigm(v[1]); r[2] = sigm(v[2]); r[3] = sigm(v[3]); return r; }
__device__ __forceinline__ u32x4 pack8(f32x4 a, f32x4 b) { u32x4 w; w.x = cvt_pk_bf16(a[0], a[1]); w.y = cvt_pk_bf16(a[2], a[3]); w.z = cvt_pk_bf16(b[0], b[1]); w.w = cvt_pk_bf16(b[2], b[3]); return w; }
struct EpiProjBf { static constexpr bool PERM = true, AFTER_DRAIN = false; bf16_t* O;
    __device__ __forceinline__ void operator()(const f32x4 (&acc)[2][2][4][2], const Unit& u, int wr, int wc, int fr, int fq) const {
        const int row0 = u.pm * BM + wr * 64 + fr, col0 = u.pn * BM + wc * 32 + 8 * fq; const bool sg = u.pn >= 12;
#pragma unroll
        for (int ai = 0; ai < 2; ++ai)
#pragma unroll
            for (int m = 0; m < 4; ++m) { bf16_t* rowp = O + (size_t)(row0 + ai * HALF + m * 16) * PBP + col0;
#pragma unroll
                for (int bj = 0; bj < 2; ++bj) { f32x4 v0 = acc[ai][bj][m][0], v1 = acc[ai][bj][m][1];
                    if (sg) { v0 = sig4(v0); v1 = sig4(v1); }
                    *(u32x4*)(rowp + bj * HALF) = pack8(v0, v1); } }
    }
};
struct EpiF32 { static constexpr bool PERM = false, AFTER_DRAIN = false; float* O; int ldc;
    __device__ __forceinline__ void operator()(const f32x4 (&acc)[2][2][4][2], const Unit& u, int wr, int wc, int fr, int fq) const {
        const int row0 = u.pm * BM + wr * 64 + fr, col0 = u.pn * BM + wc * 32 + 4 * fq;
#pragma unroll
        for (int ai = 0; ai < 2; ++ai)
#pragma unroll
            for (int m = 0; m < 4; ++m) { float* rowp = O + (size_t)(row0 + ai * HALF + m * 16) * ldc + col0;
#pragma unroll
                for (int bj = 0; bj < 2; ++bj)
#pragma unroll
                    for (int n = 0; n < 2; ++n) *(f32x4*)(rowp + bj * HALF + n * 16) = acc[ai][bj][m][n]; }
    }
};
struct EpiRw { static constexpr bool PERM = false, AFTER_DRAIN = false; bf16_t* O; float* LF;
    __device__ __forceinline__ void operator()(const f32x4 (&acc)[2][2][4][2], const Unit& u, int wr, int wc, int fr, int fq) const {
        const int row0 = u.pm * BM + wr * 64 + fr, colt = wc * 32 + 4 * fq, col0 = u.pn * BM + colt; const bool last = u.pn == 13;
#pragma unroll
        for (int ai = 0; ai < 2; ++ai)
#pragma unroll
            for (int m = 0; m < 4; ++m) { const size_t row = (size_t)(row0 + ai * HALF + m * 16);
#pragma unroll
                for (int bj = 0; bj < 2; ++bj)
#pragma unroll
                    for (int n = 0; n < 2; ++n) { const f32x4 v = acc[ai][bj][m][n]; u32x2 w; w.x = cvt_pk_bf16(v[0], v[1]); w.y = cvt_pk_bf16(v[2], v[3]);
                        *(u32x2*)(O + row * NF32 + col0 + bj * HALF + n * 16) = w;
                        if (last) *(f32x4*)(LF + row * 256 + colt + bj * HALF + n * 16) = v; } }
    }
};
struct EpiLora { static constexpr bool PERM = false, AFTER_DRAIN = false;
    const float* w0; const float* a0; float* WD; float* AA; bf16_t* G; int pn0;
    __device__ __forceinline__ void operator()(const f32x4 (&acc)[2][2][4][2], const Unit& u, int wr, int wc, int fr, int fq) const {
        const int pnq = u.pn + pn0, sel = pnq >> 2; int row0 = u.pm * BM + wr * 64 + fr, cb = (pnq & 3) * BM + wc * 32 + 4 * fq;
        asm volatile("" : "+v"(row0), "+v"(cb));
#pragma unroll
        for (int bj = 0; bj < 2; ++bj)
#pragma unroll
            for (int n = 0; n < 2; ++n) { const int c = cb + bj * HALF + n * 16;
                if (sel == 0) { const f32x4 wv = *(const f32x4*)(w0 + c);
#pragma unroll
                    for (int ai = 0; ai < 2; ++ai)
#pragma unroll
                        for (int m = 0; m < 4; ++m) { const size_t off = (size_t)(row0 + ai * HALF + m * 16) * 1024 + c; f32x4 o;
#pragma unroll
                            for (int i = 0; i < 4; ++i) { const float x = wv[i] + acc[ai][bj][m][n][i];
                                const float wraw = fminf(x, 0.f) - __logf(1.f + __expf(-fabsf(x))) - 0.5f; o[i] = __expf(-__expf(wraw)); }
                            *(f32x4*)(WD + off) = o; }
                } else if (sel == 1) { const f32x4 av = *(const f32x4*)(a0 + c);
#pragma unroll
                    for (int ai = 0; ai < 2; ++ai)
#pragma unroll
                        for (int m = 0; m < 4; ++m) { const size_t off = (size_t)(row0 + ai * HALF + m * 16) * 1024 + c; f32x4 oa;
#pragma unroll
                            for (int i = 0; i < 4; ++i) oa[i] = sigm(av[i] + acc[ai][bj][m][n][i]);
                            *(f32x4*)(AA + off) = oa; }
                } else {
#pragma unroll
                    for (int ai = 0; ai < 2; ++ai)
#pragma unroll
                        for (int m = 0; m < 4; ++m) { const size_t off = (size_t)(row0 + ai * HALF + m * 16) * 1024 + c; const f32x4 v = acc[ai][bj][m][n];
                            u32x2 w; w.x = cvt_pk_bf16(v[0], v[1]); w.y = cvt_pk_bf16(v[2], v[3]); *(u32x2*)(G + off) = w; }
                } }
    }
};
template <int PASS> struct EpiMerge { static constexpr bool PERM = true, AFTER_DRAIN = false; const bf16_t* SG; float* TMP; bf16_t* MG;
    __device__ __forceinline__ void operator()(const f32x4 (&acc)[2][2][4][2], const Unit& u, int wr, int wc, int fr, int fq) const {
        const int row0 = u.pm * BM + wr * 64 + fr, col0 = u.pn * BM + wc * 32 + 8 * fq;
#pragma unroll
        for (int ai = 0; ai < 2; ++ai)
#pragma unroll
            for (int m = 0; m < 4; ++m) { const int row = row0 + ai * HALF + m * 16;
#pragma unroll
                for (int bj = 0; bj < 2; ++bj) { const int c = col0 + bj * HALF; const u32x4 s = *(const u32x4*)(SG + (size_t)row * PBP + c);
                    f32x4 v0 = acc[ai][bj][m][0], v1 = acc[ai][bj][m][1];
                    v0 = v0 * (f32x4){bflo(s.x), bfhi(s.x), bflo(s.y), bfhi(s.y)}; v1 = v1 * (f32x4){bflo(s.z), bfhi(s.z), bflo(s.w), bfhi(s.w)};
                    float* tp = TMP + (size_t)row * DM + c;
                    if (PASS == 1) { *(f32x4*)tp = v0; *(f32x4*)(tp + 4) = v1; }
                    else { v0 = v0 + *(const f32x4*)tp; v1 = v1 + *(const f32x4*)(tp + 4); *(u32x4*)(MG + (size_t)row * DM + c) = pack8(v0, v1); } } }
    }
};
struct EpiMergeDual { static constexpr bool PERM = true, AFTER_DRAIN = false; const bf16_t* SGA; const bf16_t* SGB; bf16_t* MG;
    __device__ __forceinline__ void mid(f32x4 (&acc)[2][2][4][2], const Unit& u, int wr, int wc, int fr, int fq) const {
        int row0 = u.pm * BM + wr * 64 + fr, col0 = u.pn * BM + wc * 32 + 8 * fq;
        asm volatile("" : "+v"(row0), "+v"(col0));
#pragma unroll
        for (int ai = 0; ai < 2; ++ai)
#pragma unroll
            for (int m = 0; m < 4; ++m) { const size_t ro = (size_t)(row0 + ai * HALF + m * 16) * PBP;
#pragma unroll
                for (int bj = 0; bj < 2; ++bj) { const int c = col0 + bj * HALF; const u32x4 a = *(const u32x4*)(SGA + ro + c), b = *(const u32x4*)(SGB + ro + c);
#define MRG_R(x, y) ((x) * __builtin_amdgcn_rcpf(fmaxf((y), 1e-20f)))
                    acc[ai][bj][m][0] = acc[ai][bj][m][0] * (f32x4){MRG_R(bflo(a.x), bflo(b.x)), MRG_R(bfhi(a.x), bfhi(b.x)), MRG_R(bflo(a.y), bflo(b.y)), MRG_R(bfhi(a.y), bfhi(b.y))};
                    acc[ai][bj][m][1] = acc[ai][bj][m][1] * (f32x4){MRG_R(bflo(a.z), bflo(b.z)), MRG_R(bfhi(a.z), bfhi(b.z)), MRG_R(bflo(a.w), bflo(b.w)), MRG_R(bfhi(a.w), bfhi(b.w))};
#undef MRG_R
                }
                asm volatile("" ::: "memory"); }
    }
    __device__ __forceinline__ void operator()(const f32x4 (&acc)[2][2][4][2], const Unit& u, int wr, int wc, int fr, int fq) const {
        const int row0 = u.pm * BM + wr * 64 + fr, col0 = u.pn * BM + wc * 32 + 8 * fq;
#pragma unroll
        for (int ai = 0; ai < 2; ++ai)
#pragma unroll
            for (int m = 0; m < 4; ++m) { const int row = row0 + ai * HALF + m * 16;
#pragma unroll
                for (int bj = 0; bj < 2; ++bj) { const int c = col0 + bj * HALF; const u32x4 s = *(const u32x4*)(SGB + (size_t)row * PBP + c);
                    const f32x4 v0 = acc[ai][bj][m][0] * (f32x4){bflo(s.x), bfhi(s.x), bflo(s.y), bfhi(s.y)}, v1 = acc[ai][bj][m][1] * (f32x4){bflo(s.z), bfhi(s.z), bflo(s.w), bfhi(s.w)};
                    *(u32x4*)(MG + (size_t)row * DM + c) = pack8(v0, v1); } }
    }
};
struct EpiRes { static constexpr bool PERM = false, AFTER_DRAIN = false; const float* X; float* OUT; const float* gate;
    __device__ __forceinline__ void operator()(const f32x4 (&acc)[2][2][4][2], const Unit& u, int wr, int wc, int fr, int fq) const {
        const int row0 = u.pm * BM + wr * 64 + fr, col0 = u.pn * BM + wc * 32 + 4 * fq; const float* gp = gate + (size_t)(u.pm >> 3) * NMOD;
#pragma unroll
        for (int bj = 0; bj < 2; ++bj)
#pragma unroll
            for (int n = 0; n < 2; ++n) { const int c = col0 + bj * HALF + n * 16; const f32x4 gv = *(const f32x4*)(gp + c);
#pragma unroll
                for (int ai = 0; ai < 2; ++ai)
#pragma unroll
                    for (int m = 0; m < 4; ++m) { const size_t off = (size_t)(row0 + ai * HALF + m * 16) * DM + c;
                        const f32x4 xv = *(const f32x4*)(X + off); *(f32x4*)(OUT + off) = xv * ALPHA + gv * acc[ai][bj][m][n]; } }
    }
};
struct EpiSwiGLU { static constexpr bool PERM = true, AFTER_DRAIN = false; bf16_t* ACT;
    __device__ __forceinline__ void operator()(const f32x4 (&acc)[2][2][4][2], const Unit& u, int wr, int wc, int fr, int fq) const {
        const int row0 = u.pm * BM + wr * 64 + fr, col0 = u.pn * HALF + wc * 32 + 8 * fq;
#pragma unroll
        for (int ai = 0; ai < 2; ++ai)
#pragma unroll
            for (int m = 0; m < 4; ++m) { const f32x4 g0 = acc[ai][0][m][0], g1 = acc[ai][0][m][1], u0 = acc[ai][1][m][0], u1 = acc[ai][1][m][1];
                const f32x4 a0 = g0 * sig4(g0) * u0, a1 = g1 * sig4(g1) * u1;
                *(u32x4*)(ACT + (size_t)(row0 + ai * HALF + m * 16) * DFF + col0) = pack8(a0, a1); }
    }
};

__device__ __forceinline__ void row_stats_exchange(const f32x4 (&v)[2][2][4][2], const Unit& u, int wr, int wc, int fr, int fq, PG8_LAS unsigned char* lds, int wid, int lane, float* slots, const XcdBarrier& bar) {
    PG8_LAS f32x2* P = (PG8_LAS f32x2*)lds; PG8_LAS f32x2* S = (PG8_LAS f32x2*)(lds + 8192);
#pragma unroll
    for (int ai = 0; ai < 2; ++ai)
#pragma unroll
        for (int m = 0; m < 4; ++m) {
            float s = 0.f;
#pragma unroll
            for (int bj = 0; bj < 2; ++bj)
#pragma unroll
                for (int n = 0; n < 2; ++n) { const f32x4 x = v[ai][bj][m][n]; s += (x[0] + x[1]) + (x[2] + x[3]); }
            s += __shfl_xor(s, 16); s += __shfl_xor(s, 32);
            const float mw = s * (1.0f / 64.0f); float q = 0.f;
#pragma unroll
            for (int bj = 0; bj < 2; ++bj)
#pragma unroll
                for (int n = 0; n < 2; ++n) { const f32x4 d = v[ai][bj][m][n] - mw; q += (d[0] * d[0] + d[1] * d[1]) + (d[2] * d[2] + d[3] * d[3]); }
            q += __shfl_xor(q, 16); q += __shfl_xor(q, 32);
            if (fq == 0) P[(ai * HALF + wr * 64 + m * 16 + fr) * 4 + wc] = (f32x2){mw, q};
        }
    asm volatile("s_waitcnt lgkmcnt(0)" ::: "memory"); __builtin_amdgcn_s_barrier(); asm volatile("" ::: "memory");
    const int row = wid * 32 + (lane & 31);
    if (lane < 32) {
        const f32x2 a = P[row * 4 + 0], b = P[row * 4 + 1], c = P[row * 4 + 2], d = P[row * 4 + 3];
        const float mt = (a[0] + b[0] + c[0] + d[0]) * 0.25f;
        const float da = a[0] - mt, db = b[0] - mt, dc = c[0] - mt, dd = d[0] - mt;
        const float m2 = (a[1] + b[1]) + (c[1] + d[1]) + 64.0f * ((da * da + db * db) + (dc * dc + dd * dd));
        *(f32x2*)(slots + ((size_t)(u.pm * BM + row) * 8 + u.pn) * 2) = (f32x2){mt, m2};
    }
    xcd_barrier(bar);
    if (lane < 32) {
        const float* sp = slots + (size_t)(u.pm * BM + row) * 16; float mt[8], m2[8]; float ms = 0.f;
#pragma unroll
        for (int t = 0; t < 8; ++t) { const f32x2 w = *(const f32x2*)(sp + 2 * t); mt[t] = w[0]; m2[t] = w[1]; ms += w[0]; }
        const float mean = ms * 0.125f; float q = 0.f;
#pragma unroll
        for (int t = 0; t < 8; ++t) { const float dm = mt[t] - mean; q += m2[t] + 256.0f * dm * dm; }
        S[row] = (f32x2){mean, 1.0f / sqrtf(q * (1.0f / 2048.0f) + LN_EPS)};
    }
    asm volatile("s_waitcnt lgkmcnt(0)" ::: "memory"); __builtin_amdgcn_s_barrier(); asm volatile("" ::: "memory");
}
#define LNF_PIN(ai, m) asm volatile("" : "+v"(acc[ai][0][m][0]), "+v"(acc[ai][0][m][1]), "+v"(acc[ai][1][m][0]), "+v"(acc[ai][1][m][1]))
#define LNF_RESID(Xp, gvv) do { _Pragma("unroll") for (int ai = 0; ai < 2; ++ai) _Pragma("unroll") for (int m = 0; m < 4; ++m) { const float* rp_ = (Xp) + (size_t)(row0 + ai * HALF + m * 16) * DM + col0; \
        _Pragma("unroll") for (int bj = 0; bj < 2; ++bj) _Pragma("unroll") for (int n = 0; n < 2; ++n) acc[ai][bj][m][n] = *(const f32x4*)(rp_ + bj * HALF + n * 16) * ALPHA + gvv[bj][n] * acc[ai][bj][m][n]; \
        LNF_PIN(ai, m); if (m & 1) asm volatile("" ::: "memory"); } } while (0)
struct EpiResLn { static constexpr bool PERM = false, AFTER_DRAIN = true; const float* X; float* OUT; const float* gate; const float* lg; const float* lb; float* slots; const XcdBarrier* bar;
    __device__ __forceinline__ void operator()(const f32x4 (&)[2][2][4][2], const Unit&, int, int, int, int) const {}
    __device__ __forceinline__ void fused(f32x4 (&acc)[2][2][4][2], const Unit& u, int wr, int wc, int fr, int fq, PG8_LAS unsigned char* lds, int wid, int lane) const {
        const PG8_LAS f32x2* S = (const PG8_LAS f32x2*)(lds + 8192);
        const int row0 = u.pm * BM + wr * 64 + fr, col0 = u.pn * BM + wc * 32 + 4 * fq; const float* gp = gate + (size_t)(u.pm >> 3) * NMOD + col0;
        { f32x4 gv[2][2];
#pragma unroll
          for (int bj = 0; bj < 2; ++bj)
#pragma unroll
              for (int n = 0; n < 2; ++n) gv[bj][n] = *(const f32x4*)(gp + bj * HALF + n * 16);
          LNF_RESID(X, gv); }
        row_stats_exchange(acc, u, wr, wc, fr, fq, lds, wid, lane, slots, *bar);
        f32x4 g4[2][2], b4[2][2];
#pragma unroll
        for (int bj = 0; bj < 2; ++bj)
#pragma unroll
            for (int n = 0; n < 2; ++n) { g4[bj][n] = *(const f32x4*)(lg + col0 + bj * HALF + n * 16); b4[bj][n] = *(const f32x4*)(lb + col0 + bj * HALF + n * 16); }
#pragma unroll
        for (int ai = 0; ai < 2; ++ai)
#pragma unroll
            for (int m = 0; m < 4; ++m) { const int r = ai * HALF + wr * 64 + m * 16 + fr; const f32x2 sr = S[r]; float* op = OUT + (size_t)(u.pm * BM + r) * DM + col0;
#pragma unroll
                for (int bj = 0; bj < 2; ++bj)
#pragma unroll
                    for (int n = 0; n < 2; ++n) *(f32x4*)(op + bj * HALF + n * 16) = (acc[ai][bj][m][n] - sr[0]) * sr[1] * g4[bj][n] + b4[bj][n];
                if (m & 1) asm volatile("" ::: "memory"); }
    }
};
struct EpiResLnLn { static constexpr bool PERM = false, AFTER_DRAIN = true; const float* X; float* X1; bf16_t* H2; const float* mod; const float* lg; const float* lb; float* slots1; float* slots2; const XcdBarrier* bar;
    __device__ __forceinline__ void operator()(const f32x4 (&)[2][2][4][2], const Unit&, int, int, int, int) const {}
    __device__ __forceinline__ void fused(f32x4 (&acc)[2][2][4][2], const Unit& u, int wr, int wc, int fr, int fq, PG8_LAS unsigned char* lds, int wid, int lane) const {
        const PG8_LAS f32x2* S = (const PG8_LAS f32x2*)(lds + 8192);
        const int row0 = u.pm * BM + wr * 64 + fr, col0 = u.pn * BM + wc * 32 + 4 * fq; const float* mb = mod + (size_t)(u.pm >> 3) * NMOD + col0;
        { f32x4 gv[2][2];
#pragma unroll
          for (int bj = 0; bj < 2; ++bj)
#pragma unroll
              for (int n = 0; n < 2; ++n) gv[bj][n] = *(const f32x4*)(mb + 2 * DM + bj * HALF + n * 16);
          LNF_RESID(X, gv); }
        row_stats_exchange(acc, u, wr, wc, fr, fq, lds, wid, lane, slots1, *bar);
        { f32x4 g4[2][2], b4[2][2];
#pragma unroll
          for (int bj = 0; bj < 2; ++bj)
#pragma unroll
              for (int n = 0; n < 2; ++n) { g4[bj][n] = *(const f32x4*)(lg + col0 + bj * HALF + n * 16); b4[bj][n] = *(const f32x4*)(lb + col0 + bj * HALF + n * 16); }
#pragma unroll
          for (int ai = 0; ai < 2; ++ai)
#pragma unroll
              for (int m = 0; m < 4; ++m) { const int r = ai * HALF + wr * 64 + m * 16 + fr; const f32x2 sr = S[r]; float* op = X1 + (size_t)(u.pm * BM + r) * DM + col0;
#pragma unroll
                  for (int bj = 0; bj < 2; ++bj)
#pragma unroll
                      for (int n = 0; n < 2; ++n) { const f32x4 x1 = (acc[ai][bj][m][n] - sr[0]) * sr[1] * g4[bj][n] + b4[bj][n]; acc[ai][bj][m][n] = x1; *(f32x4*)(op + bj * HALF + n * 16) = x1; }
                  LNF_PIN(ai, m); if (m & 1) asm volatile("" ::: "memory"); } }
        row_stats_exchange(acc, u, wr, wc, fr, fq, lds, wid, lane, slots2, *bar);
        f32x4 sh[2][2], sc[2][2];
#pragma unroll
        for (int bj = 0; bj < 2; ++bj)
#pragma unroll
            for (int n = 0; n < 2; ++n) { sh[bj][n] = *(const f32x4*)(mb + 3 * DM + bj * HALF + n * 16); sc[bj][n] = *(const f32x4*)(mb + 4 * DM + bj * HALF + n * 16) + 1.f; }
#pragma unroll
        for (int ai = 0; ai < 2; ++ai)
#pragma unroll
            for (int m = 0; m < 4; ++m) { const int r = ai * HALF + wr * 64 + m * 16 + fr; const f32x2 sr = S[r]; bf16_t* op = H2 + (size_t)(u.pm * BM + r) * DM + col0;
#pragma unroll
                for (int bj = 0; bj < 2; ++bj)
#pragma unroll
                    for (int n = 0; n < 2; ++n) { const f32x4 o = (acc[ai][bj][m][n] - sr[0]) * sr[1] * sc[bj][n] + sh[bj][n]; u32x2 w; w.x = cvt_pk_bf16(o[0], o[1]); w.y = cvt_pk_bf16(o[2], o[3]);
                        *(u32x2*)(op + bj * HALF + n * 16) = w; }
                if (m & 1) asm volatile("" ::: "memory"); }
    }
};
}
__device__ __forceinline__ int q_pop(unsigned* ctr, int lane) { unsigned v = 0u; if (lane == 0) v = __hip_atomic_fetch_add(ctr, 1u, __ATOMIC_RELAXED, __HIP_MEMORY_SCOPE_AGENT); return (int)__builtin_amdgcn_readfirstlane(v); }
struct MapId { __device__ __forceinline__ int operator()(int n) const { return n; } };
struct MapWin { __device__ __forceinline__ int operator()(int n) const {
    return n < 4096 ? n : n < 8192 ? 7624 + (n - 4096) : n < 11712 ? 4104 + (n - 8192) : n < 11720 ? 4096 + (n - 11712) : -1; } };
struct MapGu { __device__ __forceinline__ int operator()(int n) const { const int pn = n >> 8, j = n & 255; return j < 128 ? 128 * pn + j : DFF + 128 * pn + (j - 128); } };
template <class Map>
__device__ __forceinline__ void transpose_item(const float* W, int ldw, bf16_t* WT, int Kd, int kb, int nb, LAS float* scr, int lane, Map map) {
    const int k0 = 64 * kb, n0 = 32 * nb; const int src = map(n0 + (lane & 31));
    const float* wp = W + (size_t)(k0 + (lane >> 5)) * ldw + (src >= 0 ? src : 0);
    float tv[32];
#pragma unroll
    for (int i = 0; i < 32; ++i) tv[i] = src >= 0 ? __builtin_nontemporal_load(wp + (size_t)(2 * i) * ldw) : 0.f;
#pragma unroll
    for (int i = 0; i < 32; ++i) scr[(2 * i + (lane >> 5)) * 33 + (lane & 31)] = tv[i];
    LDS_WAIT();
    const int c = lane & 7;
#pragma unroll
    for (int j = 0; j < 4; ++j) { const int n = (lane >> 3) + 8 * j; const LAS float* s = scr + (8 * c) * 33 + n;
        u32x4 o; o.x = pk2(s[0 * 33], s[1 * 33]); o.y = pk2(s[2 * 33], s[3 * 33]); o.z = pk2(s[4 * 33], s[5 * 33]); o.w = pk2(s[6 * 33], s[7 * 33]);
        *(u32x4*)(WT + (size_t)(n0 + n) * Kd + k0 + 8 * c) = o; }
    LDS_WAIT();
}
template <class Map>
__device__ __forceinline__ void transpose_item2(const float* W, int ldw, bf16_t* WT, int Kd, int kb, int nb, LAS float* scrf, int lane, Map map) {
    LAS unsigned* scr = (LAS unsigned*)scrf;
    const int k0 = 64 * kb, n0 = 64 * nb, half = lane >> 5, c2 = lane & 31; const int src = map(n0 + 2 * c2);
    const float* wp = W + (size_t)(k0 + 32 * half) * ldw + (src >= 0 ? src : 0);
    f32x2 tv[32];
#pragma unroll
    for (int i = 0; i < 32; ++i) tv[i] = src >= 0 ? __builtin_nontemporal_load((const f32x2*)(wp + (size_t)i * ldw)) : (f32x2){0.f, 0.f};
    LAS unsigned* w0 = scr + (2 * c2) * 33 + 16 * half;
#pragma unroll
    for (int j = 0; j < 16; ++j) { w0[j] = pk2(tv[2 * j][0], tv[2 * j + 1][0]); w0[33 + j] = pk2(tv[2 * j][1], tv[2 * j + 1][1]); }
    LDS_WAIT();
    const int c = lane & 7;
#pragma unroll
    for (int j = 0; j < 8; ++j) { const int n = (lane >> 3) + 8 * j; const LAS unsigned* sp = scr + n * 33 + 4 * c;
        u32x4 o; o.x = sp[0]; o.y = sp[1]; o.z = sp[2]; o.w = sp[3];
        *(u32x4*)(WT + (size_t)(n0 + n) * Kd + k0 + 8 * c) = o; }
    LDS_WAIT();
}
__device__ __forceinline__ void ln_stats(const f32x4 (&v)[8], float& mean, float& rstd) {
    float s = 0.f;
#pragma unroll
    for (int j = 0; j < 8; ++j) s += (v[j][0] + v[j][1]) + (v[j][2] + v[j][3]);
    mean = wave_sum(s) * (1.f / DM); float q = 0.f;
#pragma unroll
    for (int j = 0; j < 8; ++j) { const f32x4 d = v[j] - mean; q += (d[0] * d[0] + d[1] * d[1]) + (d[2] * d[2] + d[3] * d[3]); }
    rstd = 1.f / sqrtf(wave_sum(q) * (1.f / DM) + LN_EPS);
}

__device__ __forceinline__ void prep_row(const Params& p, int t, int lane) {
    unsigned char* ws = p.ws;
    const bf16_t* PBF = (const bf16_t*)(ws + WS_PBF) + (size_t)t * PBP;
    bf16_t* QN = (bf16_t*)(ws + WS_QN) + (size_t)t * 1024; bf16_t* KN = (bf16_t*)(ws + WS_KN) + (size_t)t * 1024;
    u32x4 qk4[4];
#pragma unroll
    for (int ps = 0; ps < 4; ++ps) qk4[ps] = *(const u32x4*)(PBF + (ps >> 1) * 1024 + (ps & 1) * 512 + lane * 8);
#pragma unroll
    for (int ps = 0; ps < 4; ++ps) {
        const int isk = ps >> 1, c = (ps & 1) * 512 + lane * 8;
        const u32x4 w = qk4[ps];
        float x[8] = {bflo(w.x), bfhi(w.x), bflo(w.y), bfhi(w.y), bflo(w.z), bfhi(w.z), bflo(w.w), bfhi(w.w)};
        float ss = 0.f;
#pragma unroll
        for (int i = 0; i < 8; ++i) ss += x[i] * x[i];
        ss = rowsum16(ss);
        const float rs = 1.f / sqrtf(ss * (1.f / 128.f) + RMS_EPS);
        const float* gp = (isk ? p.in[7] : p.in[6]) + (c & 127);
        const f32x4 g0 = *(const f32x4*)gp, g1 = *(const f32x4*)(gp + 4);
        u32x4 o; o.x = pk2(x[0] * rs * g0[0], x[1] * rs * g0[1]); o.y = pk2(x[2] * rs * g0[2], x[3] * rs * g0[3]);
        o.z = pk2(x[4] * rs * g1[0], x[5] * rs * g1[1]); o.w = pk2(x[6] * rs * g1[2], x[7] * rs * g1[3]);
        *(u32x4*)((isk ? KN : QN) + c) = o;
    }
    const bf16_t* cur = (const bf16_t*)(ws + WS_PRW) + (size_t)t * NF32; const bf16_t* prv = cur - NF32;
    const bool first = (t & (SEQ - 1)) == 0; const float* mu = p.in[8];
#define SHIFTED(col) ({ const f32x4 c_ = ld4bf(cur + (col)); const f32x4 p_ = first ? (f32x4){0.f, 0.f, 0.f, 0.f} : ld4bf(prv + (col)); const f32x4 m_ = *(const f32x4*)(mu + (col)); c_ + (p_ - c_) * m_; })
    bf16_t* AC = (bf16_t*)(ws + WS_ACAT) + (size_t)t * 256; bf16_t* AC2 = (bf16_t*)(ws + WS_ACAT2) + (size_t)t * 256;
    if (lane < 32) {
        f32x4 a = {0.f, 0.f, 0.f, 0.f}, b = {0.f, 0.f, 0.f, 0.f};
        if (lane < 24) { const f32x4 xw = SHIFTED(3072 + lane * 4); b = SHIFTED(3168 + lane * 4);
#pragma unroll
            for (int i = 0; i < 4; ++i) { const float e = __expf(-2.f * fabsf(xw[i])); const float th = (1.f - e) / (1.f + e); a[i] = xw[i] < 0.f ? -th : th; } }
        u32x2 wa, wb; wa.x = pk2(a[0], a[1]); wa.y = pk2(a[2], a[3]); wb.x = pk2(b[0], b[1]); wb.y = pk2(b[2], b[3]);
        *(u32x2*)(AC + lane * 4) = wa; *(u32x2*)(AC + 128 + lane * 4) = wb; }
    { const f32x4 xg = SHIFTED(3264 + lane * 4); u32x2 w; w.x = pk2(sigm(xg[0]), sigm(xg[1])); w.y = pk2(sigm(xg[2]), sigm(xg[3])); *(u32x2*)(AC2 + lane * 4) = w; }
#undef SHIFTED
}

__device__ __forceinline__ void rwkv_job(LAS unsigned char* lds, int job, const float* mu, const float* k_k, const float* k_a, const bf16_t* PRW, const float* WD, const float* AA, float* Y, int tid, int wave, int lane) {
    const int bh = job >> 1, half = job & 1, b = bh >> 4, h = bh & 15;
    const size_t tok0 = (size_t)b * SEQ;
    constexpr int TC = 32, CHF = TC * 384, NCH = SEQ / TC;
    LAS float* buf = (LAS float*)lds;
    const int lt = tid & 255, lrow = lt >> 4, piece = lt & 15, hc = h * 64 + piece * 4;
    const size_t goff = (tok0 + lrow) * 1024 + hc;
    const bf16_t* prw0 = PRW + tok0 * NF32 + hc;
    u32x2 rb[12]; f32x4 rg[4];
    const f32x4 kkc = *(const f32x4*)(k_k + hc), kac = *(const f32x4*)(k_a + hc), mur = *(const f32x4*)(mu + hc), muk = *(const f32x4*)(mu + 1024 + hc), muv = *(const f32x4*)(mu + 2048 + hc);
#define RW_LOAD(rg, c) do { const size_t o_ = goff + (size_t)(c) * TC * 1024; _Pragma("unroll") for (int p_ = 0; p_ < 2; ++p_) { const int t_ = (c) * TC + lrow + 16 * p_, tp_ = t_ > 0 ? t_ - 1 : 0; \
        _Pragma("unroll") for (int s_ = 0; s_ < 3; ++s_) { rb[6 * p_ + 2 * s_] = *(const u32x2*)(prw0 + (size_t)t_ * NF32 + s_ * 1024); rb[6 * p_ + 2 * s_ + 1] = *(const u32x2*)(prw0 + (size_t)tp_ * NF32 + s_ * 1024); } \
        rg[p_] = *(const f32x4*)(WD + o_ + (size_t)p_ * 16 * 1024); rg[2 + p_] = *(const f32x4*)(AA + o_ + (size_t)p_ * 16 * 1024); } } while (0)
#define RW_BF4(w) ((f32x4){bflo((w).x), bfhi((w).x), bflo((w).y), bfhi((w).y)})
#define RW_WRITE(rg, c) do { _Pragma("unroll") for (int p_ = 0; p_ < 2; ++p_) { LAS float* d_ = buf + ((c) & 1) * CHF + (lrow + 16 * p_) * 384 + piece * 4; \
        const float fz_ = ((c) * TC + lrow + 16 * p_) > 0 ? 1.f : 0.f;     \
        const f32x4 rc_ = RW_BF4(rb[6 * p_]), rp_ = RW_BF4(rb[6 * p_ + 1]) * fz_, kc_ = RW_BF4(rb[6 * p_ + 2]), kp_ = RW_BF4(rb[6 * p_ + 3]) * fz_, vc_ = RW_BF4(rb[6 * p_ + 4]), vp_ = RW_BF4(rb[6 * p_ + 5]) * fz_; \
        const f32x4 ks_ = kc_ + (kp_ - kc_) * muk, a_ = rg[2 + p_]; const f32x4 kv_ = ks_ * kkc; \
        const float nn_ = rowsum16((kv_[0] * kv_[0] + kv_[1] * kv_[1]) + (kv_[2] * kv_[2] + kv_[3] * kv_[3])); const f32x4 kk_ = kv_ * __builtin_amdgcn_rsqf(fmaxf(nn_, 1e-24f));     \
        *(LAS f32x4*)(d_) = kk_; *(LAS f32x4*)(d_ + 64) = rg[p_]; *(LAS f32x4*)(d_ + 128) = kk_ * a_; *(LAS f32x4*)(d_ + 192) = ks_ * ((a_ - 1.f) * kac + 1.f); \
        *(LAS f32x4*)(d_ + 256) = rc_ + (rp_ - rc_) * mur; *(LAS f32x4*)(d_ + 320) = vc_ + (vp_ - vc_) * muv; } } while (0)
    if (wave >= 4) { RW_LOAD(rg, 0); RW_WRITE(rg, 0); RW_LOAD(rg, 1); }
    __syncthreads();
    const int rw = lane >> 3, j = lane & 7, rl = wave * 8 + rw;
    f32x2 S[4] = {{0.f, 0.f}, {0.f, 0.f}, {0.f, 0.f}, {0.f, 0.f}};
#define RW_STEP(dst, dv, st_) do { const LAS float* sp_ = cb + (st_) * 384; \
        _Pragma("unroll") for (int s_ = 0; s_ < 5; ++s_) { dst[2 * s_] = *(const LAS f32x4*)(sp_ + s_ * 64); dst[2 * s_ + 1] = *(const LAS f32x4*)(sp_ + s_ * 64 + 4); } \
        dv = vb[(st_) * 384]; } while (0)
    for (int c = 0; c < NCH; ++c) {
        if (wave >= 4) { if (c + 1 < NCH) { RW_WRITE(rg, c + 1); if (c + 2 < NCH) RW_LOAD(rg, c + 2); } }
        else {
            const LAS float* cb = buf + (c & 1) * CHF + 8 * j;
            const LAS float* vb = buf + (c & 1) * CHF + 320 + half * 32 + rl;
            float* yp = Y + (tok0 + (size_t)c * TC) * 1024 + h * 64 + half * 32 + rl;
            f32x4 q[10]; float vv;
            RW_STEP(q, vv, 0);
#pragma unroll 8
            for (int st = 0; st < TC; ++st) {
                f32x4 n[10]; float nv; const int ns = st + 1 < TC ? st + 1 : st;
                RW_STEP(n, nv, ns);
                f32x2 ta = S[0] * q[0].lo, tb = S[1] * q[0].hi; ta = S[2] * q[1].lo + ta; tb = S[3] * q[1].hi + tb; ta = ta + tb;
                float d = ta[0] + ta[1];
                d += dppf<0xB1>(d); d += dppf<0x4E>(d); d += dppf<0x141>(d);
                S[0] = S[0] * q[2].lo - q[4].lo * d + q[6].lo * vv;
                S[1] = S[1] * q[2].hi - q[4].hi * d + q[6].hi * vv;
                S[2] = S[2] * q[3].lo - q[5].lo * d + q[7].lo * vv;
                S[3] = S[3] * q[3].hi - q[5].hi * d + q[7].hi * vv;
                f32x2 ua = S[0] * q[8].lo, ub = S[1] * q[8].hi; ua = S[2] * q[9].lo + ua; ub = S[3] * q[9].hi + ub; ua = ua + ub;
                float y = ua[0] + ua[1];
                y += dppf<0xB1>(y); y += dppf<0x4E>(y); y += dppf<0x141>(y);
                yp[(size_t)st * 1024] = y;
#pragma unroll
                for (int i = 0; i < 10; ++i) q[i] = n[i];
                vv = nv;
            }
        }
        __syncthreads();
    }
#undef RW_STEP
#undef RW_LOAD
#undef RW_BF4
#undef RW_WRITE
}

__device__ __forceinline__ void post_row(const Params& p, int t, int lane) {
    unsigned char* ws = p.ws;
    const float* Y = (const float*)(ws + WS_YRAW) + (size_t)t * 1024; const bf16_t* G = (const bf16_t*)(ws + WS_G) + (size_t)t * 1024;
    const float* AA = p.out + (size_t)MT * 1024 + (size_t)t * 1024;
    const bf16_t* cur = (const bf16_t*)(ws + WS_PRW) + (size_t)t * NF32; const bool first = (t & (SEQ - 1)) == 0; const bf16_t* prv = first ? cur : cur - NF32; const float fz = first ? 0.f : 1.f; const float* mu = p.in[8];
    bf16_t* YB = (bf16_t*)(ws + WS_KN) + (size_t)t * 1024;
#pragma unroll
    for (int pp = 0; pp < 2; ++pp) {
        f32x4 y_[2], r_[2], k_[2], v_[2], rk_[2], lg_[2], lb_[2], a_[2], ka_[2]; u32x2 g_[2];
#pragma unroll
        for (int q = 0; q < 2; ++q) { const int c = (2 * pp + q) * 256 + lane * 4;
            y_[q] = *(const f32x4*)(Y + c); a_[q] = *(const f32x4*)(AA + c); ka_[q] = *(const f32x4*)(p.in[15] + c);
            { const f32x4 rc = ld4bf(cur + c), rp = ld4bf(prv + c) * fz, kc = ld4bf(cur + 1024 + c), kp = ld4bf(prv + 1024 + c) * fz, vc = ld4bf(cur + 2048 + c), vp = ld4bf(prv + 2048 + c) * fz;
              r_[q] = rc + (rp - rc) * *(const f32x4*)(mu + c); k_[q] = kc + (kp - kc) * *(const f32x4*)(mu + 1024 + c); v_[q] = vc + (vp - vc) * *(const f32x4*)(mu + 2048 + c); }
            rk_[q] = *(const f32x4*)(p.in[16] + c); lg_[q] = *(const f32x4*)(p.in[17] + c); lb_[q] = *(const f32x4*)(p.in[18] + c); g_[q] = *(const u32x2*)(G + c); }
#pragma unroll
        for (int q = 0; q < 2; ++q) { const int c = (2 * pp + q) * 256 + lane * 4;
            const f32x4 y = y_[q];
            const float mean = rowsum16((y[0] + y[1]) + (y[2] + y[3])) * (1.f / 64.f);
            const f32x4 d = y - mean;
            const float var = rowsum16((d[0] * d[0] + d[1] * d[1]) + (d[2] * d[2] + d[3] * d[3])) * (1.f / 64.f);
            const float rs = 1.f / sqrtf(var + LNX_EPS);
            const f32x4 yn = d * rs * lg_[q] + lb_[q];
            const f32x4 pr = r_[q] * (k_[q] * ((a_[q] - 1.f) * ka_[q] + 1.f)) * rk_[q];
            const float bs = rowsum16((pr[0] + pr[1]) + (pr[2] + pr[3]));
            const u32x2 gw = g_[q];
            const f32x4 o = (yn + v_[q] * bs) * (f32x4){bflo(gw.x), bfhi(gw.x), bflo(gw.y), bfhi(gw.y)};
            u32x2 w; w.x = pk2(o[0], o[1]); w.y = pk2(o[2], o[3]); *(u32x2*)(YB + c) = w; }
    }
}

__device__ __forceinline__ void og_row(const Params& p, int t, int lane) {
    unsigned char* ws = p.ws;
    bf16_t* O = (bf16_t*)(ws + WS_O) + (size_t)t * 1024; const bf16_t* SG = (const bf16_t*)(ws + WS_PBF) + (size_t)t * PBP + 3072;
    u32x4 o8[2], s8[2];
#pragma unroll
    for (int ps = 0; ps < 2; ++ps) { o8[ps] = *(const u32x4*)(O + ps * 512 + lane * 8); s8[ps] = *(const u32x4*)(SG + ps * 512 + lane * 8); }
#pragma unroll
    for (int ps = 0; ps < 2; ++ps) { const int c = ps * 512 + lane * 8;
        const u32x4 o = o8[ps], s = s8[ps]; u32x4 w;
        w.x = pk2(bflo(o.x) * bflo(s.x), bfhi(o.x) * bfhi(s.x)); w.y = pk2(bflo(o.y) * bflo(s.y), bfhi(o.y) * bfhi(s.y));
        w.z = pk2(bflo(o.z) * bflo(s.z), bfhi(o.z) * bfhi(s.z)); w.w = pk2(bflo(o.w) * bflo(s.w), bfhi(o.w) * bfhi(s.w));
        *(u32x4*)(O + c) = w; }
}

__device__ __forceinline__ void cumsum_job(const Params& p, int job, LAS unsigned char* lds, int tid, int wave, int lane) {
    unsigned char* ws = p.ws; float* CUM = (float*)(ws + WS_CUM); LAS float* wsum = (LAS float*)lds;
    const int b = job >> 3, h = job & 7; const float bias = p.in[5][h]; const int t0 = tid * 4; float l[4];
#pragma unroll
    for (int i = 0; i < 4; ++i) { const float x = ((const float*)(ws + WS_LF))[(size_t)(b * SEQ + t0 + i) * 256 + 192 + h] + bias; l[i] = fminf(x, 0.f) - log1pf(expf(-fabsf(x))); }
    l[1] += l[0]; l[2] += l[1]; l[3] += l[2];
    const float tot = l[3]; float sc = tot;
#pragma unroll
    for (int o = 1; o < 64; o <<= 1) { const float n = __shfl_up(sc, o); if (lane >= o) sc += n; }
    __syncthreads();
    if (lane == 63) wsum[wave] = sc;
    __syncthreads();
    float woff = 0.f;
    for (int w = 0; w < wave; ++w) woff += wsum[w];
    const float base = woff + sc - tot;
    *(f32x4*)(CUM + (size_t)job * SEQ + t0) = (f32x4){base + l[0], base + l[1], base + l[2], base + l[3]};
}

typedef __hip_bfloat16 fabt;
__device__ __forceinline__ fa::BlockRef<fabt, fabt> fa_ref(int L, int pass, const fabt* Qn, const fabt* Kn, const fabt* Vb, fabt* O, const float* CUM) {
    const int bh = (L & 127) >> 2, x = L & 3, qb = pass ? 7 - x : x, b = bh >> 3, h = bh & 7; const size_t row0 = (size_t)b * SEQ;
    fa::BlockRef<fabt, fabt> r;
    r.Q = Qn + (row0 + (size_t)qb * 256) * 1024 + h * 128; r.O = O + (row0 + (size_t)qb * 256) * 1024 + h * 128;
    r.K = Kn + row0 * 1024 + h * 128; r.V = Vb + row0 * PBP + h * 128; r.SG = Vb + (row0 + (size_t)qb * 256) * PBP + 1024 + h * 128; r.CB = CUM + bh * SEQ; r.P0 = qb * 256;
    return r;
}
#ifndef REP_P0
#define REP_P0 1
#endif
#ifndef REP_P3
#define REP_P3 1
#endif
#ifndef REP_REC
#define REP_REC 1
#endif
#ifndef REP_P10
#define REP_P10 1
#endif
#ifndef REP_P2
#define REP_P2 1
#endif
#ifndef REP_ATT
#define REP_ATT 1
#endif
#ifndef REP_P7B
#define REP_P7B 1
#endif
#ifndef REP_P8
#define REP_P8 1
#endif
#ifndef PROBE_MASK
#define PROBE_MASK 0
#endif
#ifndef PROBE_MULT
#define PROBE_MULT 8
#endif
#ifndef GU_SPLIT
#define GU_SPLIT 11264
#endif
#ifndef REP_SYNC
#define REP_SYNC 0
#endif
__global__ void __launch_bounds__(512) mk_fwd(Params p) {
    extern __shared__ __attribute__((aligned(16))) unsigned char lds_raw[];
    cg::grid_group grid = cg::this_grid();
    LAS unsigned char* lds = (LAS unsigned char*)lds_raw;
    if (threadIdx.x < 2) ((LAS unsigned*)(lds + 131072))[threadIdx.x] = 0u;
    __syncthreads();
#if PROBE_MASK
    unsigned long long* tsb = (unsigned long long*)(p.ws + WS_BAR + 49152); int nts = 0;
#define STAMP() do { if (blockIdx.x == 0 && threadIdx.x == 0) tsb[nts] = __builtin_amdgcn_s_memrealtime(); ++nts; } while (0)
#else
#define STAMP() do {} while (0)
#endif
    STAMP();
    const XcdBarrier bar = xcd_barrier_post((unsigned*)(p.ws + WS_BAR), (volatile LAS unsigned*)(lds + 131072));
    const int G = gridDim.x, blk = blockIdx.x, NGW = G * 8;
#define PHASE_IDS() int tid = threadIdx.x; asm volatile("" : "+v"(tid)); const int lane = tid & 63, wave = __builtin_amdgcn_readfirstlane(tid >> 6), gw = blk * 8 + wave; (void)gw; (void)lane; LAS float* scr = (LAS float*)(lds + wave * 8704); (void)scr
    unsigned char* ws = p.ws;
    float* MOD = (float*)(ws + WS_MOD); float* CUM = (float*)(ws + WS_CUM); float* PART = (float*)(ws + WS_PART);
    bf16_t* XN = (bf16_t*)(ws + WS_XN); bf16_t* PBF = (bf16_t*)(ws + WS_PBF); float* PF32 = (float*)(ws + WS_PF32);

    for (int rep_ = 0; rep_ < REP_P0; ++rep_) {
        PHASE_IDS();
        __syncthreads();
        LAS float* sl = (LAS float*)(lds + 73728);
        for (int i = tid; i < NB * DM; i += 512) { const float v = p.in[1][i]; sl[i] = v * sigm(v); }
        __syncthreads();
        constexpr int I_MOD = 16 * 48, I_IN = 32 * (NPROJ / 64), I_OUT = 32 * 32, I_A = 16 * 32;
        const int vgw = wave * G + blk, ntr = I_IN;
        for (int r = vgw; r < I_MOD; r += 8 * G) {
            const int ks = r / 48, cc = r % 48;
            const float* wp = p.in[2] + (size_t)(ks * 128) * NMOD + cc * 256 + lane * 4;
            f32x4 a0 = {0.f, 0.f, 0.f, 0.f}, a1 = a0, a2 = a0, a3 = a0;
#pragma unroll 16
            for (int rr = 0; rr < 128; ++rr) { const f32x4 w = __builtin_nontemporal_load((const f32x4*)(wp + (size_t)rr * NMOD)); const int d = ks * 128 + rr;
                a0 += w * sl[d]; a1 += w * sl[DM + d]; a2 += w * sl[2 * DM + d]; a3 += w * sl[3 * DM + d]; }
            float* pp = PART + (size_t)(ks * 4) * NMOD + cc * 256 + lane * 4;
            *(f32x4*)pp = a0; *(f32x4*)(pp + NMOD) = a1; *(f32x4*)(pp + 2 * NMOD) = a2; *(f32x4*)(pp + 3 * NMOD) = a3;
        }
        const bool bal = (G == 256);
        const int t_lo = bal ? (vgw < 768 ? vgw : 768 + 4 * (vgw - 768)) : vgw, t_n = bal ? (vgw < 768 ? 1 : 4) : ntr, t_st = bal ? 1 : 8 * G;
        for (int k = 0; k < t_n; ++k) {
            int r = t_lo + k * t_st; if (r >= ntr) break;
            transpose_item2(p.in[4], 11720, (bf16_t*)(ws + WS_WIN), DM, r / (NPROJ / 64), r % (NPROJ / 64), scr, lane, MapWin());
        }
        bf16_t* WL = (bf16_t*)(ws + WS_WLORA);
        for (int idx = blk * 512 + tid; idx < 3072 * 32; idx += G * 512) {
            const int n = idx % 3072, kc = idx / 3072, k0 = kc * 8; float v[8];
#pragma unroll
            for (int i = 0; i < 8; ++i) { const int k = k0 + i; float x = 0.f;
                if (n < 1024) { if (k < 96) x = p.in[10][(size_t)k * 1024 + n]; }
                else if (n < 2048) { if (k >= 128 && k < 224) x = p.in[12][(size_t)(k - 128) * 1024 + (n - 1024)]; }
                else x = p.in[13][(size_t)k * 1024 + (n - 2048)];
                v[i] = x; }
            u32x4 o; o.x = pk2(v[0], v[1]); o.y = pk2(v[2], v[3]); o.z = pk2(v[4], v[5]); o.w = pk2(v[6], v[7]);
            *(u32x4*)(WL + (size_t)n * 256 + k0) = o;
        }
    }
    grid.sync();
    STAMP();
    for (int rep_ = 0; rep_ < REP_SYNC; ++rep_) xcd_barrier(bar);

    {
        PHASE_IDS();
        LAS float* lsm = (LAS float*)lds;
        for (int rb = blk; rb < MT / 32; rb += G) {
            const int b = rb / 64;
            __syncthreads();
            for (int i = tid; i < 2 * DM; i += 512) { float s = p.in[3][i];
#pragma unroll
                for (int ks = 0; ks < 16; ++ks) s += PART[(size_t)(ks * 4 + b) * NMOD + i];
                lsm[i] = s; }
            __syncthreads();
            for (int rr = wave; rr < 32; rr += 16) { const int row = rb * 32 + rr, row2 = row + 8;
                const float* xr = p.in[0] + (size_t)row * DM + lane * 4; const float* xr2 = p.in[0] + (size_t)row2 * DM + lane * 4; f32x4 v[8], u[8];
#pragma unroll
                for (int j = 0; j < 8; ++j) { v[j] = __builtin_nontemporal_load((const f32x4*)(xr + j * 256)); u[j] = __builtin_nontemporal_load((const f32x4*)(xr2 + j * 256)); }
                float mean, rstd, mean2, rstd2; ln_stats(v, mean, rstd); ln_stats(u, mean2, rstd2);
                bf16_t* orow = XN + (size_t)row * DM + lane * 4; bf16_t* orow2 = XN + (size_t)row2 * DM + lane * 4;
#pragma unroll
                for (int j = 0; j < 8; ++j) { const int c = j * 256 + lane * 4; const f32x4 sh = *(const LAS f32x4*)(lsm + c), sc = *(const LAS f32x4*)(lsm + DM + c);
                    const f32x4 o = (v[j] - mean) * rstd * (sc + 1.f) + sh; u32x2 w; w.x = pk2(o[0], o[1]); w.y = pk2(o[2], o[3]); *(u32x2*)(orow + j * 256) = w;
                    const f32x4 o2 = (u[j] - mean2) * rstd2 * (sc + 1.f) + sh; u32x2 w2; w2.x = pk2(o2[0], o2[1]); w2.y = pk2(o2[2], o2[3]); *(u32x2*)(orow2 + j * 256) = w2; } }
        }
        for (int i = blk * 512 + tid; i < NB * NMOD; i += G * 512) { const int b = i / NMOD, col = i % NMOD; float s = p.in[3][col];
#pragma unroll
            for (int ks = 0; ks < 16; ++ks) s += PART[(size_t)(ks * 4 + b) * NMOD + col];
            MOD[i] = s; }
    }
    xcd_barrier(bar);
    STAMP();

    for (int rep_ = 0; rep_ < REP_P2; ++rep_) {
        {
        pg8::StaticOrder S; S.init(MT, NBF, G, blk);
        pg8::Gemm g{XN, (const bf16_t*)(ws + WS_WIN), MT, NBF, DM}; pg8::EpiProjBf E{PBF};
        pg8::gemm_phase<pg8::EpiProjBf, pg8::StaticOrder, true, true>(lds, g, S, E);
        }
        {
        pg8::StaticOrder S; S.init(MT, NF32, G, blk);
        pg8::Gemm g{XN, (const bf16_t*)(ws + WS_WIN) + (size_t)NBF * DM, MT, NF32, DM}; pg8::EpiRw E{(bf16_t*)(ws + WS_PRW), (float*)(ws + WS_LF)};
        pg8::gemm_phase<pg8::EpiRw, pg8::StaticOrder, true, true>(lds, g, S, E);
        }
    }
    xcd_barrier(bar);
    STAMP();

    for (int rep_ = 0; rep_ < REP_P3; ++rep_) {
        PHASE_IDS();
        __syncthreads();
        for (int row = gw; row < MT; row += NGW) prep_row(p, row, lane);
    }
    xcd_barrier(bar);
    STAMP();

    {
        { pg8::StaticOrder S; S.init(MT, 2048, G, blk);
          pg8::Gemm g{(const bf16_t*)(ws + WS_ACAT), (const bf16_t*)(ws + WS_WLORA), MT, 2048, 256};
          pg8::EpiLora E{p.in[9], p.in[11], p.out, p.out + (size_t)MT * 1024, (bf16_t*)(ws + WS_G), 0};
          pg8::gemm_phase<pg8::EpiLora, pg8::StaticOrder, true, true>(lds, g, S, E); }
    }
    xcd_barrier(bar);
    STAMP();

    if (blk >= G / 2) {
        pg8::StaticOrder S; S.init(MT, 1024, G - G / 2, blk - G / 2);
        pg8::Gemm g{(const bf16_t*)(ws + WS_ACAT2), (const bf16_t*)(ws + WS_WLORA) + (size_t)2048 * 256, MT, 1024, 256};
        pg8::EpiLora E{p.in[9], p.in[11], p.out, p.out + (size_t)MT * 1024, (bf16_t*)(ws + WS_G), 8};
        pg8::gemm_phase<pg8::EpiLora, pg8::StaticOrder, true, true>(lds, g, S, E);
    }
    {
        PHASE_IDS();
        const int NREC = G / 2;
        if (blk < NREC) {
            for (int rep_ = 0; rep_ < REP_REC; ++rep_)
            for (int job = blk; job < 128; job += NREC)
                rwkv_job(lds, job, p.in[8], p.in[14], p.in[15], (const bf16_t*)(ws + WS_PRW), p.out, p.out + (size_t)MT * 1024, (float*)(ws + WS_YRAW), tid, wave, lane);
        } else {
            const int AW = G - NREC, total = 128 * REP_ATT; int L = blk - NREC;
            for (int Lc = blk - NREC; Lc < 128; Lc += AW) cumsum_job(p, Lc >> 2, lds, tid, wave, lane);
            asm volatile("s_waitcnt vmcnt(0)" ::: "memory"); __syncthreads();
            if (L < total) {
                const fabt* Qn = (const fabt*)(ws + WS_QN); const fabt* Kn = (const fabt*)(ws + WS_KN); const fabt* Vb = (const fabt*)(ws + WS_PBF) + 2048; fabt* O = (fabt*)(ws + WS_O);
                constexpr int W = 1 << 20; char* ldsc = (char*)lds_raw;
                int pass = 0; fa::BlockRef<fabt, fabt> cur = fa_ref(L, 0, Qn, Kn, Vb, O, CUM);
                fa::Seam<fabt> S;
                fa::causal_swa_prime<fabt, fabt, 1024, 1024, PBP>(cur, W, ldsc, S);
                for (;;) {
                    const bool more_pass = pass == 0, more_item = L + AW < total, last = !more_pass && !more_item;
                    int passn = pass + 1, Ln = L;
                    if (!more_pass) { passn = 0; Ln = more_item ? L + AW : L; }
                    const fa::BlockRef<fabt, fabt> nxt = last ? cur : fa_ref(Ln, passn, Qn, Kn, Vb, O, CUM);
                    fa::causal_swa_block<fabt, fabt, 1024, 1024, PBP>(cur, nxt, SEQ, W, ldsc, S);
                    if (last) break;
                    cur = nxt; pass = passn; L = Ln;
                }
            }
            __syncthreads();
            const int aw = (blk - NREC) * 8 + wave, AWV = AW * 8;
            for (int r = aw; r < 32 * (2 * DFF / 64); r += AWV) transpose_item2(p.in[24], 2 * DFF, (bf16_t*)(ws + WS_WGU), DM, r / (2 * DFF / 64), r % (2 * DFF / 64), scr, lane, MapGu());
            for (int r = aw; r < 32 * 32; r += AWV) transpose_item2(p.in[21], DM, (bf16_t*)(ws + WS_WOUT), DM, r / 32, r % 32, scr, lane, MapId());
            for (int r = aw; r < 2 * 16 * 32; r += AWV) { const int q = r & 511; transpose_item2(r < 512 ? p.in[19] : p.in[20], DM, (bf16_t*)(ws + (r < 512 ? WS_WA : WS_WB)), 1024, q / 32, q % 32, scr, lane, MapId()); }
        }
    }
    xcd_barrier(bar);
    STAMP();

    {
        PHASE_IDS();
        for (int row = gw; row < MT; row += NGW) post_row(p, row, lane);
        for (int r = gw; r < (DFF / 64) * 32; r += NGW) transpose_item2(p.in[25], DM, (bf16_t*)(ws + WS_WDOWN), DFF, r / 32, r % 32, scr, lane, MapId());
    }
    xcd_barrier(bar);
    STAMP();

    for (int rep_ = 0; rep_ < REP_P7B; ++rep_) {
        pg8::StaticOrder S; S.init(MT, DM, G, blk);
        pg8::Gemm g{(const bf16_t*)(ws + WS_O), (const bf16_t*)(ws + WS_WA), MT, DM, 1024, (const bf16_t*)(ws + WS_KN), (const bf16_t*)(ws + WS_WB)};
        pg8::EpiMergeDual E{PBF + 4096, PBF + 6144, (bf16_t*)(ws + WS_MERGED)};
        pg8::gemm_phase<pg8::EpiMergeDual, pg8::StaticOrder, true, true, true>(lds, g, S, E);
    }
    xcd_barrier(bar);
    STAMP();

    const bool fusedln = (G == 256);
    if (fusedln) {
        pg8::StaticOrder S; S.init(MT, DM, G, blk);
        pg8::Gemm g{(const bf16_t*)(ws + WS_MERGED), (const bf16_t*)(ws + WS_WOUT), MT, DM, DM};
        pg8::EpiResLnLn E{p.in[0], p.out, XN, MOD, p.in[22], p.in[23], (float*)(ws + WS_SLOT), (float*)(ws + WS_SLOT + 512 * 1024), &bar};
        pg8::gemm_phase<pg8::EpiResLnLn, pg8::StaticOrder, false, true>(lds, g, S, E);
        xcd_barrier(bar);
    } else {
        for (int rep_ = 0; rep_ < REP_P8; ++rep_) {
            pg8::StaticOrder S; S.init(MT, DM, G, blk);
            pg8::Gemm g{(const bf16_t*)(ws + WS_MERGED), (const bf16_t*)(ws + WS_WOUT), MT, DM, DM}; pg8::EpiRes E{p.in[0], p.out, MOD + 2 * DM};
            pg8::gemm_phase<pg8::EpiRes, pg8::StaticOrder, true, true>(lds, g, S, E);
        }
        xcd_barrier(bar);
        STAMP();

        { PHASE_IDS();
        for (int row = gw; row < MT; row += 2 * NGW) {
            const int row2 = row + NGW < MT ? row + NGW : row;
            float* xr = p.out + (size_t)row * DM + lane * 4; float* xr2 = p.out + (size_t)row2 * DM + lane * 4; f32x4 v[8], u[8];
    #pragma unroll
            for (int j = 0; j < 8; ++j) { v[j] = *(const f32x4*)(xr + j * 256); u[j] = *(const f32x4*)(xr2 + j * 256); }
            float mean, rstd, mean2, rstd2; ln_stats(v, mean, rstd); ln_stats(u, mean2, rstd2);
    #pragma unroll
            for (int j = 0; j < 8; ++j) { const int c = j * 256 + lane * 4; const f32x4 g = *(const f32x4*)(p.in[22] + c), b = *(const f32x4*)(p.in[23] + c);
                v[j] = (v[j] - mean) * rstd * g + b; u[j] = (u[j] - mean2) * rstd2 * g + b; *(f32x4*)(xr + j * 256) = v[j]; if (row2 != row) *(f32x4*)(xr2 + j * 256) = u[j]; }
            ln_stats(v, mean, rstd); ln_stats(u, mean2, rstd2);
            const float* mb = MOD + (size_t)(row / SEQ) * NMOD; const float* mb2 = MOD + (size_t)(row2 / SEQ) * NMOD;
            bf16_t* orow = XN + (size_t)row * DM + lane * 4; bf16_t* orow2 = XN + (size_t)row2 * DM + lane * 4;
    #pragma unroll
            for (int j = 0; j < 8; ++j) { const int c = j * 256 + lane * 4;
                { const f32x4 sh = *(const f32x4*)(mb + 3 * DM + c), sc = *(const f32x4*)(mb + 4 * DM + c);
                  const f32x4 o = (v[j] - mean) * rstd * (sc + 1.f) + sh; u32x2 w; w.x = pk2(o[0], o[1]); w.y = pk2(o[2], o[3]); *(u32x2*)(orow + j * 256) = w; }
                if (row2 != row) { const f32x4 sh = *(const f32x4*)(mb2 + 3 * DM + c), sc = *(const f32x4*)(mb2 + 4 * DM + c);
                  const f32x4 o = (u[j] - mean2) * rstd2 * (sc + 1.f) + sh; u32x2 w; w.x = pk2(o[0], o[1]); w.y = pk2(o[2], o[3]); *(u32x2*)(orow2 + j * 256) = w; } }
        } }
        xcd_barrier(bar);
        STAMP();
    }

    for (int rep_ = 0; rep_ < REP_P10; ++rep_) {
        pg8::StaticOrder S; S.init(MT, 2 * DFF, G, blk);
        pg8::Gemm g{XN, (const bf16_t*)(ws + WS_WGU), MT, 2 * DFF, DM}; pg8::EpiSwiGLU E{PBF};
        pg8::gemm_phase<pg8::EpiSwiGLU, pg8::StaticOrder, true, true>(lds, g, S, E);
    }
    xcd_barrier(bar);
    STAMP();

    if (fusedln) {
        pg8::StaticOrder S; S.init(MT, DM, G, blk);
        pg8::Gemm g{PBF, (const bf16_t*)(ws + WS_WDOWN), MT, DM, DFF};
        pg8::EpiResLn E{p.out, p.out, MOD + 5 * DM, p.in[26], p.in[27], (float*)(ws + WS_SLOT + 1024 * 1024), &bar};
        pg8::gemm_phase<pg8::EpiResLn, pg8::StaticOrder, false, true>(lds, g, S, E);
    } else {
        {
            pg8::StaticOrder S; S.init(MT, DM, G, blk);
            pg8::Gemm g{PBF, (const bf16_t*)(ws + WS_WDOWN), MT, DM, DFF}; pg8::EpiRes E{p.out, p.out, MOD + 5 * DM};
            pg8::gemm_phase<pg8::EpiRes, pg8::StaticOrder, true, true>(lds, g, S, E);
        }
        xcd_barrier(bar);
        STAMP();

        { PHASE_IDS();
        for (int row = gw; row < MT; row += 2 * NGW) {
            const int row2 = row + NGW < MT ? row + NGW : row;
            float* xr = p.out + (size_t)row * DM + lane * 4; float* xr2 = p.out + (size_t)row2 * DM + lane * 4; f32x4 v[8], u[8];
    #pragma unroll
            for (int j = 0; j < 8; ++j) { v[j] = *(const f32x4*)(xr + j * 256); u[j] = *(const f32x4*)(xr2 + j * 256); }
            float mean, rstd, mean2, rstd2; ln_stats(v, mean, rstd); ln_stats(u, mean2, rstd2);
    #pragma unroll
            for (int j = 0; j < 8; ++j) { const int c = j * 256 + lane * 4; const f32x4 g = *(const f32x4*)(p.in[26] + c), b = *(const f32x4*)(p.in[27] + c);
                *(f32x4*)(xr + j * 256) = (v[j] - mean) * rstd * g + b; if (row2 != row) *(f32x4*)(xr2 + j * 256) = (u[j] - mean2) * rstd2 * g + b; }
        } }
    }
#if PROBE_MASK
    STAMP();
    if (blockIdx.x == 0 && threadIdx.x == 0) { unsigned long long sp = 0; for (int i = 0; i + 1 < nts; ++i) if ((PROBE_MASK >> i) & 1) sp += tsb[i + 1] - tsb[i];
        const unsigned long long t0 = __builtin_amdgcn_s_memrealtime(); while (__builtin_amdgcn_s_memrealtime() - t0 < sp * PROBE_MULT) __builtin_amdgcn_s_sleep(8); }
#endif
}

extern "C" void kernel_launch(void* const* d_in, const int* in_sizes, int n_in, void* d_out, int out_size, void* d_ws, size_t ws_size, hipStream_t stream) {
    static int grid_blocks = 0;
    if (grid_blocks == 0) {
        if (n_in != 28 || out_size != MT * DM || ws_size < WS_END) { fprintf(stderr, "kernel_launch: unexpected shapes (n_in %d out %d ws %zu, need %zu)\n", n_in, out_size, ws_size, (size_t)WS_END); grid_blocks = -1; return; }
        int dev = 0, cus = 0, per_cu = 0;
        hipGetDevice(&dev);
        hipDeviceGetAttribute(&cus, hipDeviceAttributeMultiprocessorCount, dev);
        hipFuncSetAttribute((const void*)mk_fwd, hipFuncAttributeMaxDynamicSharedMemorySize, LDS_BYTES);
        hipOccupancyMaxActiveBlocksPerMultiprocessor(&per_cu, (const void*)mk_fwd, 512, LDS_BYTES);
        if (per_cu < 1 || cus < 1) { fprintf(stderr, "kernel_launch: occupancy query failed (%d x %d)\n", cus, per_cu); grid_blocks = -1; return; }
        grid_blocks = cus * per_cu;
        if (grid_blocks > 256) grid_blocks = 256;
    }
    if (grid_blocks < 0) return;
    if (hipMemsetAsync((char*)d_ws + WS_BAR, 0, 65536, stream) != hipSuccess) { fprintf(stderr, "kernel_launch: memset of the barrier words failed\n"); return; }
    Params p{};
    for (int i = 0; i < 28; ++i) p.in[i] = (const float*)d_in[i];
    p.out = (float*)d_out; p.ws = (unsigned char*)d_ws;
    void* args[] = {&p};
    hipError_t e = hipLaunchCooperativeKernel((const void*)mk_fwd, dim3(grid_blocks), dim3(512), args, LDS_BYTES, stream);
    if (e != hipSuccess) fprintf(stderr, "cooperative launch failed: %s (grid %d)\n", hipGetErrorString(e), grid_blocks);
}
```

```cpp
#include <hip/hip_runtime.h>
#include <hip/hip_bf16.h>
#include <hip/hip_cooperative_groups.h>
#include <cstdio>
#include <cstdint>
namespace cg = cooperative_groups;

namespace pg8 {
#define PG8_LAS __attribute__((address_space(3)))
typedef unsigned short bf16_t;
typedef short bf16x8 __attribute__((ext_vector_type(8)));
typedef float f32x4 __attribute__((ext_vector_type(4)));
typedef unsigned u32x4 __attribute__((ext_vector_type(4)));
constexpr int BM = 256, BK = 64, HALF = 128, HTB = HALF * BK * 2  , STAGE_BYTES = 8 * HTB, NXCD = 8, WGM = 8;

__host__ __device__ __forceinline__ int lds_byte(int r, int c) { const int st = (r >> 4) * 2 + (c >> 5), rr = r & 15, cc = c & 31, ob = rr * 64 + cc * 2; return st * 1024 + (ob ^ (((ob >> 9) & 1) << 5)); }
__host__ __device__ __forceinline__ void stage_rc(int b, int& R, int& C) { const int st = b / 1024, sb = b % 1024, swz = sb ^ (((sb >> 9) & 1) << 5); R = (st >> 1) * 16 + swz / 64; C = (st & 1) * 32 + (swz % 64) / 2; }
__host__ __device__ __forceinline__ int perm32(int rho) { const int n = rho >> 4, i = rho & 15; return 8 * (i >> 2) + 4 * n + (i & 3); }

struct Unit { int pm, pn; };
struct Gemm { const bf16_t* A; const bf16_t* Bt; int M, N, K; const bf16_t* A2 = nullptr; const bf16_t* Bt2 = nullptr; };

struct StaticOrder {
    int nM, nN, nwg, G, c;
    __host__ __device__ void init(int M, int N, int G_, int c_) { nM = M / BM; nN = N / BM; nwg = nM * nN; G = G_; c = c_; }
    __host__ __device__ bool next(int i, Unit& u) const {
        const long L = (long)i * G + c; if (L >= nwg) return false;
        int wgid = (int)L; { const int q = nwg / NXCD, r = nwg % NXCD, xcd = wgid % NXCD, off = wgid / NXCD; wgid = (xcd < r ? xcd * (q + 1) : r * (q + 1) + (xcd - r) * q) + off; }
        const int nig = WGM * nN, gid = wgid / nig, fm = gid * WGM, gsz = (nM - fm) < WGM ? (nM - fm) : WGM;
        u.pm = fm + ((wgid % nig) % gsz); u.pn = (wgid % nig) / gsz; return true;
    }
    __device__ __forceinline__ void a_ready(const Unit&) const {}
    __device__ __forceinline__ void done(const Unit&) const {}
};
__device__ __forceinline__ unsigned cvt_pk_bf16(float lo, float hi) { unsigned r; asm volatile("v_cvt_pk_bf16_f32 %0, %1, %2" : "=v"(r) : "v"(lo), "v"(hi)); return r; }
typedef float f32x2 __attribute__((ext_vector_type(2)));
template <class Epi, class Sched, bool ALIGN_EPI = false, bool SP2 = false, bool DUAL = false>
__device__ __forceinline__ void gemm_phase(PG8_LAS unsigned char* lds, const Gemm g, const Sched& S, const Epi& E) {
    int tid = threadIdx.x; asm volatile("" : "+v"(tid));
    const int wid = __builtin_amdgcn_readfirstlane(tid >> 6), lane = tid & 63, wr = wid >> 2, wc = wid & 3, fr = lane & 15, fq = lane >> 4;
    const int K = g.K, HT = K / BK, nt = DUAL ? 2 * HT : HT;
    unsigned voffA[2], voffB[2];
#pragma unroll
    for (int i = 0; i < 2; ++i) { int R, C; stage_rc(tid * 16 + i * 8192, R, C); const int Rb = Epi::PERM ? ((R & ~31) + perm32(R & 31)) : R;
        voffA[i] = (unsigned)(R * K + C) * 2u; voffB[i] = (unsigned)(Rb * K + C) * 2u; }
    const size_t kstep = (size_t)(BK * 2);
    const size_t hstep = (size_t)HALF * K * 2;
    const size_t tstep = 2 * hstep;
    const unsigned ldsw = (unsigned)wid * 1024u;
    const int aoff = lds_byte(wr * 64 + fr, fq * 8), boff = lds_byte(wc * 32 + fr, fq * 8);
#define PG8_SA(b, h) (((b) * 2 + (h)) * HTB)
#define PG8_SB(b, h) ((4 + (b) * 2 + (h)) * HTB)
#define PG8_STAGE(bufoff, gbase, voff) do { _Pragma("unroll") for (int _i = 0; _i < 2; ++_i) \
        __builtin_amdgcn_global_load_lds((const unsigned*)((const char*)(gbase) + (voff)[_i]), (PG8_LAS unsigned*)(lds + (bufoff) + ldsw + _i * 8192), 16, 0, 0); } while (0)
#define PG8_LDA(dst, b, h) do { _Pragma("unroll") for (int m = 0; m < 4; ++m) _Pragma("unroll") for (int k = 0; k < 2; ++k) dst[m][k] = *(const PG8_LAS bf16x8*)(lds + PG8_SA(b, h) + aoff + m * 2048 + k * 1024); } while (0)
#define PG8_LDB(dst, b, h) do { _Pragma("unroll") for (int n = 0; n < 2; ++n) _Pragma("unroll") for (int k = 0; k < 2; ++k) dst[n][k] = *(const PG8_LAS bf16x8*)(lds + PG8_SB(b, h) + boff + n * 2048 + k * 1024); } while (0)
#define PG8_MMA(ai, bj, At, Bt) do { __builtin_amdgcn_s_setprio(1); _Pragma("unroll") for (int m = 0; m < 4; ++m) _Pragma("unroll") for (int n = 0; n < 2; ++n) _Pragma("unroll") for (int k = 0; k < 2; ++k) \
        acc[ai][bj][m][n] = __builtin_amdgcn_mfma_f32_16x16x32_bf16(Bt[n][k], At[m][k], acc[ai][bj][m][n], 0, 0, 0); __builtin_amdgcn_s_setprio(0); } while (0)
#define PG8_WAIT_V(n) asm volatile("s_waitcnt vmcnt(" #n ")" ::: "memory")
#define PG8_WAIT_L(n) asm volatile("s_waitcnt lgkmcnt(" #n ")" ::: "memory")
#define PG8_BAR __builtin_amdgcn_s_barrier()
#define PG8_SCHED __builtin_amdgcn_sched_barrier(0)
    Unit cur, nxt; int ui = 0;
    if (!S.next(0, cur)) return;
    f32x4 acc[2][2][4][2];
#pragma unroll
    for (int a = 0; a < 2; ++a)
#pragma unroll
        for (int b = 0; b < 2; ++b)
#pragma unroll
            for (int m = 0; m < 4; ++m)
#pragma unroll
                for (int n = 0; n < 2; ++n) acc[a][b][m][n] = (f32x4){0.f, 0.f, 0.f, 0.f};
    bf16x8 At[4][2], B0[2][2], B1[2][2];
    const char* cA = (const char*)g.A + (size_t)cur.pm * tstep; const char* cB = (const char*)g.Bt + (size_t)cur.pn * tstep;
    S.a_ready(cur);
    if constexpr (SP2) {
        PG8_STAGE(PG8_SB(0, 0), cB, voffB); PG8_STAGE(PG8_SB(0, 1), cB + hstep, voffB); PG8_STAGE(PG8_SA(0, 0), cA, voffA); PG8_STAGE(PG8_SA(0, 1), cA + hstep, voffA);
        if (wr == 1) PG8_BAR;
        PG8_WAIT_V(2); PG8_BAR;
        PG8_STAGE(PG8_SB(1, 0), cB + kstep, voffB); PG8_STAGE(PG8_SA(1, 0), cA + kstep, voffA); PG8_STAGE(PG8_SB(1, 1), cB + hstep + kstep, voffB);
        PG8_WAIT_V(6); PG8_BAR;
    } else {
        PG8_STAGE(PG8_SB(0, 0), cB, voffB); PG8_STAGE(PG8_SA(0, 0), cA, voffA); PG8_STAGE(PG8_SB(0, 1), cB + hstep, voffB); PG8_STAGE(PG8_SA(0, 1), cA + hstep, voffA);
        if (wr == 1) PG8_BAR;
        PG8_WAIT_V(4); PG8_BAR;
        PG8_STAGE(PG8_SB(1, 0), cB + kstep, voffB); PG8_STAGE(PG8_SA(1, 0), cA + kstep, voffA); PG8_STAGE(PG8_SB(1, 1), cB + hstep + kstep, voffB);
        PG8_WAIT_V(6); PG8_BAR;
    }
    for (;;) {
        const bool has_next = S.next(ui + 1, nxt);
        const char* cA2 = DUAL ? (const char*)g.A2 + (size_t)cur.pm * tstep - (size_t)HT * kstep : cA; const char* cB2 = DUAL ? (const char*)g.Bt2 + (size_t)cur.pn * tstep - (size_t)HT * kstep : cB;
        const char* nA = has_next ? (const char*)g.A + (size_t)nxt.pm * tstep : cA; const char* nB = has_next ? (const char*)g.Bt + (size_t)nxt.pn * tstep : cB;
        for (int t = 0; t < nt; t += 2) {
            const bool last = (t == nt - 2);
            const char* bA0 = (DUAL && t >= HT) ? cA2 : cA; const char* bA2 = (DUAL && t + 2 >= HT) ? cA2 : cA; const char* bB2 = (DUAL && t + 2 >= HT) ? cB2 : cB;
            if constexpr (DUAL) { if (t == HT) E.mid(acc, cur, wr, wc, fr, fq); }
            const char* a1 = bA0 + (size_t)(t + 1) * kstep;
            const char* a2 = last ? nA : bA2 + (size_t)(t + 2) * kstep; const char* b2 = last ? nB : bB2 + (size_t)(t + 2) * kstep;
            const char* a3 = a2 + kstep; const char* b3 = b2 + kstep;
            if (last && has_next) S.a_ready(nxt);
            if constexpr (SP2) {
            PG8_LDB(B0, 0, 0); PG8_LDB(B1, 0, 1); PG8_SCHED; PG8_LDA(At, 0, 0); PG8_STAGE(PG8_SA(1, 1), a1 + hstep, voffA);
            PG8_WAIT_V(8); PG8_WAIT_L(0); PG8_BAR; PG8_MMA(0, 0, At, B0); PG8_MMA(0, 1, At, B1); PG8_BAR; PG8_SCHED;
            PG8_LDA(At, 0, 1); PG8_STAGE(PG8_SB(0, 0), b2, voffB); PG8_STAGE(PG8_SB(0, 1), b2 + hstep, voffB); PG8_STAGE(PG8_SA(0, 0), a2, voffA);
            PG8_WAIT_V(8); PG8_WAIT_L(0); PG8_BAR; PG8_MMA(1, 0, At, B0); PG8_MMA(1, 1, At, B1); PG8_BAR; PG8_SCHED;
            PG8_LDB(B0, 1, 0); PG8_LDB(B1, 1, 1); PG8_SCHED; PG8_LDA(At, 1, 0); PG8_STAGE(PG8_SA(0, 1), a2 + hstep, voffA);
            PG8_WAIT_V(8); PG8_WAIT_L(0); PG8_BAR; PG8_MMA(0, 0, At, B0); PG8_MMA(0, 1, At, B1); PG8_BAR; PG8_SCHED;
            PG8_LDA(At, 1, 1); PG8_STAGE(PG8_SB(1, 0), b3, voffB); PG8_STAGE(PG8_SB(1, 1), b3 + hstep, voffB); PG8_STAGE(PG8_SA(1, 0), a3, voffA);
            PG8_WAIT_V(8); PG8_WAIT_L(0); PG8_BAR; PG8_MMA(1, 0, At, B0); PG8_MMA(1, 1, At, B1); PG8_BAR; PG8_SCHED;
            } else {
            PG8_LDB(B0, 0, 0); PG8_SCHED; PG8_LDA(At, 0, 0); PG8_STAGE(PG8_SA(1, 1), a1 + hstep, voffA);
            PG8_WAIT_L(8); PG8_BAR; PG8_WAIT_L(0); PG8_MMA(0, 0, At, B0); PG8_BAR; PG8_SCHED;
            PG8_LDB(B1, 0, 1); PG8_STAGE(PG8_SB(0, 0), b2, voffB);
            PG8_BAR; PG8_WAIT_L(0); PG8_MMA(0, 1, At, B1); PG8_BAR;
            PG8_LDA(At, 0, 1); PG8_STAGE(PG8_SA(0, 0), a2, voffA);
            PG8_BAR; PG8_WAIT_L(0); PG8_MMA(1, 0, At, B0); PG8_BAR; PG8_SCHED;
            PG8_STAGE(PG8_SB(0, 1), b2 + hstep, voffB);
            PG8_WAIT_V(6); PG8_BAR; PG8_MMA(1, 1, At, B1); PG8_BAR;
            PG8_LDB(B0, 1, 0); PG8_SCHED; PG8_LDA(At, 1, 0); PG8_STAGE(PG8_SA(0, 1), a2 + hstep, voffA);
            PG8_WAIT_L(8); PG8_BAR; PG8_WAIT_L(0); PG8_MMA(0, 0, At, B0); PG8_BAR; PG8_SCHED;
            PG8_LDB(B1, 1, 1); PG8_STAGE(PG8_SB(1, 0), b3, voffB);
            PG8_BAR; PG8_WAIT_L(0); PG8_MMA(0, 1, At, B1); PG8_BAR;
            PG8_LDA(At, 1, 1); PG8_STAGE(PG8_SA(1, 0), a3, voffA);
            PG8_BAR; PG8_WAIT_L(0); PG8_MMA(1, 0, At, B0); PG8_BAR; PG8_SCHED;
            PG8_STAGE(PG8_SB(1, 1), b3 + hstep, voffB);
            PG8_WAIT_V(6); PG8_BAR; PG8_MMA(1, 1, At, B1); PG8_BAR;
            }
        }
        if constexpr (ALIGN_EPI) { if (wr == 0) PG8_BAR; }
        if constexpr (!Epi::AFTER_DRAIN) { E(acc, cur, wr, wc, fr, fq); S.done(cur); }
        if (!has_next) break;
#pragma unroll
        for (int a = 0; a < 2; ++a)
#pragma unroll
            for (int b = 0; b < 2; ++b)
#pragma unroll
                for (int m = 0; m < 4; ++m)
#pragma unroll
                    for (int n = 0; n < 2; ++n) acc[a][b][m][n] = (f32x4){0.f, 0.f, 0.f, 0.f};
        cur = nxt; cA = nA; cB = nB; ++ui;
        if constexpr (ALIGN_EPI) { if (wr == 1) PG8_BAR; }
    }
    PG8_WAIT_V(0);
    if constexpr (!ALIGN_EPI) { if (wr == 0) PG8_BAR; }
    PG8_BAR;
    if constexpr (Epi::AFTER_DRAIN) { E.fused(acc, cur, wr, wc, fr, fq, lds, wid, lane); S.done(cur); }
#undef PG8_SA
#undef PG8_SB
#undef PG8_STAGE
#undef PG8_LDA
#undef PG8_LDB
#undef PG8_MMA
#undef PG8_WAIT_V
#undef PG8_WAIT_L
#undef PG8_BAR
#undef PG8_SCHED
}
}
namespace fa {
constexpr int D = 128; constexpr bool WSKIP = false; constexpr float THR = 8.f;
constexpr float SCALE = 0.08838834764831845f;
constexpr int NW = 8, QBLK = 32, KVBLK = 64, QB = NW * QBLK;
constexpr int SHM_V = KVBLK * D * 2, SHM_K = KVBLK * D * 2;
constexpr int LDS_BYTES = 2 * SHM_V + 2 * SHM_K + NW * 64 * 4;
constexpr int KB_OFF = LDS_BYTES;
constexpr int FA_LDS_BYTES = LDS_BYTES + 2 * 2048 * 4;
__device__ __forceinline__ void load_kbias(const float* CB, int P0, float* dst) {
    const float c0 = CB[P0]; const float inv = 1.0f / SCALE;
    for (int s = threadIdx.x; s < P0 + QB; s += 512) dst[s] = (c0 - CB[s]) * inv;
}
using bf16 = __hip_bfloat16;
typedef short bf16x8 __attribute__((ext_vector_type(8)));
typedef short s16x4 __attribute__((ext_vector_type(4)));
typedef float f32x16 __attribute__((ext_vector_type(16)));
typedef float f32x4 __attribute__((ext_vector_type(4)));
typedef unsigned u32x4 __attribute__((ext_vector_type(4)));
template <class A, class Bt> struct same_t { static constexpr bool v = false; };
template <class A> struct same_t<A, A> { static constexpr bool v = true; };

#define KSWZ(row, colB) ((row) * 256 + ((colB) ^ (((row) & 7) << 4)))
#define SBAR() __builtin_amdgcn_sched_barrier(0)
__device__ __forceinline__ int v_st(int k, int c) { const int kk = (k & ~0xC) | ((k & 4) << 1) | ((k & 8) >> 1); return ((kk >> 3) * 4 + (c >> 5)) * 512 + ((kk & 7) * 32 + (c & 31)) * 2; }
__device__ __forceinline__ int v_rd_base(int lane) { return ((lane & 3) << 3) | (((lane >> 2) & 3) << 6) | (((lane >> 4) & 1) << 5) | (((lane >> 5) & 1) << 8); }
constexpr int v_rd_off(int d0, int ks, int half) { return d0 * 512 + ks * 4096 + half * 2048; }
__device__ __forceinline__ int crow(int r, int hi) { return (r & 3) + 8 * (r >> 2) + 4 * hi; }
__device__ __forceinline__ unsigned cvtpk(float lo, float hi) {
    unsigned r; asm volatile("v_cvt_pk_bf16_f32 %0, %1, %2" : "=v"(r) : "v"(lo), "v"(hi)); return r;
}
__device__ __forceinline__ bf16x8 pack8(f32x4 a, f32x4 b) {
    u32x4 w = {cvtpk(a[0], a[1]), cvtpk(a[2], a[3]), cvtpk(b[0], b[1]), cvtpk(b[2], b[3])};
    return *reinterpret_cast<bf16x8*>(&w);
}
template <class T> __device__ __forceinline__ bf16x8 load8(const T* p) {
    if constexpr (same_t<T, float>::v) { return pack8(*(const f32x4*)p, *(const f32x4*)(p + 4)); }
    else { return *reinterpret_cast<const bf16x8*>(p); }
}
__device__ __forceinline__ void mask_tile(f32x16& p0, f32x16& p1, int dq, unsigned W) {
    const float NEG = -__builtin_inff();
#pragma unroll
    for (int r = 0; r < 16; ++r) {
        const int c = (r & 3) + 8 * (r >> 2);
        if ((unsigned)(dq - c) >= W) p0[r] = NEG;
        if ((unsigned)(dq - c - 32) >= W) p1[r] = NEG;
    }
}
__device__ __forceinline__ void partialSM(f32x16& p0, f32x16& p1, float& m_reg, float& mn, float& alpha) {
    float pmax = p0[0]; for (int r = 1; r < 16; ++r) pmax = fmaxf(pmax, p0[r]); for (int r = 0; r < 16; ++r) pmax = fmaxf(pmax, p1[r]);
    { auto rr = __builtin_amdgcn_permlane32_swap(__float_as_uint(pmax), __float_as_uint(pmax), false, false);
      pmax = fmaxf(__uint_as_float(rr[0]), __uint_as_float(rr[1])); }
    constexpr float C2 = 1.4426950408889634f * SCALE;
    if (__builtin_expect(__all((pmax - m_reg) * SCALE <= THR), 1)) { mn = m_reg; alpha = 1.f; }
    else { mn = fmaxf(m_reg, pmax); alpha = __builtin_amdgcn_exp2f((m_reg - mn) * C2); m_reg = mn; }
    const float mnL = -mn * C2;
    for (int r = 0; r < 16; ++r) p0[r] = fmaf(p0[r], C2, mnL); for (int r = 0; r < 16; ++r) p1[r] = fmaf(p1[r], C2, mnL);
    for (int r = 0; r < 16; ++r) p0[r] = __builtin_amdgcn_exp2f(p0[r]);
}
__device__ __forceinline__ void finishSM(f32x16& p0, f32x16& p1, float alpha, float& l_reg, bf16x8& pa0, bf16x8& pa1, bf16x8& pa2, bf16x8& pa3) {
    for (int r = 0; r < 16; ++r) p1[r] = __builtin_amdgcn_exp2f(p1[r]);
    float ps = 0; for (int r = 0; r < 16; ++r) ps += p0[r]; for (int r = 0; r < 16; ++r) ps += p1[r];
    { auto rr = __builtin_amdgcn_permlane32_swap(__float_as_uint(ps), __float_as_uint(ps), false, false);
      ps = __uint_as_float(rr[0]) + __uint_as_float(rr[1]); }
    l_reg = l_reg * alpha + ps;
#define PK4(P, B_, OUT) do { unsigned a0 = cvtpk(P[B_+0], P[B_+1]), a1 = cvtpk(P[B_+2], P[B_+3]);                          \
        unsigned b0 = cvtpk(P[B_+4], P[B_+5]), b1 = cvtpk(P[B_+6], P[B_+7]);                                             \
        auto r0 = __builtin_amdgcn_permlane32_swap(a0, b0, false, false); auto r1 = __builtin_amdgcn_permlane32_swap(a1, b1, false, false); \
        u32x4 w = {r0[0], r1[0], r0[1], r1[1]}; OUT = *reinterpret_cast<bf16x8*>(&w); } while (0)
    PK4(p0, 0, pa0); PK4(p0, 8, pa1); PK4(p1, 0, pa2); PK4(p1, 8, pa3);
#undef PK4
}
template <int KB, bool SK>
__device__ __forceinline__ void qkt(f32x16& p0, f32x16& p1, const char* K_lds, int r32, int hi, const bf16x8* qr, bool act, const float* kbp) {
    if (SK && !act) { const float NEG = -__builtin_inff();
#pragma unroll
        for (int r = 0; r < 16; ++r) { p0[r] = NEG; p1[r] = NEG; } return; }
    p0 = f32x16{}; p1 = f32x16{};
    const char* kb[4];
#pragma unroll
    for (int dd = 0; dd < 4; ++dd) kb[dd] = K_lds + KB * SHM_K + KSWZ(r32, (dd * 16 + hi * 8) * 2);
#pragma unroll
    for (int d0 = 0; d0 < 8; ++d0) { const char* a = kb[d0 & 3] + (d0 >> 2) * 128;
        bf16x8 b0 = *reinterpret_cast<const bf16x8*>(a);
        bf16x8 b1 = *reinterpret_cast<const bf16x8*>(a + 32 * 256);
        p0 = __builtin_amdgcn_mfma_f32_32x32x16_bf16(b0, qr[d0], p0, 0, 0, 0);
        p1 = __builtin_amdgcn_mfma_f32_32x32x16_bf16(b1, qr[d0], p1, 0, 0, 0); }
    {
        const float c0_ = hi ? 0.f : kbp[r32], c1_ = hi ? 0.f : kbp[32 + r32];
        const unsigned hp = cvtpk(c0_, c1_); const float r0_ = c0_ - __uint_as_float(hp << 16), r1_ = c1_ - __uint_as_float(hp & 0xffff0000u);
        const unsigned mp = cvtpk(r0_, r1_); const unsigned lp = cvtpk(r0_ - __uint_as_float(mp << 16), r1_ - __uint_as_float(mp & 0xffff0000u));
        u32x4 k0_ = {(hp & 0xffffu) | (mp << 16), lp & 0xffffu, 0u, 0u}, k1_ = {(hp >> 16) | (mp & 0xffff0000u), lp >> 16, 0u, 0u};
        const u32x4 q1_ = {0x3F803F80u, 0x00003F80u, 0u, 0u};
        p0 = __builtin_amdgcn_mfma_f32_32x32x16_bf16(*reinterpret_cast<bf16x8*>(&k0_), *reinterpret_cast<const bf16x8*>(&q1_), p0, 0, 0, 0);
        p1 = __builtin_amdgcn_mfma_f32_32x32x16_bf16(*reinterpret_cast<bf16x8*>(&k1_), *reinterpret_cast<const bf16x8*>(&q1_), p1, 0, 0, 0); }
}
template <int VB, bool SK>
__device__ __forceinline__ void pv_tile(f32x16* o, int vb0, bf16x8 pa0, bf16x8 pa1, bf16x8 pa2, bf16x8 pa3, bool act) {
    if (SK && !act) return;
#define TRRD(dst, off) asm volatile("ds_read_b64_tr_b16 %0, %1 offset:%2" : "=&v"(dst) : "v"(vb0), "i"(off) : "memory")
#define PV_D0(d0) do { s16x4 l0, l1, l2, l3, h0, h1, h2, h3; constexpr int b_ = VB * SHM_V + v_rd_off(d0, 0, 0);     \
        TRRD(l0, b_); TRRD(h0, b_ + 2048); TRRD(l1, b_ + 4096); TRRD(h1, b_ + 6144); TRRD(l2, b_ + 8192); TRRD(h2, b_ + 10240); TRRD(l3, b_ + 12288); TRRD(h3, b_ + 14336); \
        asm volatile("s_waitcnt lgkmcnt(0)" ::: "memory"); SBAR();                 \
        o[d0] = __builtin_amdgcn_mfma_f32_32x32x16_bf16(pa0, (bf16x8){l0[0], l0[1], l0[2], l0[3], h0[0], h0[1], h0[2], h0[3]}, o[d0], 0, 0, 0);   \
        o[d0] = __builtin_amdgcn_mfma_f32_32x32x16_bf16(pa1, (bf16x8){l1[0], l1[1], l1[2], l1[3], h1[0], h1[1], h1[2], h1[3]}, o[d0], 0, 0, 0);   \
        o[d0] = __builtin_amdgcn_mfma_f32_32x32x16_bf16(pa2, (bf16x8){l2[0], l2[1], l2[2], l2[3], h2[0], h2[1], h2[2], h2[3]}, o[d0], 0, 0, 0);   \
        o[d0] = __builtin_amdgcn_mfma_f32_32x32x16_bf16(pa3, (bf16x8){l3[0], l3[1], l3[2], l3[3], h3[0], h3[1], h3[2], h3[3]}, o[d0], 0, 0, 0); } while (0)
    PV_D0(0); PV_D0(1); PV_D0(2); PV_D0(3);
#undef PV_D0
#undef TRRD
}
template <class TIn, class TOut> struct BlockRef { const TIn* Q; const TIn* K; const TIn* V; TOut* O; const TOut* SG; const float* CB; int P0; };
template <class TIn> struct Seam {
    bf16x8 qr[8];
    bf16x8 st_v0, st_v1, st_k0, st_k1; f32x4 sf0, sf1, sf2, sf3;
    int kbsel;
};
__device__ __forceinline__ int swa_jlo(int P0, int W) { const int lowk = P0 - W + 1; return lowk > 0 ? lowk / KVBLK : 0; }
#define ROW(p, k0, rr) ((p) + (size_t)((k0) + (rr)) * D + sc)
#define VMW() asm volatile("s_waitcnt vmcnt(0)" ::: "memory")
#define VMWN(n) asm volatile("s_waitcnt vmcnt(%0)" :: "i"(n) : "memory")
#define ROWK(p, k0, rr) ((p) + (size_t)((k0) + (rr)) * KP + sc)
#define ROWV(p, k0, rr) ((p) + (size_t)((k0) + (rr)) * VP + sc)
#define SLOAD_H(Kp, Vp, k0) do { S.st_v0 = load8<TIn>(ROWV(Vp, k0, sr)); S.st_v1 = load8<TIn>(ROWV(Vp, k0, 32 + sr));              \
                         S.st_k0 = load8<TIn>(ROWK(Kp, k0, sr)); S.st_k1 = load8<TIn>(ROWK(Kp, k0, 32 + sr)); } while (0)
#define SWRITE_HK(bf) do { *(bf16x8*)(K_lds + (bf) * SHM_K + kws) = S.st_k0; *(bf16x8*)(K_lds + (bf) * SHM_K + kws + 32 * 256) = S.st_k1; } while (0)
#define SWRITE_HV(bf) do { *(bf16x8*)(V_lds + (bf) * SHM_V + vst0) = S.st_v0; *(bf16x8*)(V_lds + (bf) * SHM_V + vst1) = S.st_v1; } while (0)
#define SWRITE_H(bf) do { SWRITE_HV(bf); SWRITE_HK(bf); } while (0)
#define SLOAD_F(p, k0) do { S.sf0 = *(const f32x4*)ROW(p, k0, sr); S.sf1 = *(const f32x4*)(ROW(p, k0, sr) + 4);                \
                            S.sf2 = *(const f32x4*)ROW(p, k0, 32 + sr); S.sf3 = *(const f32x4*)(ROW(p, k0, 32 + sr) + 4); } while (0)
#define SWRITE_KF(bf) do { *(bf16x8*)(K_lds + (bf) * SHM_K + kws) = pack8(S.sf0, S.sf1); *(bf16x8*)(K_lds + (bf) * SHM_K + kws + 32 * 256) = pack8(S.sf2, S.sf3); } while (0)
#define SWRITE_VF(bf) do { *(bf16x8*)(V_lds + (bf) * SHM_V + vst0) = pack8(S.sf0, S.sf1); *(bf16x8*)(V_lds + (bf) * SHM_V + vst1) = pack8(S.sf2, S.sf3); } while (0)
template <class TIn, class TOut, int QP, int KP, int VP>
__device__ __forceinline__ void causal_swa_prime(const BlockRef<TIn, TOut>& cur, int W, char* lds, Seam<TIn>& S) {
    constexpr bool F32 = same_t<TIn, float>::v;
    int tid = threadIdx.x; asm volatile("" : "+v"(tid));
    const int wid = __builtin_amdgcn_readfirstlane(tid >> 6), lane = tid & 63, r32 = lane & 31, hi = lane >> 5;
    const int sr = tid >> 4, sc = (tid & 15) * 8, kws = KSWZ(sr, sc * 2); char* K_lds = lds + 2 * SHM_V;
    const int kb0 = swa_jlo(cur.P0, W) * KVBLK;
    for (int d0 = 0; d0 < 8; ++d0) S.qr[d0] = load8<TIn>(cur.Q + (size_t)(wid * QBLK + r32) * QP + d0 * 16 + hi * 8);
    if constexpr (F32) { SLOAD_F((const float*)cur.K, kb0); VMW(); SWRITE_KF(0); SBAR(); SLOAD_F((const float*)cur.V, kb0); }
    else { SLOAD_H(cur.K, cur.V, kb0); VMW(); SWRITE_HK(0); }
    load_kbias(cur.CB, cur.P0, (float*)(lds + KB_OFF)); S.kbsel = 0;
    __syncthreads();
}
template <class TIn, class TOut, int QP, int KP, int VP>
__device__ __forceinline__ void causal_swa_block(const BlockRef<TIn, TOut>& cur, const BlockRef<TIn, TOut>& nxt, int skv, int W, char* lds, Seam<TIn>& S) {
    constexpr bool F32 = same_t<TIn, float>::v;
    int tid = threadIdx.x; asm volatile("" : "+v"(tid));
    const int wid = __builtin_amdgcn_readfirstlane(tid >> 6), lane = tid & 63, r32 = lane & 31, hi = lane >> 5;
    const int j_lo = swa_jlo(cur.P0, W);
    int j_hi = (cur.P0 + QB - 1) / KVBLK + 1; if (j_hi > skv / KVBLK) j_hi = skv / KVBLK;
    const int NT = j_hi - j_lo;
    const int kbn = swa_jlo(nxt.P0, W) * KVBLK;
    const int qlo = cur.P0 + wid * QBLK, qm = qlo + r32 - 4 * hi;
    char* V_lds = lds; char* K_lds = lds + 2 * SHM_V; const float* kbl = (const float*)(lds + KB_OFF) + S.kbsel * 2048;
    float* ws = (float*)(lds + 2 * SHM_V + 2 * SHM_K) + wid * 64; float* li_l = ws, * al_l = ws + 32;
    float m_reg = -1e30f, l_reg = 0; f32x16 o[4] = {};
    const int sr = tid >> 4, sc = (tid & 15) * 8, vst0 = v_st(sr, sc), vst1 = v_st(32 + sr, sc), kws = KSWZ(sr, sc * 2);
    const int vb0 = (int)(uintptr_t)V_lds + v_rd_base(lane);
    const TIn* Kh = cur.K; const TIn* Vh = cur.V;
#define RESC(a) do { if (__any((a) < 1.f)) { if (hi == 0) al_l[r32] = (a); asm volatile("s_waitcnt lgkmcnt(0)" ::: "memory");              \
                     for (int d_ = 0; d_ < 4; ++d_) for (int r = 0; r < 16; ++r) o[d_][r] *= al_l[crow(r, hi)]; } } while (0)
#define KBASE(t) ((j_lo + (t)) * KVBLK)
#define KBP(t) (kbl + KBASE(t))
#define ACT(t) (KBASE(t) <= qlo + QBLK - 1 && KBASE(t) + KVBLK - 1 >= qlo - W + 1)
#define MASKT(P0_, P1_, t) do { const int kb_ = KBASE(t); if ((!SK || ACT(t)) && (kb_ + KVBLK - 1 > qlo || kb_ <= qlo + QBLK - 1 - W)) mask_tile(P0_, P1_, qm - kb_, (unsigned)W); } while (0)
    constexpr int NQL = F32 ? 16 : 8;
    constexpr bool SK = WSKIP && !F32;
#define SEAM_K0() do { VMWN(NQL); if constexpr (F32) { SWRITE_KF(0); SBAR(); SLOAD_F((const float*)nxt.V, kbn); } else { SWRITE_HK(0); } SBAR(); } while (0)
    f32x16 pA0, pA1, pB0, pB1; float mnA, mnB, alA, alB; bf16x8 pa0, pa1, pa2, pa3;
    if constexpr (F32) { VMW(); SWRITE_VF(0); SBAR(); } else { SWRITE_HV(0); SBAR(); }
    if (NT > 1) { if constexpr (F32) SLOAD_F((const float*)Kh, KBASE(1)); else SLOAD_H(Kh, Vh, KBASE(1)); }
    SBAR(); qkt<0, SK>(pA0, pA1, K_lds, r32, hi, S.qr, ACT(0), KBP(0));
    if constexpr (F32) { if (NT > 1) { VMW(); SWRITE_KF(1); SBAR(); SLOAD_F((const float*)Vh, KBASE(1)); } }
    MASKT(pA0, pA1, 0); partialSM(pA0, pA1, m_reg, mnA, alA);
    if (NT > 1) { VMW(); if constexpr (F32) { SWRITE_VF(1); SBAR(); if (NT > 2) SLOAD_F((const float*)Kh, KBASE(2)); } else SWRITE_H(1); }
    __syncthreads();
#define HALF_STEP(PX0, PX1, mnX, alX, PY0, PY1, alY, t, KB, VB, SB) do {                                                      \
        SBAR(); qkt<KB, SK>(PX0, PX1, K_lds, r32, hi, S.qr, ACT(t), KBP(t));                                             \
        finishSM(PY0, PY1, alY, l_reg, pa0, pa1, pa2, pa3); SBAR();                                                           \
        if ((t) + 1 < NT) { if constexpr (F32) { VMW(); SWRITE_KF(SB); SBAR(); SLOAD_F((const float*)Vh, KBASE((t) + 1)); }  \
                            else { SLOAD_H(Kh, Vh, KBASE((t) + 1)); } SBAR(); }                                               \
        pv_tile<VB, SK>(o, vb0, pa0, pa1, pa2, pa3, ACT((t) - 1)); MASKT(PX0, PX1, (t)); partialSM(PX0, PX1, m_reg, mnX, alX);                                        \
        __syncthreads();                                                                                                      \
        if ((t) + 1 < NT) { VMW(); if constexpr (F32) { SWRITE_VF(SB); SBAR(); if ((t) + 2 < NT) SLOAD_F((const float*)Kh, KBASE((t) + 2)); } \
                            else { SWRITE_H(SB); } }                                                                          \
        RESC(alX); __syncthreads(); } while (0)
    for (int t = 1; t + 1 < NT; t += 2) {
        HALF_STEP(pB0, pB1, mnB, alB, pA0, pA1, alA, t, 1, 0, 0);
        HALF_STEP(pA0, pA1, mnA, alA, pB0, pB1, alB, t + 1, 0, 1, 1);
    }
    const bool even = (NT & 1) == 0;
    if (even) { SBAR(); qkt<1, SK>(pB0, pB1, K_lds, r32, hi, S.qr, ACT(NT - 1), KBP(NT - 1)); SBAR(); }
#define QROW(e) (nxt.Q + (size_t)(wid * QBLK + r32) * D + ((e) >> 1) * 16 + hi * 8 + ((e) & 1) * 4)
    if constexpr (F32) { SLOAD_F((const float*)nxt.K, kbn); SBAR();
#pragma unroll
        for (int e = 0; e < 8; ++e) (void)0; }
    else { SLOAD_H(nxt.K, nxt.V, kbn); SBAR();
#pragma unroll
        for (int d0 = 0; d0 < 8; ++d0) S.qr[d0] = load8<TIn>(nxt.Q + (size_t)(wid * QBLK + r32) * QP + d0 * 16 + hi * 8); }
    SBAR();
    finishSM(pA0, pA1, alA, l_reg, pa0, pa1, pa2, pa3); SBAR();
    if constexpr (F32) {
#pragma unroll
        for (int e = 8; e < 16; ++e) (void)0; SBAR(); }
#undef QROW
    pv_tile<0, SK>(o, vb0, pa0, pa1, pa2, pa3, ACT(even ? NT - 2 : NT - 1));
    if (even) { MASKT(pB0, pB1, NT - 1); partialSM(pB0, pB1, m_reg, mnB, alB); __syncthreads(); RESC(alB);
        finishSM(pB0, pB1, alB, l_reg, pa0, pa1, pa2, pa3); SBAR(); pv_tile<1, SK>(o, vb0, pa0, pa1, pa2, pa3, ACT(NT - 1)); }
    SBAR(); SEAM_K0();
    if (hi == 0) li_l[r32] = l_reg; asm volatile("s_waitcnt lgkmcnt(0)" ::: "memory");
    float rli[16];
#pragma unroll
    for (int r = 0; r < 16; ++r) rli[r] = __builtin_amdgcn_rcpf(li_l[crow(r, hi)]);
    TOut* Ow = cur.O + (size_t)(wid * QBLK) * QP; const TOut* SGw = cur.SG + (size_t)(wid * QBLK) * VP;
#pragma unroll
    for (int r = 0; r < 16; ++r) { const int orow = crow(r, hi);
#pragma unroll
        for (int d0 = 0; d0 < 4; ++d0) { const float v = o[d0][r] * rli[r] * __bfloat162float(SGw[(size_t)orow * VP + d0 * 32 + r32]);
            if constexpr (same_t<TOut, float>::v) { Ow[(size_t)orow * QP + d0 * 32 + r32] = v; }
            else { const float vn = __shfl_xor(v, 1);
                   if ((r32 & 1) == 0) *(unsigned*)(Ow + (size_t)orow * QP + d0 * 32 + r32) = cvtpk(v, vn); } } }
    if constexpr (F32) {
#pragma unroll
        for (int d0 = 0; d0 < 8; ++d0) (void)0; }
    load_kbias(nxt.CB, nxt.P0, (float*)(lds + KB_OFF) + (S.kbsel ^ 1) * 2048);
    __syncthreads();
    S.kbsel ^= 1;
#undef RESC
#undef KBASE
#undef KBP
#undef ACT
#undef MASKT
#undef SEAM_K0
#undef HALF_STEP
}
#undef ROW
#undef VMW
#undef VMWN
#undef SLOAD_H
#undef SWRITE_HK
#undef SWRITE_HV
#undef SWRITE_H
#undef SLOAD_F
#undef SWRITE_KF
#undef SWRITE_VF

}
#ifndef LAS
#define LAS __attribute__((address_space(3)))
#endif
#define RLX_AGENT __ATOMIC_RELAXED, __HIP_MEMORY_SCOPE_AGENT
#define XB_TMO      128
#define XB_XCNT(j)  (256  + 64 * (j))
#define XB_XSUB(j)  (1280 + 64 * (j))
#define XB_XGEN(j)  (2304 + 64 * (j))
#define XB_TOP      3328
#define XB_TOPGEN   3392
#define XCD_BAR_WORDS 3456
#define XB_SPIN_CAP (1u << 18)

__device__ __forceinline__ unsigned xb_ld(unsigned* p)              { return __hip_atomic_load(p, __ATOMIC_RELAXED, __HIP_MEMORY_SCOPE_AGENT); }
__device__ __forceinline__ unsigned xb_add(unsigned* p, unsigned v) { return __hip_atomic_fetch_add(p, v, __ATOMIC_RELAXED, __HIP_MEMORY_SCOPE_AGENT); }
__device__ __forceinline__ unsigned xb_xcc_id() { return (unsigned)__builtin_amdgcn_s_getreg((3 << 11) | 20) & 0xFu; }
#define XB_SPIN(cond, bar) do { unsigned _sp = 0; while (cond) { __builtin_amdgcn_s_sleep(1); \
    if ((++_sp & 255u) == 0u) { if (xb_ld(&(bar)[XB_TMO])) break; if (_sp > XB_SPIN_CAP) { atomicAdd(&(bar)[XB_TMO], 1u); break; } } } } while (0)

struct XcdBarrier {
    unsigned* bar; unsigned x;
    volatile LAS unsigned* st;
};

__device__ __forceinline__ XcdBarrier xcd_barrier_post(unsigned* bar, volatile LAS unsigned* st) {
    XcdBarrier b; b.bar = bar; b.x = xb_xcc_id(); b.st = st;
    if (threadIdx.x == 0) (void)xb_add(&bar[XB_XCNT(b.x)], 1u);
    return b;
}
__device__ __forceinline__ void xcd_barrier_complete(unsigned* bar, unsigned x, unsigned& nloc, unsigned& nx) {
    const unsigned G = gridDim.x * gridDim.y * gridDim.z;
    unsigned sum, cnt, mine, sp = 0u;
    for (;;) {
        sum = 0u; cnt = 0u; mine = 0u;
#pragma unroll
        for (unsigned j = 0; j < 16; ++j) { const unsigned c = xb_ld(&bar[XB_XCNT(j)]); sum += c; cnt += (c > 0u) ? 1u : 0u; mine = (j == x) ? c : mine; }
        if (sum == G) break;
        __builtin_amdgcn_s_sleep(1);
        if ((++sp & 255u) == 0u) { if (xb_ld(&bar[XB_TMO])) break; if (sp > XB_SPIN_CAP) { atomicAdd(&bar[XB_TMO], 1u); break; } }
    }
    nloc = mine > 0u ? mine : 1u; nx = cnt > 0u ? cnt : 1u;
}

__device__ __forceinline__ void xcd_barrier(const XcdBarrier& b) {
    asm volatile("s_waitcnt vmcnt(0)" ::: "memory");
    __syncthreads();
    if (threadIdx.x == 0) {
        unsigned* bar = b.bar;
        __builtin_amdgcn_s_waitcnt(0);
        unsigned nloc = b.st[0], nx = b.st[1];
        if (nloc == 0u) { xcd_barrier_complete(bar, b.x, nloc, nx); b.st[0] = nloc; b.st[1] = nx; }
        const unsigned old = xb_add(&bar[XB_XSUB(b.x)], 1u);
        const unsigned gen = old / nloc;
        if (old + 1u == (gen + 1u) * nloc) {
            __builtin_amdgcn_fence(__ATOMIC_RELEASE, "agent");
            asm volatile("s_waitcnt vmcnt(0)" ::: "memory");
            const unsigned og = xb_add(&bar[XB_TOP], 1u);
            const unsigned tg = og / nx;
            if (og + 1u == (tg + 1u) * nx) xb_add(&bar[XB_TOPGEN], 1u);
            else XB_SPIN(xb_ld(&bar[XB_TOPGEN]) == tg, bar);
            __builtin_amdgcn_fence(__ATOMIC_ACQUIRE, "agent");
            xb_add(&bar[XB_XGEN(b.x)], 1u);
            asm volatile("s_waitcnt vmcnt(0)" ::: "memory");
        } else {
            XB_SPIN(xb_ld(&bar[XB_XGEN(b.x)]) == gen, bar);
            __builtin_amdgcn_fence(__ATOMIC_ACQUIRE, "agent");
            asm volatile("s_waitcnt vmcnt(0)" ::: "memory");
        }
    }
    __syncthreads();
}
#ifndef LAS
#define LAS __attribute__((address_space(3)))
#endif
typedef unsigned short bf16_t;
typedef float f32x4 __attribute__((ext_vector_type(4)));
typedef float f32x2 __attribute__((ext_vector_type(2)));
typedef unsigned u32x4 __attribute__((ext_vector_type(4)));
typedef unsigned u32x2 __attribute__((ext_vector_type(2)));
constexpr int DM = 2048, NB = 4, SEQ = 2048, MT = NB * SEQ;
constexpr int DFF = 5632, NMOD = 12288;
constexpr int NBF = 8192, NF32 = 3584, NPROJ = NBF + NF32;
constexpr int PBP = NBF + 64;
constexpr float ALPHA = 1.189207115002721f, LN_EPS = 1e-5f, RMS_EPS = 1e-6f, LNX_EPS = 64e-5f;
constexpr size_t MiB = 1u << 20;
constexpr size_t WS_MOD = 0, WS_CUM = 1 * MiB, WS_PART = 2 * MiB, WS_BAR = 5 * MiB, WS_SLOT = 6 * MiB;
constexpr size_t WS_WOUT = 8 * MiB, WS_WA = 16 * MiB, WS_WB = 20 * MiB, WS_WLORA = 24 * MiB;
constexpr size_t WS_WIN = 28 * MiB;
constexpr size_t WS_ACAT = 60 * MiB, WS_ACAT2 = 363 * MiB, WS_MERGED = 235 * MiB;
constexpr int KSP = PBP / 2;
constexpr size_t WS_XN = 74 * MiB;
constexpr size_t WS_QN = 74 * MiB, WS_KN = 90 * MiB;
constexpr size_t WS_PBF = 106 * MiB;
constexpr size_t WS_PRW = 235 * MiB, WS_LF = 291 * MiB;
constexpr size_t WS_PF32 = 235 * MiB;
constexpr size_t WS_G = 347 * MiB, WS_YRAW = 299 * MiB, WS_WGU = 28 * MiB;
constexpr size_t WS_KK = 347 * MiB;
constexpr size_t WS_O = 379 * MiB;
constexpr size_t WS_WDOWN = 395 * MiB;
constexpr size_t WS_END = 417 * MiB;
constexpr int LDS_BYTES = 131072 + 64;

struct Params { const float* in[28]; float* out; unsigned char* ws; };

__device__ __forceinline__ unsigned f2bf(float f) { unsigned u = __builtin_bit_cast(unsigned, f); return (u + 0x7fffu + ((u >> 16) & 1u)) >> 16; }
__device__ __forceinline__ unsigned pk2(float lo, float hi) { return pg8::cvt_pk_bf16(lo, hi); }
__device__ __forceinline__ float bflo(unsigned w) { return __builtin_bit_cast(float, w << 16); }
__device__ __forceinline__ float bfhi(unsigned w) { return __builtin_bit_cast(float, w & 0xffff0000u); }
__device__ __forceinline__ f32x4 ld4bf(const bf16_t* p) { const u32x2 w = *(const u32x2*)p; return (f32x4){bflo(w.x), bfhi(w.x), bflo(w.y), bfhi(w.y)}; }
__device__ __forceinline__ float sigm(float x) { return __builtin_amdgcn_rcpf(1.f + __builtin_amdgcn_exp2f(-1.4426950408889634f * x)); }
__device__ __forceinline__ float wave_sum(float v) {
#pragma unroll
    for (int o = 1; o < 64; o <<= 1) v += __shfl_xor(v, o);
    return v;
}
template <int CTRL> __device__ __forceinline__ float dppf(float x) { return __builtin_bit_cast(float, __builtin_amdgcn_mov_dpp(__builtin_bit_cast(int, x), CTRL, 0xf, 0xf, true)); }
__device__ __forceinline__ float rowsum16(float v) { v += dppf<0xB1>(v); v += dppf<0x4E>(v); v += dppf<0x141>(v); v += dppf<0x128>(v); return v; }
#define LDS_WAIT() asm volatile("s_waitcnt lgkmcnt(0)" ::: "memory")

namespace pg8 {
__device__ __forceinline__ f32x4 sig4(f32x4 v) { f32x4 r; r[0] = sigm(v[0]); r[1] = sigm(v[1]); r[2] = sigm(v[2]); r[3] = sigm(v[3]); return r; }
__device__ __forceinline__ u32x4 pack8(f32x4 a, f32x4 b) { u32x4 w; w.x = cvt_pk_bf16(a[0], a[1]); w.y = cvt_pk_bf16(a[2], a[3]); w.z = cvt_pk_bf16(b[0], b[1]); w.w = cvt_pk_bf16(b[2], b[3]); return w; }
struct EpiProjBf { static constexpr bool PERM = true, AFTER_DRAIN = false; bf16_t* O;
    __device__ __forceinline__ void operator()(const f32x4 (&acc)[2][2][4][2], const Unit& u, int wr, int wc, int fr, int fq) const {
        const int row0 = u.pm * BM + wr * 64 + fr, col0 = u.pn * BM + wc * 32 + 8 * fq; const bool sg = u.pn >= 12;
#pragma unroll
        for (int ai = 0; ai < 2; ++ai)
#pragma unroll
            for (int m = 0; m < 4; ++m) { bf16_t* rowp = O + (size_t)(row0 + ai * HALF + m * 16) * PBP + col0;
#pragma unroll
                for (int bj = 0; bj < 2; ++bj) { f32x4 v0 = acc[ai][bj][m][0], v1 = acc[ai][bj][m][1];
                    if (sg) { v0 = sig4(v0); v1 = sig4(v1); }
                    *(u32x4*)(rowp + bj * HALF) = pack8(v0, v1); } }
    }
};
struct EpiF32 { static constexpr bool PERM = false, AFTER_DRAIN = false; float* O; int ldc;
    __device__ __forceinline__ void operator()(const f32x4 (&acc)[2][2][4][2], const Unit& u, int wr, int wc, int fr, int fq) const {
        const int row0 = u.pm * BM + wr * 64 + fr, col0 = u.pn * BM + wc * 32 + 4 * fq;
#pragma unroll
        for (int ai = 0; ai < 2; ++ai)
#pragma unroll
            for (int m = 0; m < 4; ++m) { float* rowp = O + (size_t)(row0 + ai * HALF + m * 16) * ldc + col0;
#pragma unroll
                for (int bj = 0; bj < 2; ++bj)
#pragma unroll
                    for (int n = 0; n < 2; ++n) *(f32x4*)(rowp + bj * HALF + n * 16) = acc[ai][bj][m][n]; }
    }
};
struct EpiRw { static constexpr bool PERM = false, AFTER_DRAIN = false; bf16_t* O; float* LF;
    __device__ __forceinline__ void operator()(const f32x4 (&acc)[2][2][4][2], const Unit& u, int wr, int wc, int fr, int fq) const {
        const int row0 = u.pm * BM + wr * 64 + fr, colt = wc * 32 + 4 * fq, col0 = u.pn * BM + colt; const bool last = u.pn == 13;
#pragma unroll
        for (int ai = 0; ai < 2; ++ai)
#pragma unroll
            for (int m = 0; m < 4; ++m) { const size_t row = (size_t)(row0 + ai * HALF + m * 16);
#pragma unroll
                for (int bj = 0; bj < 2; ++bj)
#pragma unroll
                    for (int n = 0; n < 2; ++n) { const f32x4 v = acc[ai][bj][m][n]; u32x2 w; w.x = cvt_pk_bf16(v[0], v[1]); w.y = cvt_pk_bf16(v[2], v[3]);
                        *(u32x2*)(O + row * NF32 + col0 + bj * HALF + n * 16) = w;
                        if (last) *(f32x4*)(LF + row * 256 + colt + bj * HALF + n * 16) = v; } }
    }
};
struct EpiLora { static constexpr bool PERM = false, AFTER_DRAIN = false;
    const float* w0; const float* a0; float* WD; float* AA; bf16_t* G; int pn0;
    __device__ __forceinline__ void operator()(const f32x4 (&acc)[2][2][4][2], const Unit& u, int wr, int wc, int fr, int fq) const {
        const int pnq = u.pn + pn0, sel = pnq >> 2; int row0 = u.pm * BM + wr * 64 + fr, cb = (pnq & 3) * BM + wc * 32 + 4 * fq;
        asm volatile("" : "+v"(row0), "+v"(cb));
#pragma unroll
        for (int bj = 0; bj < 2; ++bj)
#pragma unroll
            for (int n = 0; n < 2; ++n) { const int c = cb + bj * HALF + n * 16;
                if (sel == 0) { const f32x4 wv = *(const f32x4*)(w0 + c);
#pragma unroll
                    for (int ai = 0; ai < 2; ++ai)
#pragma unroll
                        for (int m = 0; m < 4; ++m) { const size_t off = (size_t)(row0 + ai * HALF + m * 16) * 1024 + c; f32x4 o;
#pragma unroll
                            for (int i = 0; i < 4; ++i) { const float x = wv[i] + acc[ai][bj][m][n][i];
                                const float wraw = fminf(x, 0.f) - __logf(1.f + __expf(-fabsf(x))) - 0.5f; o[i] = __expf(-__expf(wraw)); }
                            *(f32x4*)(WD + off) = o; }
                } else if (sel == 1) { const f32x4 av = *(const f32x4*)(a0 + c);
#pragma unroll
                    for (int ai = 0; ai < 2; ++ai)
#pragma unroll
                        for (int m = 0; m < 4; ++m) { const size_t off = (size_t)(row0 + ai * HALF + m * 16) * 1024 + c; f32x4 oa;
#pragma unroll
                            for (int i = 0; i < 4; ++i) oa[i] = sigm(av[i] + acc[ai][bj][m][n][i]);
                            *(f32x4*)(AA + off) = oa; }
                } else {
#pragma unroll
                    for (int ai = 0; ai < 2; ++ai)
#pragma unroll
                        for (int m = 0; m < 4; ++m) { const size_t off = (size_t)(row0 + ai * HALF + m * 16) * 1024 + c; const f32x4 v = acc[ai][bj][m][n];
                            u32x2 w; w.x = cvt_pk_bf16(v[0], v[1]); w.y = cvt_pk_bf16(v[2], v[3]); *(u32x2*)(G + off) = w; }
                } }
    }
};
template <int PASS> struct EpiMerge { static constexpr bool PERM = true, AFTER_DRAIN = false; const bf16_t* SG; float* TMP; bf16_t* MG;
    __device__ __forceinline__ void operator()(const f32x4 (&acc)[2][2][4][2], const Unit& u, int wr, int wc, int fr, int fq) const {
        const int row0 = u.pm * BM + wr * 64 + fr, col0 = u.pn * BM + wc * 32 + 8 * fq;
#pragma unroll
        for (int ai = 0; ai < 2; ++ai)
#pragma unroll
            for (int m = 0; m < 4; ++m) { const int row = row0 + ai * HALF + m * 16;
#pragma unroll
                for (int bj = 0; bj < 2; ++bj) { const int c = col0 + bj * HALF; const u32x4 s = *(const u32x4*)(SG + (size_t)row * PBP + c);
                    f32x4 v0 = acc[ai][bj][m][0], v1 = acc[ai][bj][m][1];
                    v0 = v0 * (f32x4){bflo(s.x), bfhi(s.x), bflo(s.y), bfhi(s.y)}; v1 = v1 * (f32x4){bflo(s.z), bfhi(s.z), bflo(s.w), bfhi(s.w)};
                    float* tp = TMP + (size_t)row * DM + c;
                    if (PASS == 1) { *(f32x4*)tp = v0; *(f32x4*)(tp + 4) = v1; }
                    else { v0 = v0 + *(const f32x4*)tp; v1 = v1 + *(const f32x4*)(tp + 4); *(u32x4*)(MG + (size_t)row * DM + c) = pack8(v0, v1); } } }
    }
};
struct EpiMergeDual { static constexpr bool PERM = true, AFTER_DRAIN = false; const bf16_t* SGA; const bf16_t* SGB; bf16_t* MG;
    __device__ __forceinline__ void mid(f32x4 (&acc)[2][2][4][2], const Unit& u, int wr, int wc, int fr, int fq) const {
        int row0 = u.pm * BM + wr * 64 + fr, col0 = u.pn * BM + wc * 32 + 8 * fq;
        asm volatile("" : "+v"(row0), "+v"(col0));
#pragma unroll
        for (int ai = 0; ai < 2; ++ai)
#pragma unroll
            for (int m = 0; m < 4; ++m) { const size_t ro = (size_t)(row0 + ai * HALF + m * 16) * PBP;
#pragma unroll
                for (int bj = 0; bj < 2; ++bj) { const int c = col0 + bj * HALF; const u32x4 a = *(const u32x4*)(SGA + ro + c), b = *(const u32x4*)(SGB + ro + c);
#define MRG_R(x, y) ((x) * __builtin_amdgcn_rcpf(fmaxf((y), 1e-20f)))
                    acc[ai][bj][m][0] = acc[ai][bj][m][0] * (f32x4){MRG_R(bflo(a.x), bflo(b.x)), MRG_R(bfhi(a.x), bfhi(b.x)), MRG_R(bflo(a.y), bflo(b.y)), MRG_R(bfhi(a.y), bfhi(b.y))};
                    acc[ai][bj][m][1] = acc[ai][bj][m][1] * (f32x4){MRG_R(bflo(a.z), bflo(b.z)), MRG_R(bfhi(a.z), bfhi(b.z)), MRG_R(bflo(a.w), bflo(b.w)), MRG_R(bfhi(a.w), bfhi(b.w))};
#undef MRG_R
                }
                asm volatile("" ::: "memory"); }
    }
    __device__ __forceinline__ void operator()(const f32x4 (&acc)[2][2][4][2], const Unit& u, int wr, int wc, int fr, int fq) const {
        const int row0 = u.pm * BM + wr * 64 + fr, col0 = u.pn * BM + wc * 32 + 8 * fq;
#pragma unroll
        for (int ai = 0; ai < 2; ++ai)
#pragma unroll
            for (int m = 0; m < 4; ++m) { const int row = row0 + ai * HALF + m * 16;
#pragma unroll
                for (int bj = 0; bj < 2; ++bj) { const int c = col0 + bj * HALF; const u32x4 s = *(const u32x4*)(SGB + (size_t)row * PBP + c);
                    const f32x4 v0 = acc[ai][bj][m][0] * (f32x4){bflo(s.x), bfhi(s.x), bflo(s.y), bfhi(s.y)}, v1 = acc[ai][bj][m][1] * (f32x4){bflo(s.z), bfhi(s.z), bflo(s.w), bfhi(s.w)};
                    *(u32x4*)(MG + (size_t)row * DM + c) = pack8(v0, v1); } }
    }
};
struct EpiRes { static constexpr bool PERM = false, AFTER_DRAIN = false; const float* X; float* OUT; const float* gate;
    __device__ __forceinline__ void operator()(const f32x4 (&acc)[2][2][4][2], const Unit& u, int wr, int wc, int fr, int fq) const {
        const int row0 = u.pm * BM + wr * 64 + fr, col0 = u.pn * BM + wc * 32 + 4 * fq; const float* gp = gate + (size_t)(u.pm >> 3) * NMOD;
#pragma unroll
        for (int bj = 0; bj < 2; ++bj)
#pragma unroll
            for (int n = 0; n < 2; ++n) { const int c = col0 + bj * HALF + n * 16; const f32x4 gv = *(const f32x4*)(gp + c);
#pragma unroll
                for (int ai = 0; ai < 2; ++ai)
#pragma unroll
                    for (int m = 0; m < 4; ++m) { const size_t off = (size_t)(row0 + ai * HALF + m * 16) * DM + c;
                        const f32x4 xv = *(const f32x4*)(X + off); *(f32x4*)(OUT + off) = xv * ALPHA + gv * acc[ai][bj][m][n]; } }
    }
};
struct EpiSwiGLU { static constexpr bool PERM = true, AFTER_DRAIN = false; bf16_t* ACT;
    __device__ __forceinline__ void operator()(const f32x4 (&acc)[2][2][4][2], const Unit& u, int wr, int wc, int fr, int fq) const {
        const int row0 = u.pm * BM + wr * 64 + fr, col0 = u.pn * HALF + wc * 32 + 8 * fq;
#pragma unroll
        for (int ai = 0; ai < 2; ++ai)
#pragma unroll
            for (int m = 0; m < 4; ++m) { const f32x4 g0 = acc[ai][0][m][0], g1 = acc[ai][0][m][1], u0 = acc[ai][1][m][0], u1 = acc[ai][1][m][1];
                const f32x4 a0 = g0 * sig4(g0) * u0, a1 = g1 * sig4(g1) * u1;
                *(u32x4*)(ACT + (size_t)(row0 + ai * HALF + m * 16) * DFF + col0) = pack8(a0, a1); }
    }
};

__device__ __forceinline__ void row_stats_exchange(const f32x4 (&v)[2][2][4][2], const Unit& u, int wr, int wc, int fr, int fq, PG8_LAS unsigned char* lds, int wid, int lane, float* slots, const XcdBarrier& bar) {
    PG8_LAS f32x2* P = (PG8_LAS f32x2*)lds; PG8_LAS f32x2* S = (PG8_LAS f32x2*)(lds + 8192);
#pragma unroll
    for (int ai = 0; ai < 2; ++ai)
#pragma unroll
        for (int m = 0; m < 4; ++m) {
            float s = 0.f;
#pragma unroll
            for (int bj = 0; bj < 2; ++bj)
#pragma unroll
                for (int n = 0; n < 2; ++n) { const f32x4 x = v[ai][bj][m][n]; s += (x[0] + x[1]) + (x[2] + x[3]); }
            s += __shfl_xor(s, 16); s += __shfl_xor(s, 32);
            const float mw = s * (1.0f / 64.0f); float q = 0.f;
#pragma unroll
            for (int bj = 0; bj < 2; ++bj)
#pragma unroll
                for (int n = 0; n < 2; ++n) { const f32x4 d = v[ai][bj][m][n] - mw; q += (d[0] * d[0] + d[1] * d[1]) + (d[2] * d[2] + d[3] * d[3]); }
            q += __shfl_xor(q, 16); q += __shfl_xor(q, 32);
            if (fq == 0) P[(ai * HALF + wr * 64 + m * 16 + fr) * 4 + wc] = (f32x2){mw, q};
        }
    asm volatile("s_waitcnt lgkmcnt(0)" ::: "memory"); __builtin_amdgcn_s_barrier(); asm volatile("" ::: "memory");
    const int row = wid * 32 + (lane & 31);
    if (lane < 32) {
        const f32x2 a = P[row * 4 + 0], b = P[row * 4 + 1], c = P[row * 4 + 2], d = P[row * 4 + 3];
        const float mt = (a[0] + b[0] + c[0] + d[0]) * 0.25f;
        const float da = a[0] - mt, db = b[0] - mt, dc = c[0] - mt, dd = d[0] - mt;
        const float m2 = (a[1] + b[1]) + (c[1] + d[1]) + 64.0f * ((da * da + db * db) + (dc * dc + dd * dd));
        *(f32x2*)(slots + ((size_t)(u.pm * BM + row) * 8 + u.pn) * 2) = (f32x2){mt, m2};
    }
    xcd_barrier(bar);
    if (lane < 32) {
        const float* sp = slots + (size_t)(u.pm * BM + row) * 16; float mt[8], m2[8]; float ms = 0.f;
#pragma unroll
        for (int t = 0; t < 8; ++t) { const f32x2 w = *(const f32x2*)(sp + 2 * t); mt[t] = w[0]; m2[t] = w[1]; ms += w[0]; }
        const float mean = ms * 0.125f; float q = 0.f;
#pragma unroll
        for (int t = 0; t < 8; ++t) { const float dm = mt[t] - mean; q += m2[t] + 256.0f * dm * dm; }
        S[row] = (f32x2){mean, __builtin_amdgcn_rsqf(q * (1.0f / 2048.0f) + LN_EPS)};
    }
    asm volatile("s_waitcnt lgkmcnt(0)" ::: "memory"); __builtin_amdgcn_s_barrier(); asm volatile("" ::: "memory");
}
#define LNF_PIN(ai, m) asm volatile("" : "+v"(acc[ai][0][m][0]), "+v"(acc[ai][0][m][1]), "+v"(acc[ai][1][m][0]), "+v"(acc[ai][1][m][1]))
#define LNF_RESID(Xp, gvv) do { _Pragma("unroll") for (int ai = 0; ai < 2; ++ai) _Pragma("unroll") for (int m = 0; m < 4; ++m) { const float* rp_ = (Xp) + (size_t)(row0 + ai * HALF + m * 16) * DM + col0; \
        _Pragma("unroll") for (int bj = 0; bj < 2; ++bj) _Pragma("unroll") for (int n = 0; n < 2; ++n) acc[ai][bj][m][n] = *(const f32x4*)(rp_ + bj * HALF + n * 16) * ALPHA + gvv[bj][n] * acc[ai][bj][m][n]; \
        LNF_PIN(ai, m); if (m & 1) asm volatile("" ::: "memory"); } } while (0)
struct EpiResLn { static constexpr bool PERM = false, AFTER_DRAIN = true; const float* X; float* OUT; const float* gate; const float* lg; const float* lb; float* slots; const XcdBarrier* bar;
    __device__ __forceinline__ void operator()(const f32x4 (&)[2][2][4][2], const Unit&, int, int, int, int) const {}
    __device__ __forceinline__ void fused(f32x4 (&acc)[2][2][4][2], const Unit& u, int wr, int wc, int fr, int fq, PG8_LAS unsigned char* lds, int wid, int lane) const {
        const PG8_LAS f32x2* S = (const PG8_LAS f32x2*)(lds + 8192);
        const int row0 = u.pm * BM + wr * 64 + fr, col0 = u.pn * BM + wc * 32 + 4 * fq; const float* gp = gate + (size_t)(u.pm >> 3) * NMOD + col0;
        { f32x4 gv[2][2];
#pragma unroll
          for (int bj = 0; bj < 2; ++bj)
#pragma unroll
              for (int n = 0; n < 2; ++n) gv[bj][n] = *(const f32x4*)(gp + bj * HALF + n * 16);
          LNF_RESID(X, gv); }
        row_stats_exchange(acc, u, wr, wc, fr, fq, lds, wid, lane, slots, *bar);
        f32x4 g4[2][2], b4[2][2];
#pragma unroll
        for (int bj = 0; bj < 2; ++bj)
#pragma unroll
            for (int n = 0; n < 2; ++n) { g4[bj][n] = *(const f32x4*)(lg + col0 + bj * HALF + n * 16); b4[bj][n] = *(const f32x4*)(lb + col0 + bj * HALF + n * 16); }
#pragma unroll
        for (int ai = 0; ai < 2; ++ai)
#pragma unroll
            for (int m = 0; m < 4; ++m) { const int r = ai * HALF + wr * 64 + m * 16 + fr; const f32x2 sr = S[r]; float* op = OUT + (size_t)(u.pm * BM + r) * DM + col0;
#pragma unroll
                for (int bj = 0; bj < 2; ++bj)
#pragma unroll
                    for (int n = 0; n < 2; ++n) *(f32x4*)(op + bj * HALF + n * 16) = (acc[ai][bj][m][n] - sr[0]) * sr[1] * g4[bj][n] + b4[bj][n];
                if (m & 1) asm volatile("" ::: "memory"); }
    }
};
struct EpiResLnLn { static constexpr bool PERM = false, AFTER_DRAIN = true; const float* X; float* X1; bf16_t* H2; const float* mod; const float* lg; const float* lb; float* slots1; float* slots2; const XcdBarrier* bar;
    __device__ __forceinline__ void operator()(const f32x4 (&)[2][2][4][2], const Unit&, int, int, int, int) const {}
    __device__ __forceinline__ void fused(f32x4 (&acc)[2][2][4][2], const Unit& u, int wr, int wc, int fr, int fq, PG8_LAS unsigned char* lds, int wid, int lane) const {
        const PG8_LAS f32x2* S = (const PG8_LAS f32x2*)(lds + 8192);
        const int row0 = u.pm * BM + wr * 64 + fr, col0 = u.pn * BM + wc * 32 + 4 * fq; const float* mb = mod + (size_t)(u.pm >> 3) * NMOD + col0;
        { f32x4 gv[2][2];
#pragma unroll
          for (int bj = 0; bj < 2; ++bj)
#pragma unroll
              for (int n = 0; n < 2; ++n) gv[bj][n] = *(const f32x4*)(mb + 2 * DM + bj * HALF + n * 16);
          LNF_RESID(X, gv); }
        row_stats_exchange(acc, u, wr, wc, fr, fq, lds, wid, lane, slots1, *bar);
        { f32x4 g4[2][2], b4[2][2];
#pragma unroll
          for (int bj = 0; bj < 2; ++bj)
#pragma unroll
              for (int n = 0; n < 2; ++n) { g4[bj][n] = *(const f32x4*)(lg + col0 + bj * HALF + n * 16); b4[bj][n] = *(const f32x4*)(lb + col0 + bj * HALF + n * 16); }
#pragma unroll
          for (int ai = 0; ai < 2; ++ai)
#pragma unroll
              for (int m = 0; m < 4; ++m) { const int r = ai * HALF + wr * 64 + m * 16 + fr; const f32x2 sr = S[r]; float* op = X1 + (size_t)(u.pm * BM + r) * DM + col0;
#pragma unroll
                  for (int bj = 0; bj < 2; ++bj)
#pragma unroll
                      for (int n = 0; n < 2; ++n) { const f32x4 x1 = (acc[ai][bj][m][n] - sr[0]) * sr[1] * g4[bj][n] + b4[bj][n]; acc[ai][bj][m][n] = x1; *(f32x4*)(op + bj * HALF + n * 16) = x1; }
                  LNF_PIN(ai, m); if (m & 1) asm volatile("" ::: "memory"); } }
        row_stats_exchange(acc, u, wr, wc, fr, fq, lds, wid, lane, slots2, *bar);
        f32x4 sh[2][2], sc[2][2];
#pragma unroll
        for (int bj = 0; bj < 2; ++bj)
#pragma unroll
            for (int n = 0; n < 2; ++n) { sh[bj][n] = *(const f32x4*)(mb + 3 * DM + bj * HALF + n * 16); sc[bj][n] = *(const f32x4*)(mb + 4 * DM + bj * HALF + n * 16) + 1.f; }
#pragma unroll
        for (int ai = 0; ai < 2; ++ai)
#pragma unroll
            for (int m = 0; m < 4; ++m) { const int r = ai * HALF + wr * 64 + m * 16 + fr; const f32x2 sr = S[r]; bf16_t* op = H2 + (size_t)(u.pm * BM + r) * DM + col0;
#pragma unroll
                for (int bj = 0; bj < 2; ++bj)
#pragma unroll
                    for (int n = 0; n < 2; ++n) { const f32x4 o = (acc[ai][bj][m][n] - sr[0]) * sr[1] * sc[bj][n] + sh[bj][n]; u32x2 w; w.x = cvt_pk_bf16(o[0], o[1]); w.y = cvt_pk_bf16(o[2], o[3]);
                        *(u32x2*)(op + bj * HALF + n * 16) = w; }
                if (m & 1) asm volatile("" ::: "memory"); }
    }
};
}
__device__ __forceinline__ int q_pop(unsigned* ctr, int lane) { unsigned v = 0u; if (lane == 0) v = __hip_atomic_fetch_add(ctr, 1u, __ATOMIC_RELAXED, __HIP_MEMORY_SCOPE_AGENT); return (int)__builtin_amdgcn_readfirstlane(v); }
struct MapId { __device__ __forceinline__ int operator()(int n) const { return n; } };
struct MapWin { __device__ __forceinline__ int operator()(int n) const {
    return n < 4096 ? n : n < 8192 ? 7624 + (n - 4096) : n < 11712 ? 4104 + (n - 8192) : n < 11720 ? 4096 + (n - 11712) : -1; } };
struct MapGu { __device__ __forceinline__ int operator()(int n) const { const int pn = n >> 8, j = n & 255; return j < 128 ? 128 * pn + j : DFF + 128 * pn + (j - 128); } };
template <class Map>
__device__ __forceinline__ void transpose_item(const float* W, int ldw, bf16_t* WT, int Kd, int kb, int nb, LAS float* scr, int lane, Map map) {
    const int k0 = 64 * kb, n0 = 32 * nb; const int src = map(n0 + (lane & 31));
    const float* wp = W + (size_t)(k0 + (lane >> 5)) * ldw + (src >= 0 ? src : 0);
    float tv[32];
#pragma unroll
    for (int i = 0; i < 32; ++i) tv[i] = src >= 0 ? __builtin_nontemporal_load(wp + (size_t)(2 * i) * ldw) : 0.f;
#pragma unroll
    for (int i = 0; i < 32; ++i) scr[(2 * i + (lane >> 5)) * 33 + (lane & 31)] = tv[i];
    LDS_WAIT();
    const int c = lane & 7;
#pragma unroll
    for (int j = 0; j < 4; ++j) { const int n = (lane >> 3) + 8 * j; const LAS float* s = scr + (8 * c) * 33 + n;
        u32x4 o; o.x = pk2(s[0 * 33], s[1 * 33]); o.y = pk2(s[2 * 33], s[3 * 33]); o.z = pk2(s[4 * 33], s[5 * 33]); o.w = pk2(s[6 * 33], s[7 * 33]);
        *(u32x4*)(WT + (size_t)(n0 + n) * Kd + k0 + 8 * c) = o; }
    LDS_WAIT();
}
template <class Map>
__device__ __forceinline__ void transpose_item2(const float* W, int ldw, bf16_t* WT, int Kd, int kb, int nb, LAS float* scrf, int lane, Map map) {
    LAS unsigned* scr = (LAS unsigned*)scrf;
    const int k0 = 64 * kb, n0 = 64 * nb, half = lane >> 5, c2 = lane & 31; const int src = map(n0 + 2 * c2);
    const float* wp = W + (size_t)(k0 + 32 * half) * ldw + (src >= 0 ? src : 0);
    f32x2 tv[32];
#pragma unroll
    for (int i = 0; i < 32; ++i) tv[i] = src >= 0 ? __builtin_nontemporal_load((const f32x2*)(wp + (size_t)i * ldw)) : (f32x2){0.f, 0.f};
    LAS unsigned* w0 = scr + (2 * c2) * 33 + 16 * half;
#pragma unroll
    for (int j = 0; j < 16; ++j) { w0[j] = pk2(tv[2 * j][0], tv[2 * j + 1][0]); w0[33 + j] = pk2(tv[2 * j][1], tv[2 * j + 1][1]); }
    LDS_WAIT();
    const int c = lane & 7;
#pragma unroll
    for (int j = 0; j < 8; ++j) { const int n = (lane >> 3) + 8 * j; const LAS unsigned* sp = scr + n * 33 + 4 * c;
        u32x4 o; o.x = sp[0]; o.y = sp[1]; o.z = sp[2]; o.w = sp[3];
        *(u32x4*)(WT + (size_t)(n0 + n) * Kd + k0 + 8 * c) = o; }
    LDS_WAIT();
}
__device__ __forceinline__ void ln_stats(const f32x4 (&v)[8], float& mean, float& rstd) {
    float s = 0.f;
#pragma unroll
    for (int j = 0; j < 8; ++j) s += (v[j][0] + v[j][1]) + (v[j][2] + v[j][3]);
    mean = wave_sum(s) * (1.f / DM); float q = 0.f;
#pragma unroll
    for (int j = 0; j < 8; ++j) { const f32x4 d = v[j] - mean; q += (d[0] * d[0] + d[1] * d[1]) + (d[2] * d[2] + d[3] * d[3]); }
    rstd = __builtin_amdgcn_rsqf(wave_sum(q) * (1.f / DM) + LN_EPS);
}

__device__ __forceinline__ void prep_row(const Params& p, int t, int lane) {
    unsigned char* ws = p.ws;
    const bf16_t* PBF = (const bf16_t*)(ws + WS_PBF) + (size_t)t * PBP;
    bf16_t* QN = (bf16_t*)(ws + WS_QN) + (size_t)t * 1024; bf16_t* KN = (bf16_t*)(ws + WS_KN) + (size_t)t * 1024;
    u32x4 qk4[4];
#pragma unroll
    for (int ps = 0; ps < 4; ++ps) qk4[ps] = *(const u32x4*)(PBF + (ps >> 1) * 1024 + (ps & 1) * 512 + lane * 8);
#pragma unroll
    for (int ps = 0; ps < 4; ++ps) {
        const int isk = ps >> 1, c = (ps & 1) * 512 + lane * 8;
        const u32x4 w = qk4[ps];
        float x[8] = {bflo(w.x), bfhi(w.x), bflo(w.y), bfhi(w.y), bflo(w.z), bfhi(w.z), bflo(w.w), bfhi(w.w)};
        float ss = 0.f;
#pragma unroll
        for (int i = 0; i < 8; ++i) ss += x[i] * x[i];
        ss = rowsum16(ss);
        const float rs = __builtin_amdgcn_rsqf(ss * (1.f / 128.f) + RMS_EPS);
        const float* gp = (isk ? p.in[7] : p.in[6]) + (c & 127);
        const f32x4 g0 = *(const f32x4*)gp, g1 = *(const f32x4*)(gp + 4);
        u32x4 o; o.x = pk2(x[0] * rs * g0[0], x[1] * rs * g0[1]); o.y = pk2(x[2] * rs * g0[2], x[3] * rs * g0[3]);
        o.z = pk2(x[4] * rs * g1[0], x[5] * rs * g1[1]); o.w = pk2(x[6] * rs * g1[2], x[7] * rs * g1[3]);
        *(u32x4*)((isk ? KN : QN) + c) = o;
    }
    const bf16_t* cur = (const bf16_t*)(ws + WS_PRW) + (size_t)t * NF32; const bf16_t* prv = cur - NF32;
    const bool first = (t & (SEQ - 1)) == 0; const float* mu = p.in[8];
#define SHIFTED(col) ({ const f32x4 c_ = ld4bf(cur + (col)); const f32x4 p_ = first ? (f32x4){0.f, 0.f, 0.f, 0.f} : ld4bf(prv + (col)); const f32x4 m_ = *(const f32x4*)(mu + (col)); c_ + (p_ - c_) * m_; })
    bf16_t* AC = (bf16_t*)(ws + WS_ACAT) + (size_t)t * 256; bf16_t* AC2 = (bf16_t*)(ws + WS_ACAT2) + (size_t)t * 256;
    if (lane < 32) {
        f32x4 a = {0.f, 0.f, 0.f, 0.f}, b = {0.f, 0.f, 0.f, 0.f};
        if (lane < 24) { const f32x4 xw = SHIFTED(3072 + lane * 4); b = SHIFTED(3168 + lane * 4);
#pragma unroll
            for (int i = 0; i < 4; ++i) { const float e = __expf(-2.f * fabsf(xw[i])); const float th = (1.f - e) / (1.f + e); a[i] = xw[i] < 0.f ? -th : th; } }
        u32x2 wa, wb; wa.x = pk2(a[0], a[1]); wa.y = pk2(a[2], a[3]); wb.x = pk2(b[0], b[1]); wb.y = pk2(b[2], b[3]);
        *(u32x2*)(AC + lane * 4) = wa; *(u32x2*)(AC + 128 + lane * 4) = wb; }
    { const f32x4 xg = SHIFTED(3264 + lane * 4); u32x2 w; w.x = pk2(sigm(xg[0]), sigm(xg[1])); w.y = pk2(sigm(xg[2]), sigm(xg[3])); *(u32x2*)(AC2 + lane * 4) = w; }
#undef SHIFTED
}

__device__ __forceinline__ void rwkv_job(LAS unsigned char* lds, int job, const float* mu, const float* k_k, const float* k_a, const bf16_t* PRW, const float* WD, const float* AA, float* Y, int tid, int wave, int lane) {
    const int bh = job >> 1, half = job & 1, b = bh >> 4, h = bh & 15;
    const size_t tok0 = (size_t)b * SEQ;
    constexpr int TC = 32, CHF = TC * 384, NCH = SEQ / TC;
    LAS float* buf = (LAS float*)lds;
    const int lt = tid & 255, lrow = lt >> 4, piece = lt & 15, hc = h * 64 + piece * 4;
    const size_t goff = (tok0 + lrow) * 1024 + hc;
    const bf16_t* prw0 = PRW + tok0 * NF32 + hc;
    u32x2 rb[12]; f32x4 rg[4];
    const f32x4 kkc = *(const f32x4*)(k_k + hc), kac = *(const f32x4*)(k_a + hc), mur = *(const f32x4*)(mu + hc), muk = *(const f32x4*)(mu + 1024 + hc), muv = *(const f32x4*)(mu + 2048 + hc);
#define RW_LOAD(rg, c) do { const size_t o_ = goff + (size_t)(c) * TC * 1024; _Pragma("unroll") for (int p_ = 0; p_ < 2; ++p_) { const int t_ = (c) * TC + lrow + 16 * p_, tp_ = t_ > 0 ? t_ - 1 : 0; \
        _Pragma("unroll") for (int s_ = 0; s_ < 3; ++s_) { rb[6 * p_ + 2 * s_] = *(const u32x2*)(prw0 + (size_t)t_ * NF32 + s_ * 1024); rb[6 * p_ + 2 * s_ + 1] = *(const u32x2*)(prw0 + (size_t)tp_ * NF32 + s_ * 1024); } \
        rg[p_] = *(const f32x4*)(WD + o_ + (size_t)p_ * 16 * 1024); rg[2 + p_] = *(const f32x4*)(AA + o_ + (size_t)p_ * 16 * 1024); } } while (0)
#define RW_BF4(w) ((f32x4){bflo((w).x), bfhi((w).x), bflo((w).y), bfhi((w).y)})
#define RW_WRITE(rg, c) do { _Pragma("unroll") for (int p_ = 0; p_ < 2; ++p_) { LAS float* d_ = buf + ((c) & 1) * CHF + (lrow + 16 * p_) * 384 + piece * 4; \
        const float fz_ = ((c) * TC + lrow + 16 * p_) > 0 ? 1.f : 0.f;     \
        const f32x4 rc_ = RW_BF4(rb[6 * p_]), rp_ = RW_BF4(rb[6 * p_ + 1]) * fz_, kc_ = RW_BF4(rb[6 * p_ + 2]), kp_ = RW_BF4(rb[6 * p_ + 3]) * fz_, vc_ = RW_BF4(rb[6 * p_ + 4]), vp_ = RW_BF4(rb[6 * p_ + 5]) * fz_; \
        const f32x4 ks_ = kc_ + (kp_ - kc_) * muk, a_ = rg[2 + p_]; const f32x4 kv_ = ks_ * kkc; \
        const float nn_ = rowsum16((kv_[0] * kv_[0] + kv_[1] * kv_[1]) + (kv_[2] * kv_[2] + kv_[3] * kv_[3])); const f32x4 kk_ = kv_ * __builtin_amdgcn_rsqf(fmaxf(nn_, 1e-24f));     \
        *(LAS f32x4*)(d_) = kk_; *(LAS f32x4*)(d_ + 64) = rg[p_]; *(LAS f32x4*)(d_ + 128) = kk_ * a_; *(LAS f32x4*)(d_ + 192) = ks_ * ((a_ - 1.f) * kac + 1.f); \
        *(LAS f32x4*)(d_ + 256) = rc_ + (rp_ - rc_) * mur; *(LAS f32x4*)(d_ + 320) = vc_ + (vp_ - vc_) * muv; } } while (0)
    if (wave >= 4) { RW_LOAD(rg, 0); RW_WRITE(rg, 0); RW_LOAD(rg, 1); }
    __syncthreads();
    const int rw = lane >> 3, j = lane & 7, rl = wave * 8 + rw;
    f32x2 S[4] = {{0.f, 0.f}, {0.f, 0.f}, {0.f, 0.f}, {0.f, 0.f}};
#define RW_STEP(dst, dv, st_) do { const LAS float* sp_ = cb + (st_) * 384; \
        _Pragma("unroll") for (int s_ = 0; s_ < 5; ++s_) { dst[2 * s_] = *(const LAS f32x4*)(sp_ + s_ * 64); dst[2 * s_ + 1] = *(const LAS f32x4*)(sp_ + s_ * 64 + 4); } \
        dv = vb[(st_) * 384]; } while (0)
    for (int c = 0; c < NCH; ++c) {
        if (wave >= 4) { if (c + 1 < NCH) { RW_WRITE(rg, c + 1); if (c + 2 < NCH) RW_LOAD(rg, c + 2); } }
        else {
            const LAS float* cb = buf + (c & 1) * CHF + 8 * j;
            const LAS float* vb = buf + (c & 1) * CHF + 320 + half * 32 + rl;
            float* yp = Y + (tok0 + (size_t)c * TC) * 1024 + h * 64 + half * 32 + rl;
            f32x4 q[10]; float vv;
            RW_STEP(q, vv, 0);
#pragma unroll 8
            for (int st = 0; st < TC; ++st) {
                f32x4 n[10]; float nv; const int ns = st + 1 < TC ? st + 1 : st;
                RW_STEP(n, nv, ns);
                f32x2 ta = S[0] * q[0].lo, tb = S[1] * q[0].hi; ta = S[2] * q[1].lo + ta; tb = S[3] * q[1].hi + tb; ta = ta + tb;
                float d = ta[0] + ta[1];
                d += dppf<0xB1>(d); d += dppf<0x4E>(d); d += dppf<0x141>(d);
                S[0] = S[0] * q[2].lo - q[4].lo * d + q[6].lo * vv;
                S[1] = S[1] * q[2].hi - q[4].hi * d + q[6].hi * vv;
                S[2] = S[2] * q[3].lo - q[5].lo * d + q[7].lo * vv;
                S[3] = S[3] * q[3].hi - q[5].hi * d + q[7].hi * vv;
                f32x2 ua = S[0] * q[8].lo, ub = S[1] * q[8].hi; ua = S[2] * q[9].lo + ua; ub = S[3] * q[9].hi + ub; ua = ua + ub;
                float y = ua[0] + ua[1];
                y += dppf<0xB1>(y); y += dppf<0x4E>(y); y += dppf<0x141>(y);
                yp[(size_t)st * 1024] = y;
#pragma unroll
                for (int i = 0; i < 10; ++i) q[i] = n[i];
                vv = nv;
            }
        }
        __syncthreads();
    }
#undef RW_STEP
#undef RW_LOAD
#undef RW_BF4
#undef RW_WRITE
}

__device__ __forceinline__ void post_row(const Params& p, int t, int lane) {
    unsigned char* ws = p.ws;
    const float* Y = (const float*)(ws + WS_YRAW) + (size_t)t * 1024; const bf16_t* G = (const bf16_t*)(ws + WS_G) + (size_t)t * 1024;
    const float* AA = p.out + (size_t)MT * 1024 + (size_t)t * 1024;
    const bf16_t* cur = (const bf16_t*)(ws + WS_PRW) + (size_t)t * NF32; const bool first = (t & (SEQ - 1)) == 0; const bf16_t* prv = first ? cur : cur - NF32; const float fz = first ? 0.f : 1.f; const float* mu = p.in[8];
    bf16_t* YB = (bf16_t*)(ws + WS_KN) + (size_t)t * 1024;
#pragma unroll
    for (int pp = 0; pp < 2; ++pp) {
        f32x4 y_[2], r_[2], k_[2], v_[2], rk_[2], lg_[2], lb_[2], a_[2], ka_[2]; u32x2 g_[2];
#pragma unroll
        for (int q = 0; q < 2; ++q) { const int c = (2 * pp + q) * 256 + lane * 4;
            y_[q] = *(const f32x4*)(Y + c); a_[q] = *(const f32x4*)(AA + c); ka_[q] = *(const f32x4*)(p.in[15] + c);
            { const f32x4 rc = ld4bf(cur + c), rp = ld4bf(prv + c) * fz, kc = ld4bf(cur + 1024 + c), kp = ld4bf(prv + 1024 + c) * fz, vc = ld4bf(cur + 2048 + c), vp = ld4bf(prv + 2048 + c) * fz;
              r_[q] = rc + (rp - rc) * *(const f32x4*)(mu + c); k_[q] = kc + (kp - kc) * *(const f32x4*)(mu + 1024 + c); v_[q] = vc + (vp - vc) * *(const f32x4*)(mu + 2048 + c); }
            rk_[q] = *(const f32x4*)(p.in[16] + c); lg_[q] = *(const f32x4*)(p.in[17] + c); lb_[q] = *(const f32x4*)(p.in[18] + c); g_[q] = *(const u32x2*)(G + c); }
#pragma unroll
        for (int q = 0; q < 2; ++q) { const int c = (2 * pp + q) * 256 + lane * 4;
            const f32x4 y = y_[q];
            const float mean = rowsum16((y[0] + y[1]) + (y[2] + y[3])) * (1.f / 64.f);
            const f32x4 d = y - mean;
            const float var = rowsum16((d[0] * d[0] + d[1] * d[1]) + (d[2] * d[2] + d[3] * d[3])) * (1.f / 64.f);
            const float rs = __builtin_amdgcn_rsqf(var + LNX_EPS);
            const f32x4 yn = d * rs * lg_[q] + lb_[q];
            const f32x4 pr = r_[q] * (k_[q] * ((a_[q] - 1.f) * ka_[q] + 1.f)) * rk_[q];
            const float bs = rowsum16((pr[0] + pr[1]) + (pr[2] + pr[3]));
            const u32x2 gw = g_[q];
            const f32x4 o = (yn + v_[q] * bs) * (f32x4){bflo(gw.x), bfhi(gw.x), bflo(gw.y), bfhi(gw.y)};
            u32x2 w; w.x = pk2(o[0], o[1]); w.y = pk2(o[2], o[3]); *(u32x2*)(YB + c) = w; }
    }
}

__device__ __forceinline__ void og_row(const Params& p, int t, int lane) {
    unsigned char* ws = p.ws;
    bf16_t* O = (bf16_t*)(ws + WS_O) + (size_t)t * 1024; const bf16_t* SG = (const bf16_t*)(ws + WS_PBF) + (size_t)t * PBP + 3072;
    u32x4 o8[2], s8[2];
#pragma unroll
    for (int ps = 0; ps < 2; ++ps) { o8[ps] = *(const u32x4*)(O + ps * 512 + lane * 8); s8[ps] = *(const u32x4*)(SG + ps * 512 + lane * 8); }
#pragma unroll
    for (int ps = 0; ps < 2; ++ps) { const int c = ps * 512 + lane * 8;
        const u32x4 o = o8[ps], s = s8[ps]; u32x4 w;
        w.x = pk2(bflo(o.x) * bflo(s.x), bfhi(o.x) * bfhi(s.x)); w.y = pk2(bflo(o.y) * bflo(s.y), bfhi(o.y) * bfhi(s.y));
        w.z = pk2(bflo(o.z) * bflo(s.z), bfhi(o.z) * bfhi(s.z)); w.w = pk2(bflo(o.w) * bflo(s.w), bfhi(o.w) * bfhi(s.w));
        *(u32x4*)(O + c) = w; }
}

__device__ __forceinline__ void cumsum_job(const Params& p, int job, LAS unsigned char* lds, int tid, int wave, int lane) {
    unsigned char* ws = p.ws; float* CUM = (float*)(ws + WS_CUM); LAS float* wsum = (LAS float*)lds;
    const int b = job >> 3, h = job & 7; const float bias = p.in[5][h]; const int t0 = tid * 4; float l[4];
#pragma unroll
    for (int i = 0; i < 4; ++i) { const float x = ((const float*)(ws + WS_LF))[(size_t)(b * SEQ + t0 + i) * 256 + 192 + h] + bias; l[i] = fminf(x, 0.f) - log1pf(expf(-fabsf(x))); }
    l[1] += l[0]; l[2] += l[1]; l[3] += l[2];
    const float tot = l[3]; float sc = tot;
#pragma unroll
    for (int o = 1; o < 64; o <<= 1) { const float n = __shfl_up(sc, o); if (lane >= o) sc += n; }
    __syncthreads();
    if (lane == 63) wsum[wave] = sc;
    __syncthreads();
    float woff = 0.f;
    for (int w = 0; w < wave; ++w) woff += wsum[w];
    const float base = woff + sc - tot;
    *(f32x4*)(CUM + (size_t)job * SEQ + t0) = (f32x4){base + l[0], base + l[1], base + l[2], base + l[3]};
}

typedef __hip_bfloat16 fabt;
__device__ __forceinline__ fa::BlockRef<fabt, fabt> fa_ref(int L, int pass, const fabt* Qn, const fabt* Kn, const fabt* Vb, fabt* O, const float* CUM) {
    const int bh = (L & 127) >> 2, x = L & 3, qb = pass ? 7 - x : x, b = bh >> 3, h = bh & 7; const size_t row0 = (size_t)b * SEQ;
    fa::BlockRef<fabt, fabt> r;
    r.Q = Qn + (row0 + (size_t)qb * 256) * 1024 + h * 128; r.O = O + (row0 + (size_t)qb * 256) * 1024 + h * 128;
    r.K = Kn + row0 * 1024 + h * 128; r.V = Vb + row0 * PBP + h * 128; r.SG = Vb + (row0 + (size_t)qb * 256) * PBP + 1024 + h * 128; r.CB = CUM + bh * SEQ; r.P0 = qb * 256;
    return r;
}
#ifndef REP_P0
#define REP_P0 1
#endif
#ifndef REP_P3
#define REP_P3 1
#endif
#ifndef REP_REC
#define REP_REC 1
#endif
#ifndef REP_P10
#define REP_P10 1
#endif
#ifndef REP_P2
#define REP_P2 1
#endif
#ifndef REP_ATT
#define REP_ATT 1
#endif
#ifndef REP_P7B
#define REP_P7B 1
#endif
#ifndef REP_P8
#define REP_P8 1
#endif
#ifndef PROBE_MASK
#define PROBE_MASK 0
#endif
#ifndef PROBE_MULT
#define PROBE_MULT 8
#endif
#ifndef GU_SPLIT
#define GU_SPLIT 11264
#endif
#ifndef REP_SYNC
#define REP_SYNC 0
#endif
__global__ void __launch_bounds__(512) mk_fwd(Params p) {
    extern __shared__ __attribute__((aligned(16))) unsigned char lds_raw[];
    cg::grid_group grid = cg::this_grid();
    LAS unsigned char* lds = (LAS unsigned char*)lds_raw;
    if (threadIdx.x < 2) ((LAS unsigned*)(lds + 131072))[threadIdx.x] = 0u;
    __syncthreads();
#if PROBE_MASK
    unsigned long long* tsb = (unsigned long long*)(p.ws + WS_BAR + 49152); int nts = 0;
#define STAMP() do { if (blockIdx.x == 0 && threadIdx.x == 0) tsb[nts] = __builtin_amdgcn_s_memrealtime(); ++nts; } while (0)
#else
#define STAMP() do {} while (0)
#endif
    STAMP();
    const XcdBarrier bar = xcd_barrier_post((unsigned*)(p.ws + WS_BAR), (volatile LAS unsigned*)(lds + 131072));
    const int G = gridDim.x, blk = blockIdx.x, NGW = G * 8;
#define PHASE_IDS() int tid = threadIdx.x; asm volatile("" : "+v"(tid)); const int lane = tid & 63, wave = __builtin_amdgcn_readfirstlane(tid >> 6), gw = blk * 8 + wave; (void)gw; (void)lane; LAS float* scr = (LAS float*)(lds + wave * 8704); (void)scr
    unsigned char* ws = p.ws;
    float* MOD = (float*)(ws + WS_MOD); float* CUM = (float*)(ws + WS_CUM); float* PART = (float*)(ws + WS_PART);
    bf16_t* XN = (bf16_t*)(ws + WS_XN); bf16_t* PBF = (bf16_t*)(ws + WS_PBF); float* PF32 = (float*)(ws + WS_PF32);

    for (int rep_ = 0; rep_ < REP_P0; ++rep_) {
        PHASE_IDS();
        __syncthreads();
        LAS float* sl = (LAS float*)(lds + 73728);
        for (int i = tid; i < NB * DM; i += 512) { const float v = p.in[1][i]; sl[i] = v * sigm(v); }
        __syncthreads();
        constexpr int I_MOD = 16 * 48, I_IN = 32 * (NPROJ / 64), I_OUT = 32 * 32, I_A = 16 * 32;
        const int vgw = wave * G + blk, ntr = I_IN;
        for (int r = vgw; r < I_MOD; r += 8 * G) {
            const int ks = r / 48, cc = r % 48;
            const float* wp = p.in[2] + (size_t)(ks * 128) * NMOD + cc * 256 + lane * 4;
            f32x4 a0 = {0.f, 0.f, 0.f, 0.f}, a1 = a0, a2 = a0, a3 = a0;
#pragma unroll 16
            for (int rr = 0; rr < 128; ++rr) { const f32x4 w = __builtin_nontemporal_load((const f32x4*)(wp + (size_t)rr * NMOD)); const int d = ks * 128 + rr;
                a0 += w * sl[d]; a1 += w * sl[DM + d]; a2 += w * sl[2 * DM + d]; a3 += w * sl[3 * DM + d]; }
            float* pp = PART + (size_t)(ks * 4) * NMOD + cc * 256 + lane * 4;
            *(f32x4*)pp = a0; *(f32x4*)(pp + NMOD) = a1; *(f32x4*)(pp + 2 * NMOD) = a2; *(f32x4*)(pp + 3 * NMOD) = a3;
        }
        const bool bal = (G == 256);
        const int t_lo = bal ? (vgw < 768 ? vgw : 768 + 4 * (vgw - 768)) : vgw, t_n = bal ? (vgw < 768 ? 1 : 4) : ntr, t_st = bal ? 1 : 8 * G;
        for (int k = 0; k < t_n; ++k) {
            int r = t_lo + k * t_st; if (r >= ntr) break;
            transpose_item2(p.in[4], 11720, (bf16_t*)(ws + WS_WIN), DM, r / (NPROJ / 64), r % (NPROJ / 64), scr, lane, MapWin());
        }
        bf16_t* WL = (bf16_t*)(ws + WS_WLORA);
        for (int idx = blk * 512 + tid; idx < 3072 * 32; idx += G * 512) {
            const int n = idx % 3072, kc = idx / 3072, k0 = kc * 8; float v[8];
#pragma unroll
            for (int i = 0; i < 8; ++i) { const int k = k0 + i; float x = 0.f;
                if (n < 1024) { if (k < 96) x = p.in[10][(size_t)k * 1024 + n]; }
                else if (n < 2048) { if (k >= 128 && k < 224) x = p.in[12][(size_t)(k - 128) * 1024 + (n - 1024)]; }
                else x = p.in[13][(size_t)k * 1024 + (n - 2048)];
                v[i] = x; }
            u32x4 o; o.x = pk2(v[0], v[1]); o.y = pk2(v[2], v[3]); o.z = pk2(v[4], v[5]); o.w = pk2(v[6], v[7]);
            *(u32x4*)(WL + (size_t)n * 256 + k0) = o;
        }
    }
    grid.sync();
    STAMP();
    for (int rep_ = 0; rep_ < REP_SYNC; ++rep_) xcd_barrier(bar);

    {
        PHASE_IDS();
        LAS float* lsm = (LAS float*)lds;
        for (int rb = blk; rb < MT / 32; rb += G) {
            const int b = rb / 64;
            __syncthreads();
            for (int i = tid; i < 2 * DM; i += 512) { float s = p.in[3][i];
#pragma unroll
                for (int ks = 0; ks < 16; ++ks) s += PART[(size_t)(ks * 4 + b) * NMOD + i];
                lsm[i] = s; }
            __syncthreads();
            for (int rr = wave; rr < 32; rr += 16) { const int row = rb * 32 + rr, row2 = row + 8;
                const float* xr = p.in[0] + (size_t)row * DM + lane * 4; const float* xr2 = p.in[0] + (size_t)row2 * DM + lane * 4; f32x4 v[8], u[8];
#pragma unroll
                for (int j = 0; j < 8; ++j) { v[j] = __builtin_nontemporal_load((const f32x4*)(xr + j * 256)); u[j] = __builtin_nontemporal_load((const f32x4*)(xr2 + j * 256)); }
                float mean, rstd, mean2, rstd2; ln_stats(v, mean, rstd); ln_stats(u, mean2, rstd2);
                bf16_t* orow = XN + (size_t)row * DM + lane * 4; bf16_t* orow2 = XN + (size_t)row2 * DM + lane * 4;
#pragma unroll
                for (int j = 0; j < 8; ++j) { const int c = j * 256 + lane * 4; const f32x4 sh = *(const LAS f32x4*)(lsm + c), sc = *(const LAS f32x4*)(lsm + DM + c);
                    const f32x4 o = (v[j] - mean) * rstd * (sc + 1.f) + sh; u32x2 w; w.x = pk2(o[0], o[1]); w.y = pk2(o[2], o[3]); *(u32x2*)(orow + j * 256) = w;
                    const f32x4 o2 = (u[j] - mean2) * rstd2 * (sc + 1.f) + sh; u32x2 w2; w2.x = pk2(o2[0], o2[1]); w2.y = pk2(o2[2], o2[3]); *(u32x2*)(orow2 + j * 256) = w2; } }
        }
        for (int i = blk * 512 + tid; i < NB * NMOD; i += G * 512) { const int b = i / NMOD, col = i % NMOD; float s = p.in[3][col];
#pragma unroll
            for (int ks = 0; ks < 16; ++ks) s += PART[(size_t)(ks * 4 + b) * NMOD + col];
            MOD[i] = s; }
    }
    xcd_barrier(bar);
    STAMP();

    for (int rep_ = 0; rep_ < REP_P2; ++rep_) {
        {
        pg8::StaticOrder S; S.init(MT, NBF, G, blk);
        pg8::Gemm g{XN, (const bf16_t*)(ws + WS_WIN), MT, NBF, DM}; pg8::EpiProjBf E{PBF};
        pg8::gemm_phase<pg8::EpiProjBf, pg8::StaticOrder, true, true>(lds, g, S, E);
        }
        {
        pg8::StaticOrder S; S.init(MT, NF32, G, blk);
        pg8::Gemm g{XN, (const bf16_t*)(ws + WS_WIN) + (size_t)NBF * DM, MT, NF32, DM}; pg8::EpiRw E{(bf16_t*)(ws + WS_PRW), (float*)(ws + WS_LF)};
        pg8::gemm_phase<pg8::EpiRw, pg8::StaticOrder, true, true>(lds, g, S, E);
        }
    }
    xcd_barrier(bar);
    STAMP();

    for (int rep_ = 0; rep_ < REP_P3; ++rep_) {
        PHASE_IDS();
        __syncthreads();
        for (int row = gw; row < MT; row += NGW) prep_row(p, row, lane);
    }
    xcd_barrier(bar);
    STAMP();

    {
        { pg8::StaticOrder S; S.init(MT, 2048, G, blk);
          pg8::Gemm g{(const bf16_t*)(ws + WS_ACAT), (const bf16_t*)(ws + WS_WLORA), MT, 2048, 256};
          pg8::EpiLora E{p.in[9], p.in[11], p.out, p.out + (size_t)MT * 1024, (bf16_t*)(ws + WS_G), 0};
          pg8::gemm_phase<pg8::EpiLora, pg8::StaticOrder, true, true>(lds, g, S, E); }
    }
    xcd_barrier(bar);
    STAMP();

    if (blk >= G / 2) {
        pg8::StaticOrder S; S.init(MT, 1024, G - G / 2, blk - G / 2);
        pg8::Gemm g{(const bf16_t*)(ws + WS_ACAT2), (const bf16_t*)(ws + WS_WLORA) + (size_t)2048 * 256, MT, 1024, 256};
        pg8::EpiLora E{p.in[9], p.in[11], p.out, p.out + (size_t)MT * 1024, (bf16_t*)(ws + WS_G), 8};
        pg8::gemm_phase<pg8::EpiLora, pg8::StaticOrder, true, true>(lds, g, S, E);
    }
    {
        PHASE_IDS();
        const int NREC = G / 2;
        if (blk < NREC) {
            for (int rep_ = 0; rep_ < REP_REC; ++rep_)
            for (int job = blk; job < 128; job += NREC)
                rwkv_job(lds, job, p.in[8], p.in[14], p.in[15], (const bf16_t*)(ws + WS_PRW), p.out, p.out + (size_t)MT * 1024, (float*)(ws + WS_YRAW), tid, wave, lane);
        } else {
            const int AW = G - NREC, total = 128 * REP_ATT; int L = blk - NREC;
            for (int Lc = blk - NREC; Lc < 128; Lc += AW) cumsum_job(p, Lc >> 2, lds, tid, wave, lane);
            asm volatile("s_waitcnt vmcnt(0)" ::: "memory"); __syncthreads();
            if (L < total) {
                const fabt* Qn = (const fabt*)(ws + WS_QN); const fabt* Kn = (const fabt*)(ws + WS_KN); const fabt* Vb = (const fabt*)(ws + WS_PBF) + 2048; fabt* O = (fabt*)(ws + WS_O);
                constexpr int W = 1 << 20; char* ldsc = (char*)lds_raw;
                int pass = 0; fa::BlockRef<fabt, fabt> cur = fa_ref(L, 0, Qn, Kn, Vb, O, CUM);
                fa::Seam<fabt> S;
                fa::causal_swa_prime<fabt, fabt, 1024, 1024, PBP>(cur, W, ldsc, S);
                for (;;) {
                    const bool more_pass = pass == 0, more_item = L + AW < total, last = !more_pass && !more_item;
                    int passn = pass + 1, Ln = L;
                    if (!more_pass) { passn = 0; Ln = more_item ? L + AW : L; }
                    const fa::BlockRef<fabt, fabt> nxt = last ? cur : fa_ref(Ln, passn, Qn, Kn, Vb, O, CUM);
                    fa::causal_swa_block<fabt, fabt, 1024, 1024, PBP>(cur, nxt, SEQ, W, ldsc, S);
                    if (last) break;
                    cur = nxt; pass = passn; L = Ln;
                }
            }
            __syncthreads();
            const int aw = (blk - NREC) * 8 + wave, AWV = AW * 8;
            for (int r = aw; r < (DFF / 64) * 32; r += AWV) transpose_item2(p.in[25], DM, (bf16_t*)(ws + WS_WDOWN), DFF, r / 32, r % 32, scr, lane, MapId());
            for (int r = aw; r < 32 * (2 * DFF / 64); r += AWV) transpose_item2(p.in[24], 2 * DFF, (bf16_t*)(ws + WS_WGU), DM, r / (2 * DFF / 64), r % (2 * DFF / 64), scr, lane, MapGu());
            for (int r = aw; r < 32 * 32; r += AWV) transpose_item2(p.in[21], DM, (bf16_t*)(ws + WS_WOUT), DM, r / 32, r % 32, scr, lane, MapId());
            for (int r = aw; r < 2 * 16 * 32; r += AWV) { const int q = r & 511; transpose_item2(r < 512 ? p.in[19] : p.in[20], DM, (bf16_t*)(ws + (r < 512 ? WS_WA : WS_WB)), 1024, q / 32, q % 32, scr, lane, MapId()); }
        }
    }
    xcd_barrier(bar);
    STAMP();

    {
        PHASE_IDS();
        for (int row = gw; row < MT; row += NGW) post_row(p, row, lane);
    }
    xcd_barrier(bar);
    STAMP();

    for (int rep_ = 0; rep_ < REP_P7B; ++rep_) {
        pg8::StaticOrder S; S.init(MT, DM, G, blk);
        pg8::Gemm g{(const bf16_t*)(ws + WS_O), (const bf16_t*)(ws + WS_WA), MT, DM, 1024, (const bf16_t*)(ws + WS_KN), (const bf16_t*)(ws + WS_WB)};
        pg8::EpiMergeDual E{PBF + 4096, PBF + 6144, (bf16_t*)(ws + WS_MERGED)};
        pg8::gemm_phase<pg8::EpiMergeDual, pg8::StaticOrder, true, true, true>(lds, g, S, E);
    }
    xcd_barrier(bar);
    STAMP();

    const bool fusedln = (G == 256);
    if (fusedln) {
        pg8::StaticOrder S; S.init(MT, DM, G, blk);
        pg8::Gemm g{(const bf16_t*)(ws + WS_MERGED), (const bf16_t*)(ws + WS_WOUT), MT, DM, DM};
        pg8::EpiResLnLn E{p.in[0], p.out, XN, MOD, p.in[22], p.in[23], (float*)(ws + WS_SLOT), (float*)(ws + WS_SLOT + 512 * 1024), &bar};
        pg8::gemm_phase<pg8::EpiResLnLn, pg8::StaticOrder, false, true>(lds, g, S, E);
        xcd_barrier(bar);
    } else {
        for (int rep_ = 0; rep_ < REP_P8; ++rep_) {
            pg8::StaticOrder S; S.init(MT, DM, G, blk);
            pg8::Gemm g{(const bf16_t*)(ws + WS_MERGED), (const bf16_t*)(ws + WS_WOUT), MT, DM, DM}; pg8::EpiRes E{p.in[0], p.out, MOD + 2 * DM};
            pg8::gemm_phase<pg8::EpiRes, pg8::StaticOrder, true, true>(lds, g, S, E);
        }
        xcd_barrier(bar);
        STAMP();

        { PHASE_IDS();
        for (int row = gw; row < MT; row += 2 * NGW) {
            const int row2 = row + NGW < MT ? row + NGW : row;
            float* xr = p.out + (size_t)row * DM + lane * 4; float* xr2 = p.out + (size_t)row2 * DM + lane * 4; f32x4 v[8], u[8];
    #pragma unroll
            for (int j = 0; j < 8; ++j) { v[j] = *(const f32x4*)(xr + j * 256); u[j] = *(const f32x4*)(xr2 + j * 256); }
            float mean, rstd, mean2, rstd2; ln_stats(v, mean, rstd); ln_stats(u, mean2, rstd2);
    #pragma unroll
            for (int j = 0; j < 8; ++j) { const int c = j * 256 + lane * 4; const f32x4 g = *(const f32x4*)(p.in[22] + c), b = *(const f32x4*)(p.in[23] + c);
                v[j] = (v[j] - mean) * rstd * g + b; u[j] = (u[j] - mean2) * rstd2 * g + b; *(f32x4*)(xr + j * 256) = v[j]; if (row2 != row) *(f32x4*)(xr2 + j * 256) = u[j]; }
            ln_stats(v, mean, rstd); ln_stats(u, mean2, rstd2);
            const float* mb = MOD + (size_t)(row / SEQ) * NMOD; const float* mb2 = MOD + (size_t)(row2 / SEQ) * NMOD;
            bf16_t* orow = XN + (size_t)row * DM + lane * 4; bf16_t* orow2 = XN + (size_t)row2 * DM + lane * 4;
    #pragma unroll
            for (int j = 0; j < 8; ++j) { const int c = j * 256 + lane * 4;
                { const f32x4 sh = *(const f32x4*)(mb + 3 * DM + c), sc = *(const f32x4*)(mb + 4 * DM + c);
                  const f32x4 o = (v[j] - mean) * rstd * (sc + 1.f) + sh; u32x2 w; w.x = pk2(o[0], o[1]); w.y = pk2(o[2], o[3]); *(u32x2*)(orow + j * 256) = w; }
                if (row2 != row) { const f32x4 sh = *(const f32x4*)(mb2 + 3 * DM + c), sc = *(const f32x4*)(mb2 + 4 * DM + c);
                  const f32x4 o = (u[j] - mean2) * rstd2 * (sc + 1.f) + sh; u32x2 w; w.x = pk2(o[0], o[1]); w.y = pk2(o[2], o[3]); *(u32x2*)(orow2 + j * 256) = w; } }
        } }
        xcd_barrier(bar);
        STAMP();
    }

    for (int rep_ = 0; rep_ < REP_P10; ++rep_) {
        pg8::StaticOrder S; S.init(MT, 2 * DFF, G, blk);
        pg8::Gemm g{XN, (const bf16_t*)(ws + WS_WGU), MT, 2 * DFF, DM}; pg8::EpiSwiGLU E{PBF};
        pg8::gemm_phase<pg8::EpiSwiGLU, pg8::StaticOrder, true, true>(lds, g, S, E);
    }
    xcd_barrier(bar);
    STAMP();

    if (fusedln) {
        pg8::StaticOrder S; S.init(MT, DM, G, blk);
        pg8::Gemm g{PBF, (const bf16_t*)(ws + WS_WDOWN), MT, DM, DFF};
        pg8::EpiResLn E{p.out, p.out, MOD + 5 * DM, p.in[26], p.in[27], (float*)(ws + WS_SLOT + 1024 * 1024), &bar};
        pg8::gemm_phase<pg8::EpiResLn, pg8::StaticOrder, false, true>(lds, g, S, E);
    } else {
        {
            pg8::StaticOrder S; S.init(MT, DM, G, blk);
            pg8::Gemm g{PBF, (const bf16_t*)(ws + WS_WDOWN), MT, DM, DFF}; pg8::EpiRes E{p.out, p.out, MOD + 5 * DM};
            pg8::gemm_phase<pg8::EpiRes, pg8::StaticOrder, true, true>(lds, g, S, E);
        }
        xcd_barrier(bar);
        STAMP();

        { PHASE_IDS();
        for (int row = gw; row < MT; row += 2 * NGW) {
            const int row2 = row + NGW < MT ? row + NGW : row;
            float* xr = p.out + (size_t)row * DM + lane * 4; float* xr2 = p.out + (size_t)row2 * DM + lane * 4; f32x4 v[8], u[8];
    #pragma unroll
            for (int j = 0; j < 8; ++j) { v[j] = *(const f32x4*)(xr + j * 256); u[j] = *(const f32x4*)(xr2 + j * 256); }
            float mean, rstd, mean2, rstd2; ln_stats(v, mean, rstd); ln_stats(u, mean2, rstd2);
    #pragma unroll
            for (int j = 0; j < 8; ++j) { const int c = j * 256 + lane * 4; const f32x4 g = *(const f32x4*)(p.in[26] + c), b = *(const f32x4*)(p.in[27] + c);
                *(f32x4*)(xr + j * 256) = (v[j] - mean) * rstd * g + b; if (row2 != row) *(f32x4*)(xr2 + j * 256) = (u[j] - mean2) * rstd2 * g + b; }
        } }
    }
#if PROBE_MASK
    STAMP();
    if (blockIdx.x == 0 && threadIdx.x == 0) { unsigned long long sp = 0; for (int i = 0; i + 1 < nts; ++i) if ((PROBE_MASK >> i) & 1) sp += tsb[i + 1] - tsb[i];
        const unsigned long long t0 = __builtin_amdgcn_s_memrealtime(); while (__builtin_amdgcn_s_memrealtime() - t0 < sp * PROBE_MULT) __builtin_amdgcn_s_sleep(8); }
#endif
}

extern "C" void kernel_launch(void* const* d_in, const int* in_sizes, int n_in, void* d_out, int out_size, void* d_ws, size_t ws_size, hipStream_t stream) {
    static int grid_blocks = 0;
    if (grid_blocks == 0) {
        if (n_in != 28 || out_size != MT * DM || ws_size < WS_END) { fprintf(stderr, "kernel_launch: unexpected shapes (n_in %d out %d ws %zu, need %zu)\n", n_in, out_size, ws_size, (size_t)WS_END); grid_blocks = -1; return; }
        int dev = 0, cus = 0, per_cu = 0;
        hipGetDevice(&dev);
        hipDeviceGetAttribute(&cus, hipDeviceAttributeMultiprocessorCount, dev);
        hipFuncSetAttribute((const void*)mk_fwd, hipFuncAttributeMaxDynamicSharedMemorySize, LDS_BYTES);
        hipOccupancyMaxActiveBlocksPerMultiprocessor(&per_cu, (const void*)mk_fwd, 512, LDS_BYTES);
        if (per_cu < 1 || cus < 1) { fprintf(stderr, "kernel_launch: occupancy query failed (%d x %d)\n", cus, per_cu); grid_blocks = -1; return; }
        grid_blocks = cus * per_cu;
        if (grid_blocks > 256) grid_blocks = 256;
    }
    if (grid_blocks < 0) return;
    if (hipMemsetAsync((char*)d_ws + WS_BAR, 0, 65536, stream) != hipSuccess) { fprintf(stderr, "kernel_launch: memset of the barrier words failed\n"); return; }
    Params p{};
    for (int i = 0; i < 28; ++i) p.in[i] = (const float*)d_in[i];
    p.out = (float*)d_out; p.ws = (unsigned char*)d_ws;
    void* args[] = {&p};
    hipError_t e = hipLaunchCooperativeKernel((const void*)mk_fwd, dim3(grid_blocks), dim3(512), args, LDS_BYTES, stream);
    if (e != hipSuccess) fprintf(stderr, "cooperative launch failed: %s (grid %d)\n", hipGetErrorString(e), grid_blocks);
}
```

```cpp
#include <hip/hip_runtime.h>
#include <hip/hip_bf16.h>
#include <hip/hip_cooperative_groups.h>
#include <cstdio>
#include <cstdint>
namespace cg = cooperative_groups;

namespace pg8 {
#define PG8_LAS __attribute__((address_space(3)))
typedef unsigned short bf16_t;
typedef short bf16x8 __attribute__((ext_vector_type(8)));
typedef float f32x4 __attribute__((ext_vector_type(4)));
typedef unsigned u32x4 __attribute__((ext_vector_type(4)));
constexpr int BM = 256, BK = 64, HALF = 128, HTB = HALF * BK * 2  , STAGE_BYTES = 8 * HTB, NXCD = 8, WGM = 8;

__host__ __device__ __forceinline__ int lds_byte(int r, int c) { const int st = (r >> 4) * 2 + (c >> 5), rr = r & 15, cc = c & 31, ob = rr * 64 + cc * 2; return st * 1024 + (ob ^ (((ob >> 9) & 1) << 5)); }
__host__ __device__ __forceinline__ void stage_rc(int b, int& R, int& C) { const int st = b / 1024, sb = b % 1024, swz = sb ^ (((sb >> 9) & 1) << 5); R = (st >> 1) * 16 + swz / 64; C = (st & 1) * 32 + (swz % 64) / 2; }
__host__ __device__ __forceinline__ int perm32(int rho) { const int n = rho >> 4, i = rho & 15; return 8 * (i >> 2) + 4 * n + (i & 3); }

struct Unit { int pm, pn; };
struct Gemm { const bf16_t* A; const bf16_t* Bt; int M, N, K; const bf16_t* A2 = nullptr; const bf16_t* Bt2 = nullptr; };

struct StaticOrder {
    int nM, nN, nwg, G, c;
    __host__ __device__ void init(int M, int N, int G_, int c_) { nM = M / BM; nN = N / BM; nwg = nM * nN; G = G_; c = c_; }
    __host__ __device__ bool next(int i, Unit& u) const {
        const long L = (long)i * G + c; if (L >= nwg) return false;
        int wgid = (int)L; { const int q = nwg / NXCD, r = nwg % NXCD, xcd = wgid % NXCD, off = wgid / NXCD; wgid = (xcd < r ? xcd * (q + 1) : r * (q + 1) + (xcd - r) * q) + off; }
        const int nig = WGM * nN, gid = wgid / nig, fm = gid * WGM, gsz = (nM - fm) < WGM ? (nM - fm) : WGM;
        u.pm = fm + ((wgid % nig) % gsz); u.pn = (wgid % nig) / gsz; return true;
    }
    __device__ __forceinline__ void a_ready(const Unit&) const {}
    __device__ __forceinline__ void done(const Unit&) const {}
};
__device__ __forceinline__ unsigned cvt_pk_bf16(float lo, float hi) { unsigned r; asm volatile("v_cvt_pk_bf16_f32 %0, %1, %2" : "=v"(r) : "v"(lo), "v"(hi)); return r; }
typedef float f32x2 __attribute__((ext_vector_type(2)));
template <class Epi, class Sched, bool ALIGN_EPI = false, bool SP2 = false, bool DUAL = false>
__device__ __forceinline__ void gemm_phase(PG8_LAS unsigned char* lds, const Gemm g, const Sched& S, const Epi& E) {
    int tid = threadIdx.x; asm volatile("" : "+v"(tid));
    const int wid = __builtin_amdgcn_readfirstlane(tid >> 6), lane = tid & 63, wr = wid >> 2, wc = wid & 3, fr = lane & 15, fq = lane >> 4;
    const int K = g.K, HT = K / BK, nt = DUAL ? 2 * HT : HT;
    unsigned voffA[2], voffB[2];
#pragma unroll
    for (int i = 0; i < 2; ++i) { int R, C; stage_rc(tid * 16 + i * 8192, R, C); const int Rb = Epi::PERM ? ((R & ~31) + perm32(R & 31)) : R;
        voffA[i] = (unsigned)(R * K + C) * 2u; voffB[i] = (unsigned)(Rb * K + C) * 2u; }
    const size_t kstep = (size_t)(BK * 2);
    const size_t hstep = (size_t)HALF * K * 2;
    const size_t tstep = 2 * hstep;
    const unsigned ldsw = (unsigned)wid * 1024u;
    const int aoff = lds_byte(wr * 64 + fr, fq * 8), boff = lds_byte(wc * 32 + fr, fq * 8);
#define PG8_SA(b, h) (((b) * 2 + (h)) * HTB)
#define PG8_SB(b, h) ((4 + (b) * 2 + (h)) * HTB)
#define PG8_STAGE(bufoff, gbase, voff) do { _Pragma("unroll") for (int _i = 0; _i < 2; ++_i) \
        __builtin_amdgcn_global_load_lds((const unsigned*)((const char*)(gbase) + (voff)[_i]), (PG8_LAS unsigned*)(lds + (bufoff) + ldsw + _i * 8192), 16, 0, 0); } while (0)
#define PG8_LDA(dst, b, h) do { _Pragma("unroll") for (int m = 0; m < 4; ++m) _Pragma("unroll") for (int k = 0; k < 2; ++k) dst[m][k] = *(const PG8_LAS bf16x8*)(lds + PG8_SA(b, h) + aoff + m * 2048 + k * 1024); } while (0)
#define PG8_LDB(dst, b, h) do { _Pragma("unroll") for (int n = 0; n < 2; ++n) _Pragma("unroll") for (int k = 0; k < 2; ++k) dst[n][k] = *(const PG8_LAS bf16x8*)(lds + PG8_SB(b, h) + boff + n * 2048 + k * 1024); } while (0)
#define PG8_MMA(ai, bj, At, Bt) do { __builtin_amdgcn_s_setprio(1); _Pragma("unroll") for (int m = 0; m < 4; ++m) _Pragma("unroll") for (int n = 0; n < 2; ++n) _Pragma("unroll") for (int k = 0; k < 2; ++k) \
        acc[ai][bj][m][n] = __builtin_amdgcn_mfma_f32_16x16x32_bf16(Bt[n][k], At[m][k], acc[ai][bj][m][n], 0, 0, 0); __builtin_amdgcn_s_setprio(0); } while (0)
#define PG8_WAIT_V(n) asm volatile("s_waitcnt vmcnt(" #n ")" ::: "memory")
#define PG8_WAIT_L(n) asm volatile("s_waitcnt lgkmcnt(" #n ")" ::: "memory")
#define PG8_BAR __builtin_amdgcn_s_barrier()
#define PG8_SCHED __builtin_amdgcn_sched_barrier(0)
    Unit cur, nxt; int ui = 0;
    if (!S.next(0, cur)) return;
    f32x4 acc[2][2][4][2];
#pragma unroll
    for (int a = 0; a < 2; ++a)
#pragma unroll
        for (int b = 0; b < 2; ++b)
#pragma unroll
            for (int m = 0; m < 4; ++m)
#pragma unroll
                for (int n = 0; n < 2; ++n) acc[a][b][m][n] = (f32x4){0.f, 0.f, 0.f, 0.f};
    bf16x8 At[4][2], B0[2][2], B1[2][2];
    const char* cA = (const char*)g.A + (size_t)cur.pm * tstep; const char* cB = (const char*)g.Bt + (size_t)cur.pn * tstep;
    S.a_ready(cur);
    if constexpr (SP2) {
        PG8_STAGE(PG8_SB(0, 0), cB, voffB); PG8_STAGE(PG8_SB(0, 1), cB + hstep, voffB); PG8_STAGE(PG8_SA(0, 0), cA, voffA); PG8_STAGE(PG8_SA(0, 1), cA + hstep, voffA);
        if (wr == 1) PG8_BAR;
        PG8_WAIT_V(2); PG8_BAR;
        PG8_STAGE(PG8_SB(1, 0), cB + kstep, voffB); PG8_STAGE(PG8_SA(1, 0), cA + kstep, voffA); PG8_STAGE(PG8_SB(1, 1), cB + hstep + kstep, voffB);
        PG8_WAIT_V(6); PG8_BAR;
    } else {
        PG8_STAGE(PG8_SB(0, 0), cB, voffB); PG8_STAGE(PG8_SA(0, 0), cA, voffA); PG8_STAGE(PG8_SB(0, 1), cB + hstep, voffB); PG8_STAGE(PG8_SA(0, 1), cA + hstep, voffA);
        if (wr == 1) PG8_BAR;
        PG8_WAIT_V(4); PG8_BAR;
        PG8_STAGE(PG8_SB(1, 0), cB + kstep, voffB); PG8_STAGE(PG8_SA(1, 0), cA + kstep, voffA); PG8_STAGE(PG8_SB(1, 1), cB + hstep + kstep, voffB);
        PG8_WAIT_V(6); PG8_BAR;
    }
    for (;;) {
        const bool has_next = S.next(ui + 1, nxt);
        const char* cA2 = DUAL ? (const char*)g.A2 + (size_t)cur.pm * tstep - (size_t)HT * kstep : cA; const char* cB2 = DUAL ? (const char*)g.Bt2 + (size_t)cur.pn * tstep - (size_t)HT * kstep : cB;
        const char* nA = has_next ? (const char*)g.A + (size_t)nxt.pm * tstep : cA; const char* nB = has_next ? (const char*)g.Bt + (size_t)nxt.pn * tstep : cB;
        for (int t = 0; t < nt; t += 2) {
            const bool last = (t == nt - 2);
            const char* bA0 = (DUAL && t >= HT) ? cA2 : cA; const char* bA2 = (DUAL && t + 2 >= HT) ? cA2 : cA; const char* bB2 = (DUAL && t + 2 >= HT) ? cB2 : cB;
            if constexpr (DUAL) { if (t == HT) E.mid(acc, cur, wr, wc, fr, fq); }
            const char* a1 = bA0 + (size_t)(t + 1) * kstep;
            const char* a2 = last ? nA : bA2 + (size_t)(t + 2) * kstep; const char* b2 = last ? nB : bB2 + (size_t)(t + 2) * kstep;
            const char* a3 = a2 + kstep; const char* b3 = b2 + kstep;
            if (last && has_next) S.a_ready(nxt);
            if constexpr (SP2) {
            PG8_LDB(B0, 0, 0); PG8_LDB(B1, 0, 1); PG8_SCHED; PG8_LDA(At, 0, 0); PG8_STAGE(PG8_SA(1, 1), a1 + hstep, voffA);
            PG8_WAIT_V(8); PG8_WAIT_L(0); PG8_BAR; PG8_MMA(0, 0, At, B0); PG8_MMA(0, 1, At, B1); PG8_BAR; PG8_SCHED;
            PG8_LDA(At, 0, 1); PG8_STAGE(PG8_SB(0, 0), b2, voffB); PG8_STAGE(PG8_SB(0, 1), b2 + hstep, voffB); PG8_STAGE(PG8_SA(0, 0), a2, voffA);
            PG8_WAIT_V(8); PG8_WAIT_L(0); PG8_BAR; PG8_MMA(1, 0, At, B0); PG8_MMA(1, 1, At, B1); PG8_BAR; PG8_SCHED;
            PG8_LDB(B0, 1, 0); PG8_LDB(B1, 1, 1); PG8_SCHED; PG8_LDA(At, 1, 0); PG8_STAGE(PG8_SA(0, 1), a2 + hstep, voffA);
            PG8_WAIT_V(8); PG8_WAIT_L(0); PG8_BAR; PG8_MMA(0, 0, At, B0); PG8_MMA(0, 1, At, B1); PG8_BAR; PG8_SCHED;
            PG8_LDA(At, 1, 1); PG8_STAGE(PG8_SB(1, 0), b3, voffB); PG8_STAGE(PG8_SB(1, 1), b3 + hstep, voffB); PG8_STAGE(PG8_SA(1, 0), a3, voffA);
            PG8_WAIT_V(8); PG8_WAIT_L(0); PG8_BAR; PG8_MMA(1, 0, At, B0); PG8_MMA(1, 1, At, B1); PG8_BAR; PG8_SCHED;
            } else {
            PG8_LDB(B0, 0, 0); PG8_SCHED; PG8_LDA(At, 0, 0); PG8_STAGE(PG8_SA(1, 1), a1 + hstep, voffA);
            PG8_WAIT_L(8); PG8_BAR; PG8_WAIT_L(0); PG8_MMA(0, 0, At, B0); PG8_BAR; PG8_SCHED;
            PG8_LDB(B1, 0, 1); PG8_STAGE(PG8_SB(0, 0), b2, voffB);
            PG8_BAR; PG8_WAIT_L(0); PG8_MMA(0, 1, At, B1); PG8_BAR;
            PG8_LDA(At, 0, 1); PG8_STAGE(PG8_SA(0, 0), a2, voffA);
            PG8_BAR; PG8_WAIT_L(0); PG8_MMA(1, 0, At, B0); PG8_BAR; PG8_SCHED;
            PG8_STAGE(PG8_SB(0, 1), b2 + hstep, voffB);
            PG8_WAIT_V(6); PG8_BAR; PG8_MMA(1, 1, At, B1); PG8_BAR;
            PG8_LDB(B0, 1, 0); PG8_SCHED; PG8_LDA(At, 1, 0); PG8_STAGE(PG8_SA(0, 1), a2 + hstep, voffA);
            PG8_WAIT_L(8); PG8_BAR; PG8_WAIT_L(0); PG8_MMA(0, 0, At, B0); PG8_BAR; PG8_SCHED;
            PG8_LDB(B1, 1, 1); PG8_STAGE(PG8_SB(1, 0), b3, voffB);
            PG8_BAR; PG8_WAIT_L(0); PG8_MMA(0, 1, At, B1); PG8_BAR;
            PG8_LDA(At, 1, 1); PG8_STAGE(PG8_SA(1, 0), a3, voffA);
            PG8_BAR; PG8_WAIT_L(0); PG8_MMA(1, 0, At, B0); PG8_BAR; PG8_SCHED;
            PG8_STAGE(PG8_SB(1, 1), b3 + hstep, voffB);
            PG8_WAIT_V(6); PG8_BAR; PG8_MMA(1, 1, At, B1); PG8_BAR;
            }
        }
        if constexpr (ALIGN_EPI) { if (wr == 0) PG8_BAR; }
        if constexpr (!Epi::AFTER_DRAIN) { E(acc, cur, wr, wc, fr, fq); S.done(cur); }
        if (!has_next) break;
#pragma unroll
        for (int a = 0; a < 2; ++a)
#pragma unroll
            for (int b = 0; b < 2; ++b)
#pragma unroll
                for (int m = 0; m < 4; ++m)
#pragma unroll
                    for (int n = 0; n < 2; ++n) acc[a][b][m][n] = (f32x4){0.f, 0.f, 0.f, 0.f};
        cur = nxt; cA = nA; cB = nB; ++ui;
        if constexpr (ALIGN_EPI) { if (wr == 1) PG8_BAR; }
    }
    PG8_WAIT_V(0);
    if constexpr (!ALIGN_EPI) { if (wr == 0) PG8_BAR; }
    PG8_BAR;
    if constexpr (Epi::AFTER_DRAIN) { E.fused(acc, cur, wr, wc, fr, fq, lds, wid, lane); S.done(cur); }
#undef PG8_SA
#undef PG8_SB
#undef PG8_STAGE
#undef PG8_LDA
#undef PG8_LDB
#undef PG8_MMA
#undef PG8_WAIT_V
#undef PG8_WAIT_L
#undef PG8_BAR
#undef PG8_SCHED
}
}
namespace fa {
constexpr int D = 128; constexpr bool WSKIP = false; constexpr float THR = 8.f;
constexpr float SCALE = 0.08838834764831845f;
constexpr int NW = 8, QBLK = 32, KVBLK = 64, QB = NW * QBLK;
constexpr int SHM_V = KVBLK * D * 2, SHM_K = KVBLK * D * 2;
constexpr int LDS_BYTES = 2 * SHM_V + 2 * SHM_K + NW * 64 * 4;
constexpr int KB_OFF = LDS_BYTES;
constexpr int FA_LDS_BYTES = LDS_BYTES + 2 * 2048 * 4;
__device__ __forceinline__ void load_kbias(const float* CB, int P0, float* dst) {
    const float c0 = CB[P0]; const float inv = 1.0f / SCALE;
    for (int s = threadIdx.x; s < P0 + QB; s += 512) dst[s] = (c0 - CB[s]) * inv;
}
using bf16 = __hip_bfloat16;
typedef short bf16x8 __attribute__((ext_vector_type(8)));
typedef short s16x4 __attribute__((ext_vector_type(4)));
typedef float f32x16 __attribute__((ext_vector_type(16)));
typedef float f32x4 __attribute__((ext_vector_type(4)));
typedef unsigned u32x4 __attribute__((ext_vector_type(4)));
template <class A, class Bt> struct same_t { static constexpr bool v = false; };
template <class A> struct same_t<A, A> { static constexpr bool v = true; };

#define KSWZ(row, colB) ((row) * 256 + ((colB) ^ (((row) & 7) << 4)))
#define SBAR() __builtin_amdgcn_sched_barrier(0)
__device__ __forceinline__ int v_st(int k, int c) { const int kk = (k & ~0xC) | ((k & 4) << 1) | ((k & 8) >> 1); return ((kk >> 3) * 4 + (c >> 5)) * 512 + ((kk & 7) * 32 + (c & 31)) * 2; }
__device__ __forceinline__ int v_rd_base(int lane) { return ((lane & 3) << 3) | (((lane >> 2) & 3) << 6) | (((lane >> 4) & 1) << 5) | (((lane >> 5) & 1) << 8); }
constexpr int v_rd_off(int d0, int ks, int half) { return d0 * 512 + ks * 4096 + half * 2048; }
__device__ __forceinline__ int crow(int r, int hi) { return (r & 3) + 8 * (r >> 2) + 4 * hi; }
__device__ __forceinline__ unsigned cvtpk(float lo, float hi) {
    unsigned r; asm volatile("v_cvt_pk_bf16_f32 %0, %1, %2" : "=v"(r) : "v"(lo), "v"(hi)); return r;
}
__device__ __forceinline__ bf16x8 pack8(f32x4 a, f32x4 b) {
    u32x4 w = {cvtpk(a[0], a[1]), cvtpk(a[2], a[3]), cvtpk(b[0], b[1]), cvtpk(b[2], b[3])};
    return *reinterpret_cast<bf16x8*>(&w);
}
template <class T> __device__ __forceinline__ bf16x8 load8(const T* p) {
    if constexpr (same_t<T, float>::v) { return pack8(*(const f32x4*)p, *(const f32x4*)(p + 4)); }
    else { return *reinterpret_cast<const bf16x8*>(p); }
}
__device__ __forceinline__ void mask_tile(f32x16& p0, f32x16& p1, int dq, unsigned W) {
    const float NEG = -__builtin_inff();
#pragma unroll
    for (int r = 0; r < 16; ++r) {
        const int c = (r & 3) + 8 * (r >> 2);
        if ((unsigned)(dq - c) >= W) p0[r] = NEG;
        if ((unsigned)(dq - c - 32) >= W) p1[r] = NEG;
    }
}
__device__ __forceinline__ void partialSM(f32x16& p0, f32x16& p1, float& m_reg, float& mn, float& alpha) {
    float pmax = p0[0]; for (int r = 1; r < 16; ++r) pmax = fmaxf(pmax, p0[r]); for (int r = 0; r < 16; ++r) pmax = fmaxf(pmax, p1[r]);
    { auto rr = __builtin_amdgcn_permlane32_swap(__float_as_uint(pmax), __float_as_uint(pmax), false, false);
      pmax = fmaxf(__uint_as_float(rr[0]), __uint_as_float(rr[1])); }
    constexpr float C2 = 1.4426950408889634f * SCALE;
    if (__builtin_expect(__all((pmax - m_reg) * SCALE <= THR), 1)) { mn = m_reg; alpha = 1.f; }
    else { mn = fmaxf(m_reg, pmax); alpha = __builtin_amdgcn_exp2f((m_reg - mn) * C2); m_reg = mn; }
    const float mnL = -mn * C2;
    for (int r = 0; r < 16; ++r) p0[r] = fmaf(p0[r], C2, mnL); for (int r = 0; r < 16; ++r) p1[r] = fmaf(p1[r], C2, mnL);
    for (int r = 0; r < 16; ++r) p0[r] = __builtin_amdgcn_exp2f(p0[r]);
}
__device__ __forceinline__ void finishSM(f32x16& p0, f32x16& p1, float alpha, float& l_reg, bf16x8& pa0, bf16x8& pa1, bf16x8& pa2, bf16x8& pa3) {
    for (int r = 0; r < 16; ++r) p1[r] = __builtin_amdgcn_exp2f(p1[r]);
    float ps = 0; for (int r = 0; r < 16; ++r) ps += p0[r]; for (int r = 0; r < 16; ++r) ps += p1[r];
    { auto rr = __builtin_amdgcn_permlane32_swap(__float_as_uint(ps), __float_as_uint(ps), false, false);
      ps = __uint_as_float(rr[0]) + __uint_as_float(rr[1]); }
    l_reg = l_reg * alpha + ps;
#define PK4(P, B_, OUT) do { unsigned a0 = cvtpk(P[B_+0], P[B_+1]), a1 = cvtpk(P[B_+2], P[B_+3]);                          \
        unsigned b0 = cvtpk(P[B_+4], P[B_+5]), b1 = cvtpk(P[B_+6], P[B_+7]);                                             \
        auto r0 = __builtin_amdgcn_permlane32_swap(a0, b0, false, false); auto r1 = __builtin_amdgcn_permlane32_swap(a1, b1, false, false); \
        u32x4 w = {r0[0], r1[0], r0[1], r1[1]}; OUT = *reinterpret_cast<bf16x8*>(&w); } while (0)
    PK4(p0, 0, pa0); PK4(p0, 8, pa1); PK4(p1, 0, pa2); PK4(p1, 8, pa3);
#undef PK4
}
template <int KB, bool SK>
__device__ __forceinline__ void qkt(f32x16& p0, f32x16& p1, const char* K_lds, int r32, int hi, const bf16x8* qr, bool act, const float* kbp) {
    if (SK && !act) { const float NEG = -__builtin_inff();
#pragma unroll
        for (int r = 0; r < 16; ++r) { p0[r] = NEG; p1[r] = NEG; } return; }
    p0 = f32x16{}; p1 = f32x16{};
    const char* kb[4];
#pragma unroll
    for (int dd = 0; dd < 4; ++dd) kb[dd] = K_lds + KB * SHM_K + KSWZ(r32, (dd * 16 + hi * 8) * 2);
#pragma unroll
    for (int d0 = 0; d0 < 8; ++d0) { const char* a = kb[d0 & 3] + (d0 >> 2) * 128;
        bf16x8 b0 = *reinterpret_cast<const bf16x8*>(a);
        bf16x8 b1 = *reinterpret_cast<const bf16x8*>(a + 32 * 256);
        p0 = __builtin_amdgcn_mfma_f32_32x32x16_bf16(b0, qr[d0], p0, 0, 0, 0);
        p1 = __builtin_amdgcn_mfma_f32_32x32x16_bf16(b1, qr[d0], p1, 0, 0, 0); }
    {
        const float c0_ = hi ? 0.f : kbp[r32], c1_ = hi ? 0.f : kbp[32 + r32];
        const unsigned hp = cvtpk(c0_, c1_); const float r0_ = c0_ - __uint_as_float(hp << 16), r1_ = c1_ - __uint_as_float(hp & 0xffff0000u);
        const unsigned mp = cvtpk(r0_, r1_); const unsigned lp = cvtpk(r0_ - __uint_as_float(mp << 16), r1_ - __uint_as_float(mp & 0xffff0000u));
        u32x4 k0_ = {(hp & 0xffffu) | (mp << 16), lp & 0xffffu, 0u, 0u}, k1_ = {(hp >> 16) | (mp & 0xffff0000u), lp >> 16, 0u, 0u};
        const u32x4 q1_ = {0x3F803F80u, 0x00003F80u, 0u, 0u};
        p0 = __builtin_amdgcn_mfma_f32_32x32x16_bf16(*reinterpret_cast<bf16x8*>(&k0_), *reinterpret_cast<const bf16x8*>(&q1_), p0, 0, 0, 0);
        p1 = __builtin_amdgcn_mfma_f32_32x32x16_bf16(*reinterpret_cast<bf16x8*>(&k1_), *reinterpret_cast<const bf16x8*>(&q1_), p1, 0, 0, 0); }
}
template <int VB, bool SK>
__device__ __forceinline__ void pv_tile(f32x16* o, int vb0, bf16x8 pa0, bf16x8 pa1, bf16x8 pa2, bf16x8 pa3, bool act) {
    if (SK && !act) return;
#define TRRD(dst, off) asm volatile("ds_read_b64_tr_b16 %0, %1 offset:%2" : "=&v"(dst) : "v"(vb0), "i"(off) : "memory")
#define PV_D0(d0) do { s16x4 l0, l1, l2, l3, h0, h1, h2, h3; constexpr int b_ = VB * SHM_V + v_rd_off(d0, 0, 0);     \
        TRRD(l0, b_); TRRD(h0, b_ + 2048); TRRD(l1, b_ + 4096); TRRD(h1, b_ + 6144); TRRD(l2, b_ + 8192); TRRD(h2, b_ + 10240); TRRD(l3, b_ + 12288); TRRD(h3, b_ + 14336); \
        asm volatile("s_waitcnt lgkmcnt(0)" ::: "memory"); SBAR();                 \
        o[d0] = __builtin_amdgcn_mfma_f32_32x32x16_bf16(pa0, (bf16x8){l0[0], l0[1], l0[2], l0[3], h0[0], h0[1], h0[2], h0[3]}, o[d0], 0, 0, 0);   \
        o[d0] = __builtin_amdgcn_mfma_f32_32x32x16_bf16(pa1, (bf16x8){l1[0], l1[1], l1[2], l1[3], h1[0], h1[1], h1[2], h1[3]}, o[d0], 0, 0, 0);   \
        o[d0] = __builtin_amdgcn_mfma_f32_32x32x16_bf16(pa2, (bf16x8){l2[0], l2[1], l2[2], l2[3], h2[0], h2[1], h2[2], h2[3]}, o[d0], 0, 0, 0);   \
        o[d0] = __builtin_amdgcn_mfma_f32_32x32x16_bf16(pa3, (bf16x8){l3[0], l3[1], l3[2], l3[3], h3[0], h3[1], h3[2], h3[3]}, o[d0], 0, 0, 0); } while (0)
    PV_D0(0); PV_D0(1); PV_D0(2); PV_D0(3);
#undef PV_D0
#undef TRRD
}
template <class TIn, class TOut> struct BlockRef { const TIn* Q; const TIn* K; const TIn* V; TOut* O; const TOut* SG; const float* CB; int P0; };
template <class TIn> struct Seam {
    bf16x8 qr[8];
    bf16x8 st_v0, st_v1, st_k0, st_k1; f32x4 sf0, sf1, sf2, sf3;
    int kbsel;
};
__device__ __forceinline__ int swa_jlo(int P0, int W) { const int lowk = P0 - W + 1; return lowk > 0 ? lowk / KVBLK : 0; }
#define ROW(p, k0, rr) ((p) + (size_t)((k0) + (rr)) * D + sc)
#define VMW() asm volatile("s_waitcnt vmcnt(0)" ::: "memory")
#define VMWN(n) asm volatile("s_waitcnt vmcnt(%0)" :: "i"(n) : "memory")
#define ROWK(p, k0, rr) ((p) + (size_t)((k0) + (rr)) * KP + sc)
#define ROWV(p, k0, rr) ((p) + (size_t)((k0) + (rr)) * VP + sc)
#define SLOAD_H(Kp, Vp, k0) do { S.st_v0 = load8<TIn>(ROWV(Vp, k0, sr)); S.st_v1 = load8<TIn>(ROWV(Vp, k0, 32 + sr));              \
                         S.st_k0 = load8<TIn>(ROWK(Kp, k0, sr)); S.st_k1 = load8<TIn>(ROWK(Kp, k0, 32 + sr)); } while (0)
#define SWRITE_HK(bf) do { *(bf16x8*)(K_lds + (bf) * SHM_K + kws) = S.st_k0; *(bf16x8*)(K_lds + (bf) * SHM_K + kws + 32 * 256) = S.st_k1; } while (0)
#define SWRITE_HV(bf) do { *(bf16x8*)(V_lds + (bf) * SHM_V + vst0) = S.st_v0; *(bf16x8*)(V_lds + (bf) * SHM_V + vst1) = S.st_v1; } while (0)
#define SWRITE_H(bf) do { SWRITE_HV(bf); SWRITE_HK(bf); } while (0)
#define SLOAD_F(p, k0) do { S.sf0 = *(const f32x4*)ROW(p, k0, sr); S.sf1 = *(const f32x4*)(ROW(p, k0, sr) + 4);                \
                            S.sf2 = *(const f32x4*)ROW(p, k0, 32 + sr); S.sf3 = *(const f32x4*)(ROW(p, k0, 32 + sr) + 4); } while (0)
#define SWRITE_KF(bf) do { *(bf16x8*)(K_lds + (bf) * SHM_K + kws) = pack8(S.sf0, S.sf1); *(bf16x8*)(K_lds + (bf) * SHM_K + kws + 32 * 256) = pack8(S.sf2, S.sf3); } while (0)
#define SWRITE_VF(bf) do { *(bf16x8*)(V_lds + (bf) * SHM_V + vst0) = pack8(S.sf0, S.sf1); *(bf16x8*)(V_lds + (bf) * SHM_V + vst1) = pack8(S.sf2, S.sf3); } while (0)
template <class TIn, class TOut, int QP, int KP, int VP>
__device__ __forceinline__ void causal_swa_prime(const BlockRef<TIn, TOut>& cur, int W, char* lds, Seam<TIn>& S) {
    constexpr bool F32 = same_t<TIn, float>::v;
    int tid = threadIdx.x; asm volatile("" : "+v"(tid));
    const int wid = __builtin_amdgcn_readfirstlane(tid >> 6), lane = tid & 63, r32 = lane & 31, hi = lane >> 5;
    const int sr = tid >> 4, sc = (tid & 15) * 8, kws = KSWZ(sr, sc * 2); char* K_lds = lds + 2 * SHM_V;
    const int kb0 = swa_jlo(cur.P0, W) * KVBLK;
    for (int d0 = 0; d0 < 8; ++d0) S.qr[d0] = load8<TIn>(cur.Q + (size_t)(wid * QBLK + r32) * QP + d0 * 16 + hi * 8);
    if constexpr (F32) { SLOAD_F((const float*)cur.K, kb0); VMW(); SWRITE_KF(0); SBAR(); SLOAD_F((const float*)cur.V, kb0); }
    else { SLOAD_H(cur.K, cur.V, kb0); VMW(); SWRITE_HK(0); }
    load_kbias(cur.CB, cur.P0, (float*)(lds + KB_OFF)); S.kbsel = 0;
    __syncthreads();
}
template <class TIn, class TOut, int QP, int KP, int VP>
__device__ __forceinline__ void causal_swa_block(const BlockRef<TIn, TOut>& cur, const BlockRef<TIn, TOut>& nxt, int skv, int W, char* lds, Seam<TIn>& S) {
    constexpr bool F32 = same_t<TIn, float>::v;
    int tid = threadIdx.x; asm volatile("" : "+v"(tid));
    const int wid = __builtin_amdgcn_readfirstlane(tid >> 6), lane = tid & 63, r32 = lane & 31, hi = lane >> 5;
    const int j_lo = swa_jlo(cur.P0, W);
    int j_hi = (cur.P0 + QB - 1) / KVBLK + 1; if (j_hi > skv / KVBLK) j_hi = skv / KVBLK;
    const int NT = j_hi - j_lo;
    const int kbn = swa_jlo(nxt.P0, W) * KVBLK;
    const int qlo = cur.P0 + wid * QBLK, qm = qlo + r32 - 4 * hi;
    char* V_lds = lds; char* K_lds = lds + 2 * SHM_V; const float* kbl = (const float*)(lds + KB_OFF) + S.kbsel * 2048;
    float* ws = (float*)(lds + 2 * SHM_V + 2 * SHM_K) + wid * 64; float* li_l = ws, * al_l = ws + 32;
    float m_reg = -1e30f, l_reg = 0; f32x16 o[4] = {};
    const int sr = tid >> 4, sc = (tid & 15) * 8, vst0 = v_st(sr, sc), vst1 = v_st(32 + sr, sc), kws = KSWZ(sr, sc * 2);
    const int vb0 = (int)(uintptr_t)V_lds + v_rd_base(lane);
    const TIn* Kh = cur.K; const TIn* Vh = cur.V;
#define RESC(a) do { if (__any((a) < 1.f)) { if (hi == 0) al_l[r32] = (a); asm volatile("s_waitcnt lgkmcnt(0)" ::: "memory");              \
                     for (int d_ = 0; d_ < 4; ++d_) for (int r = 0; r < 16; ++r) o[d_][r] *= al_l[crow(r, hi)]; } } while (0)
#define KBASE(t) ((j_lo + (t)) * KVBLK)
#define KBP(t) (kbl + KBASE(t))
#define ACT(t) (KBASE(t) <= qlo + QBLK - 1 && KBASE(t) + KVBLK - 1 >= qlo - W + 1)
#define MASKT(P0_, P1_, t) do { const int kb_ = KBASE(t); if ((!SK || ACT(t)) && (kb_ + KVBLK - 1 > qlo || kb_ <= qlo + QBLK - 1 - W)) mask_tile(P0_, P1_, qm - kb_, (unsigned)W); } while (0)
    constexpr int NQL = F32 ? 16 : 8;
    constexpr bool SK = WSKIP && !F32;
#define SEAM_K0() do { VMWN(NQL); if constexpr (F32) { SWRITE_KF(0); SBAR(); SLOAD_F((const float*)nxt.V, kbn); } else { SWRITE_HK(0); } SBAR(); } while (0)
    f32x16 pA0, pA1, pB0, pB1; float mnA, mnB, alA, alB; bf16x8 pa0, pa1, pa2, pa3;
    if constexpr (F32) { VMW(); SWRITE_VF(0); SBAR(); } else { SWRITE_HV(0); SBAR(); }
    if (NT > 1) { if constexpr (F32) SLOAD_F((const float*)Kh, KBASE(1)); else SLOAD_H(Kh, Vh, KBASE(1)); }
    SBAR(); qkt<0, SK>(pA0, pA1, K_lds, r32, hi, S.qr, ACT(0), KBP(0));
    if constexpr (F32) { if (NT > 1) { VMW(); SWRITE_KF(1); SBAR(); SLOAD_F((const float*)Vh, KBASE(1)); } }
    MASKT(pA0, pA1, 0); partialSM(pA0, pA1, m_reg, mnA, alA);
    if (NT > 1) { VMW(); if constexpr (F32) { SWRITE_VF(1); SBAR(); if (NT > 2) SLOAD_F((const float*)Kh, KBASE(2)); } else SWRITE_H(1); }
    __syncthreads();
#define HALF_STEP(PX0, PX1, mnX, alX, PY0, PY1, alY, t, KB, VB, SB) do {                                                      \
        SBAR(); qkt<KB, SK>(PX0, PX1, K_lds, r32, hi, S.qr, ACT(t), KBP(t));                                             \
        finishSM(PY0, PY1, alY, l_reg, pa0, pa1, pa2, pa3); SBAR();                                                           \
        if ((t) + 1 < NT) { if constexpr (F32) { VMW(); SWRITE_KF(SB); SBAR(); SLOAD_F((const float*)Vh, KBASE((t) + 1)); }  \
                            else { SLOAD_H(Kh, Vh, KBASE((t) + 1)); } SBAR(); }                                               \
        pv_tile<VB, SK>(o, vb0, pa0, pa1, pa2, pa3, ACT((t) - 1)); MASKT(PX0, PX1, (t)); partialSM(PX0, PX1, m_reg, mnX, alX);                                        \
        __syncthreads();                                                                                                      \
        if ((t) + 1 < NT) { VMW(); if constexpr (F32) { SWRITE_VF(SB); SBAR(); if ((t) + 2 < NT) SLOAD_F((const float*)Kh, KBASE((t) + 2)); } \
                            else { SWRITE_H(SB); } }                                                                          \
        RESC(alX); __syncthreads(); } while (0)
    for (int t = 1; t + 1 < NT; t += 2) {
        HALF_STEP(pB0, pB1, mnB, alB, pA0, pA1, alA, t, 1, 0, 0);
        HALF_STEP(pA0, pA1, mnA, alA, pB0, pB1, alB, t + 1, 0, 1, 1);
    }
    const bool even = (NT & 1) == 0;
    if (even) { SBAR(); qkt<1, SK>(pB0, pB1, K_lds, r32, hi, S.qr, ACT(NT - 1), KBP(NT - 1)); SBAR(); }
#define QROW(e) (nxt.Q + (size_t)(wid * QBLK + r32) * D + ((e) >> 1) * 16 + hi * 8 + ((e) & 1) * 4)
    if constexpr (F32) { SLOAD_F((const float*)nxt.K, kbn); SBAR();
#pragma unroll
        for (int e = 0; e < 8; ++e) (void)0; }
    else { SLOAD_H(nxt.K, nxt.V, kbn); SBAR();
#pragma unroll
        for (int d0 = 0; d0 < 8; ++d0) S.qr[d0] = load8<TIn>(nxt.Q + (size_t)(wid * QBLK + r32) * QP + d0 * 16 + hi * 8); }
    SBAR();
    finishSM(pA0, pA1, alA, l_reg, pa0, pa1, pa2, pa3); SBAR();
    if constexpr (F32) {
#pragma unroll
        for (int e = 8; e < 16; ++e) (void)0; SBAR(); }
#undef QROW
    pv_tile<0, SK>(o, vb0, pa0, pa1, pa2, pa3, ACT(even ? NT - 2 : NT - 1));
    if (even) { MASKT(pB0, pB1, NT - 1); partialSM(pB0, pB1, m_reg, mnB, alB); __syncthreads(); RESC(alB);
        finishSM(pB0, pB1, alB, l_reg, pa0, pa1, pa2, pa3); SBAR(); pv_tile<1, SK>(o, vb0, pa0, pa1, pa2, pa3, ACT(NT - 1)); }
    SBAR(); SEAM_K0();
    if (hi == 0) li_l[r32] = l_reg; asm volatile("s_waitcnt lgkmcnt(0)" ::: "memory");
    float rli[16];
#pragma unroll
    for (int r = 0; r < 16; ++r) rli[r] = __builtin_amdgcn_rcpf(li_l[crow(r, hi)]);
    TOut* Ow = cur.O + (size_t)(wid * QBLK) * QP; const TOut* SGw = cur.SG + (size_t)(wid * QBLK) * VP;
#pragma unroll
    for (int r = 0; r < 16; ++r) { const int orow = crow(r, hi);
#pragma unroll
        for (int d0 = 0; d0 < 4; ++d0) { const float v = o[d0][r] * rli[r] * __bfloat162float(SGw[(size_t)orow * VP + d0 * 32 + r32]);
            if constexpr (same_t<TOut, float>::v) { Ow[(size_t)orow * QP + d0 * 32 + r32] = v; }
            else { const float vn = __shfl_xor(v, 1);
                   if ((r32 & 1) == 0) *(unsigned*)(Ow + (size_t)orow * QP + d0 * 32 + r32) = cvtpk(v, vn); } } }
    if constexpr (F32) {
#pragma unroll
        for (int d0 = 0; d0 < 8; ++d0) (void)0; }
    load_kbias(nxt.CB, nxt.P0, (float*)(lds + KB_OFF) + (S.kbsel ^ 1) * 2048);
    __syncthreads();
    S.kbsel ^= 1;
#undef RESC
#undef KBASE
#undef KBP
#undef ACT
#undef MASKT
#undef SEAM_K0
#undef HALF_STEP
}
#undef ROW
#undef VMW
#undef VMWN
#undef SLOAD_H
#undef SWRITE_HK
#undef SWRITE_HV
#undef SWRITE_H
#undef SLOAD_F
#undef SWRITE_KF
#undef SWRITE_VF

}
#ifndef LAS
#define LAS __attribute__((address_space(3)))
#endif
#define RLX_AGENT __ATOMIC_RELAXED, __HIP_MEMORY_SCOPE_AGENT
#define XB_TMO      128
#define XB_XCNT(j)  (256  + 64 * (j))
#define XB_XSUB(j)  (1280 + 64 * (j))
#define XB_XGEN(j)  (2304 + 64 * (j))
#define XB_TOP      3328
#define XB_TOPGEN   3392
#define XCD_BAR_WORDS 3456
#define XB_SPIN_CAP (1u << 18)

__device__ __forceinline__ unsigned xb_ld(unsigned* p)              { return __hip_atomic_load(p, __ATOMIC_RELAXED, __HIP_MEMORY_SCOPE_AGENT); }
__device__ __forceinline__ unsigned xb_add(unsigned* p, unsigned v) { return __hip_atomic_fetch_add(p, v, __ATOMIC_RELAXED, __HIP_MEMORY_SCOPE_AGENT); }
__device__ __forceinline__ unsigned xb_xcc_id() { return (unsigned)__builtin_amdgcn_s_getreg((3 << 11) | 20) & 0xFu; }
#define XB_SPIN(cond, bar) do { unsigned _sp = 0; while (cond) { __builtin_amdgcn_s_sleep(1); \
    if ((++_sp & 255u) == 0u) { if (xb_ld(&(bar)[XB_TMO])) break; if (_sp > XB_SPIN_CAP) { atomicAdd(&(bar)[XB_TMO], 1u); break; } } } } while (0)

struct XcdBarrier {
    unsigned* bar; unsigned x;
    volatile LAS unsigned* st;
};

__device__ __forceinline__ XcdBarrier xcd_barrier_post(unsigned* bar, volatile LAS unsigned* st) {
    XcdBarrier b; b.bar = bar; b.x = xb_xcc_id(); b.st = st;
    if (threadIdx.x == 0) (void)xb_add(&bar[XB_XCNT(b.x)], 1u);
    return b;
}
__device__ __forceinline__ void xcd_barrier_complete(unsigned* bar, unsigned x, unsigned& nloc, unsigned& nx) {
    const unsigned G = gridDim.x * gridDim.y * gridDim.z;
    unsigned sum, cnt, mine, sp = 0u;
    for (;;) {
        sum = 0u; cnt = 0u; mine = 0u;
#pragma unroll
        for (unsigned j = 0; j < 16; ++j) { const unsigned c = xb_ld(&bar[XB_XCNT(j)]); sum += c; cnt += (c > 0u) ? 1u : 0u; mine = (j == x) ? c : mine; }
        if (sum == G) break;
        __builtin_amdgcn_s_sleep(1);
        if ((++sp & 255u) == 0u) { if (xb_ld(&bar[XB_TMO])) break; if (sp > XB_SPIN_CAP) { atomicAdd(&bar[XB_TMO], 1u); break; } }
    }
    nloc = mine > 0u ? mine : 1u; nx = cnt > 0u ? cnt : 1u;
}

__device__ __forceinline__ void xcd_barrier(const XcdBarrier& b) {
    asm volatile("s_waitcnt vmcnt(0)" ::: "memory");
    __syncthreads();
    if (threadIdx.x == 0) {
        unsigned* bar = b.bar;
        __builtin_amdgcn_s_waitcnt(0);
        unsigned nloc = b.st[0], nx = b.st[1];
        if (nloc == 0u) { xcd_barrier_complete(bar, b.x, nloc, nx); b.st[0] = nloc; b.st[1] = nx; }
        const unsigned old = xb_add(&bar[XB_XSUB(b.x)], 1u);
        const unsigned gen = old / nloc;
        if (old + 1u == (gen + 1u) * nloc) {
            __builtin_amdgcn_fence(__ATOMIC_RELEASE, "agent");
            asm volatile("s_waitcnt vmcnt(0)" ::: "memory");
            const unsigned og = xb_add(&bar[XB_TOP], 1u);
            const unsigned tg = og / nx;
            if (og + 1u == (tg + 1u) * nx) xb_add(&bar[XB_TOPGEN], 1u);
            else XB_SPIN(xb_ld(&bar[XB_TOPGEN]) == tg, bar);
            __builtin_amdgcn_fence(__ATOMIC_ACQUIRE, "agent");
            xb_add(&bar[XB_XGEN(b.x)], 1u);
            asm volatile("s_waitcnt vmcnt(0)" ::: "memory");
        } else {
            XB_SPIN(xb_ld(&bar[XB_XGEN(b.x)]) == gen, bar);
            __builtin_amdgcn_fence(__ATOMIC_ACQUIRE, "agent");
            asm volatile("s_waitcnt vmcnt(0)" ::: "memory");
        }
    }
    __syncthreads();
}
#ifndef LAS
#define LAS __attribute__((address_space(3)))
#endif
typedef unsigned short bf16_t;
typedef float f32x4 __attribute__((ext_vector_type(4)));
typedef float f32x2 __attribute__((ext_vector_type(2)));
typedef unsigned u32x4 __attribute__((ext_vector_type(4)));
typedef unsigned u32x2 __attribute__((ext_vector_type(2)));
constexpr int DM = 2048, NB = 4, SEQ = 2048, MT = NB * SEQ;
constexpr int DFF = 5632, NMOD = 12288;
constexpr int NBF = 8192, NF32 = 3584, NPROJ = NBF + NF32;
constexpr int PBP = NBF + 64;
constexpr float ALPHA = 1.189207115002721f, LN_EPS = 1e-5f, RMS_EPS = 1e-6f, LNX_EPS = 64e-5f;
constexpr size_t MiB = 1u << 20;
constexpr size_t WS_MOD = 0, WS_CUM = 1 * MiB, WS_PART = 2 * MiB, WS_BAR = 5 * MiB, WS_SLOT = 6 * MiB;
constexpr size_t WS_WOUT = 8 * MiB, WS_WA = 16 * MiB, WS_WB = 20 * MiB, WS_WLORA = 24 * MiB;
constexpr size_t WS_WIN = 28 * MiB;
constexpr size_t WS_ACAT = 60 * MiB, WS_ACAT2 = 363 * MiB, WS_MERGED = 235 * MiB;
constexpr int KSP = PBP / 2;
constexpr size_t WS_XN = 74 * MiB;
constexpr size_t WS_QN = 74 * MiB, WS_KN = 90 * MiB;
constexpr size_t WS_PBF = 106 * MiB;
constexpr size_t WS_PRW = 235 * MiB, WS_LF = 291 * MiB;
constexpr size_t WS_PF32 = 235 * MiB;
constexpr size_t WS_G = 347 * MiB, WS_YRAW = 299 * MiB, WS_WGU = 28 * MiB;
constexpr size_t WS_KK = 347 * MiB;
constexpr size_t WS_O = 379 * MiB;
constexpr size_t WS_WDOWN = 395 * MiB;
constexpr size_t WS_END = 417 * MiB;
constexpr int LDS_BYTES = 131072 + 64;

struct Params { const float* in[28]; float* out; unsigned char* ws; };

__device__ __forceinline__ unsigned f2bf(float f) { unsigned u = __builtin_bit_cast(unsigned, f); return (u + 0x7fffu + ((u >> 16) & 1u)) >> 16; }
__device__ __forceinline__ unsigned pk2(float lo, float hi) { return pg8::cvt_pk_bf16(lo, hi); }
__device__ __forceinline__ float bflo(unsigned w) { return __builtin_bit_cast(float, w << 16); }
__device__ __forceinline__ float bfhi(unsigned w) { return __builtin_bit_cast(float, w & 0xffff0000u); }
__device__ __forceinline__ f32x4 ld4bf(const bf16_t* p) { const u32x2 w = *(const u32x2*)p; return (f32x4){bflo(w.x), bfhi(w.x), bflo(w.y), bfhi(w.y)}; }
__device__ __forceinline__ float sigm(float x) { return __builtin_amdgcn_rcpf(1.f + __builtin_amdgcn_exp2f(-1.4426950408889634f * x)); }
__device__ __forceinline__ float wave_sum(float v) {
#pragma unroll
    for (int o = 1; o < 64; o <<= 1) v += __shfl_xor(v, o);
    return v;
}
template <int CTRL> __device__ __forceinline__ float dppf(float x) { return __builtin_bit_cast(float, __builtin_amdgcn_mov_dpp(__builtin_bit_cast(int, x), CTRL, 0xf, 0xf, true)); }
__device__ __forceinline__ float rowsum16(float v) { v += dppf<0xB1>(v); v += dppf<0x4E>(v); v += dppf<0x141>(v); v += dppf<0x128>(v); return v; }
#define LDS_WAIT() asm volatile("s_waitcnt lgkmcnt(0)" ::: "memory")

namespace pg8 {
__device__ __forceinline__ f32x4 sig4(f32x4 v) { f32x4 r; r[0] = sigm(v[0]); r[1] = sigm(v[1]); r[2] = sigm(v[2]); r[3] = sigm(v[3]); return r; }
__device__ __forceinline__ u32x4 pack8(f32x4 a, f32x4 b) { u32x4 w; w.x = cvt_pk_bf16(a[0], a[1]); w.y = cvt_pk_bf16(a[2], a[3]); w.z = cvt_pk_bf16(b[0], b[1]); w.w = cvt_pk_bf16(b[2], b[3]); return w; }
struct EpiProjBf { static constexpr bool PERM = true, AFTER_DRAIN = false; bf16_t* O;
    __device__ __forceinline__ void operator()(const f32x4 (&acc)[2][2][4][2], const Unit& u, int wr, int wc, int fr, int fq) const {
        const int row0 = u.pm * BM + wr * 64 + fr, col0 = u.pn * BM + wc * 32 + 8 * fq; const bool sg = u.pn >= 12;
#pragma unroll
        for (int ai = 0; ai < 2; ++ai)
#pragma unroll
            for (int m = 0; m < 4; ++m) { bf16_t* rowp = O + (size_t)(row0 + ai * HALF + m * 16) * PBP + col0;
#pragma unroll
                for (int bj = 0; bj < 2; ++bj) { f32x4 v0 = acc[ai][bj][m][0], v1 = acc[ai][bj][m][1];
                    if (sg) { v0 = sig4(v0); v1 = sig4(v1); }
                    *(u32x4*)(rowp + bj * HALF) = pack8(v0, v1); } }
    }
};
struct EpiF32 { static constexpr bool PERM = false, AFTER_DRAIN = false; float* O; int ldc;
    __device__ __forceinline__ void operator()(const f32x4 (&acc)[2][2][4][2], const Unit& u, int wr, int wc, int fr, int fq) const {
        const int row0 = u.pm * BM + wr * 64 + fr, col0 = u.pn * BM + wc * 32 + 4 * fq;
#pragma unroll
        for (int ai = 0; ai < 2; ++ai)
#pragma unroll
            for (int m = 0; m < 4; ++m) { float* rowp = O + (size_t)(row0 + ai * HALF + m * 16) * ldc + col0;
#pragma unroll
                for (int bj = 0; bj < 2; ++bj)
#pragma unroll
                    for (int n = 0; n < 2; ++n) *(f32x4*)(rowp + bj * HALF + n * 16) = acc[ai][bj][m][n]; }
    }
};
struct EpiRw { static constexpr bool PERM = false, AFTER_DRAIN = false; bf16_t* O; float* LF;
    __device__ __forceinline__ void operator()(const f32x4 (&acc)[2][2][4][2], const Unit& u, int wr, int wc, int fr, int fq) const {
        const int row0 = u.pm * BM + wr * 64 + fr, colt = wc * 32 + 4 * fq, col0 = u.pn * BM + colt; const bool last = u.pn == 13;
#pragma unroll
        for (int ai = 0; ai < 2; ++ai)
#pragma unroll
            for (int m = 0; m < 4; ++m) { const size_t row = (size_t)(row0 + ai * HALF + m * 16);
#pragma unroll
                for (int bj = 0; bj < 2; ++bj)
#pragma unroll
                    for (int n = 0; n < 2; ++n) { const f32x4 v = acc[ai][bj][m][n]; u32x2 w; w.x = cvt_pk_bf16(v[0], v[1]); w.y = cvt_pk_bf16(v[2], v[3]);
                        *(u32x2*)(O + row * NF32 + col0 + bj * HALF + n * 16) = w;
                        if (last) *(f32x4*)(LF + row * 256 + colt + bj * HALF + n * 16) = v; } }
    }
};
struct EpiLora { static constexpr bool PERM = false, AFTER_DRAIN = false;
    const float* w0; const float* a0; float* WD; float* AA; bf16_t* G; int pn0;
    __device__ __forceinline__ void operator()(const f32x4 (&acc)[2][2][4][2], const Unit& u, int wr, int wc, int fr, int fq) const {
        const int pnq = u.pn + pn0, sel = pnq >> 2; int row0 = u.pm * BM + wr * 64 + fr, cb = (pnq & 3) * BM + wc * 32 + 4 * fq;
        asm volatile("" : "+v"(row0), "+v"(cb));
#pragma unroll
        for (int bj = 0; bj < 2; ++bj)
#pragma unroll
            for (int n = 0; n < 2; ++n) { const int c = cb + bj * HALF + n * 16;
                if (sel == 0) { const f32x4 wv = *(const f32x4*)(w0 + c);
#pragma unroll
                    for (int ai = 0; ai < 2; ++ai)
#pragma unroll
                        for (int m = 0; m < 4; ++m) { const size_t off = (size_t)(row0 + ai * HALF + m * 16) * 1024 + c; f32x4 o;
#pragma unroll
                            for (int i = 0; i < 4; ++i) { const float x = wv[i] + acc[ai][bj][m][n][i];
                                const float wraw = fminf(x, 0.f) - __logf(1.f + __expf(-fabsf(x))) - 0.5f; o[i] = __expf(-__expf(wraw)); }
                            *(f32x4*)(WD + off) = o; }
                } else if (sel == 1) { const f32x4 av = *(const f32x4*)(a0 + c);
#pragma unroll
                    for (int ai = 0; ai < 2; ++ai)
#pragma unroll
                        for (int m = 0; m < 4; ++m) { const size_t off = (size_t)(row0 + ai * HALF + m * 16) * 1024 + c; f32x4 oa;
#pragma unroll
                            for (int i = 0; i < 4; ++i) oa[i] = sigm(av[i] + acc[ai][bj][m][n][i]);
                            *(f32x4*)(AA + off) = oa; }
                } else {
#pragma unroll
                    for (int ai = 0; ai < 2; ++ai)
#pragma unroll
                        for (int m = 0; m < 4; ++m) { const size_t off = (size_t)(row0 + ai * HALF + m * 16) * 1024 + c; const f32x4 v = acc[ai][bj][m][n];
                            u32x2 w; w.x = cvt_pk_bf16(v[0], v[1]); w.y = cvt_pk_bf16(v[2], v[3]); *(u32x2*)(G + off) = w; }
                } }
    }
};
template <int PASS> struct EpiMerge { static constexpr bool PERM = true, AFTER_DRAIN = false; const bf16_t* SG; float* TMP; bf16_t* MG;
    __device__ __forceinline__ void operator()(const f32x4 (&acc)[2][2][4][2], const Unit& u, int wr, int wc, int fr, int fq) const {
        const int row0 = u.pm * BM + wr * 64 + fr, col0 = u.pn * BM + wc * 32 + 8 * fq;
#pragma unroll
        for (int ai = 0; ai < 2; ++ai)
#pragma unroll
            for (int m = 0; m < 4; ++m) { const int row = row0 + ai * HALF + m * 16;
#pragma unroll
                for (int bj = 0; bj < 2; ++bj) { const int c = col0 + bj * HALF; const u32x4 s = *(const u32x4*)(SG + (size_t)row * PBP + c);
                    f32x4 v0 = acc[ai][bj][m][0], v1 = acc[ai][bj][m][1];
                    v0 = v0 * (f32x4){bflo(s.x), bfhi(s.x), bflo(s.y), bfhi(s.y)}; v1 = v1 * (f32x4){bflo(s.z), bfhi(s.z), bflo(s.w), bfhi(s.w)};
                    float* tp = TMP + (size_t)row * DM + c;
                    if (PASS == 1) { *(f32x4*)tp = v0; *(f32x4*)(tp + 4) = v1; }
                    else { v0 = v0 + *(const f32x4*)tp; v1 = v1 + *(const f32x4*)(tp + 4); *(u32x4*)(MG + (size_t)row * DM + c) = pack8(v0, v1); } } }
    }
};
struct EpiMergeDual { static constexpr bool PERM = true, AFTER_DRAIN = false; const bf16_t* SGA; const bf16_t* SGB; bf16_t* MG;
    __device__ __forceinline__ void mid(f32x4 (&acc)[2][2][4][2], const Unit& u, int wr, int wc, int fr, int fq) const {
        int row0 = u.pm * BM + wr * 64 + fr, col0 = u.pn * BM + wc * 32 + 8 * fq;
        asm volatile("" : "+v"(row0), "+v"(col0));
#pragma unroll
        for (int ai = 0; ai < 2; ++ai)
#pragma unroll
            for (int m = 0; m < 4; ++m) { const size_t ro = (size_t)(row0 + ai * HALF + m * 16) * PBP;
#pragma unroll
                for (int bj = 0; bj < 2; ++bj) { const int c = col0 + bj * HALF; const u32x4 a = *(const u32x4*)(SGA + ro + c), b = *(const u32x4*)(SGB + ro + c);
#define MRG_R(x, y) ((x) * __builtin_amdgcn_rcpf(fmaxf((y), 1e-20f)))
                    acc[ai][bj][m][0] = acc[ai][bj][m][0] * (f32x4){MRG_R(bflo(a.x), bflo(b.x)), MRG_R(bfhi(a.x), bfhi(b.x)), MRG_R(bflo(a.y), bflo(b.y)), MRG_R(bfhi(a.y), bfhi(b.y))};
                    acc[ai][bj][m][1] = acc[ai][bj][m][1] * (f32x4){MRG_R(bflo(a.z), bflo(b.z)), MRG_R(bfhi(a.z), bfhi(b.z)), MRG_R(bflo(a.w), bflo(b.w)), MRG_R(bfhi(a.w), bfhi(b.w))};
#undef MRG_R
                }
                asm volatile("" ::: "memory"); }
    }
    __device__ __forceinline__ void operator()(const f32x4 (&acc)[2][2][4][2], const Unit& u, int wr, int wc, int fr, int fq) const {
        const int row0 = u.pm * BM + wr * 64 + fr, col0 = u.pn * BM + wc * 32 + 8 * fq;
#pragma unroll
        for (int ai = 0; ai < 2; ++ai)
#pragma unroll
            for (int m = 0; m < 4; ++m) { const int row = row0 + ai * HALF + m * 16;
#pragma unroll
                for (int bj = 0; bj < 2; ++bj) { const int c = col0 + bj * HALF; const u32x4 s = *(const u32x4*)(SGB + (size_t)row * PBP + c);
                    const f32x4 v0 = acc[ai][bj][m][0] * (f32x4){bflo(s.x), bfhi(s.x), bflo(s.y), bfhi(s.y)}, v1 = acc[ai][bj][m][1] * (f32x4){bflo(s.z), bfhi(s.z), bflo(s.w), bfhi(s.w)};
                    *(u32x4*)(MG + (size_t)row * DM + c) = pack8(v0, v1); } }
    }
};
struct EpiRes { static constexpr bool PERM = false, AFTER_DRAIN = false; const float* X; float* OUT; const float* gate;
    __device__ __forceinline__ void operator()(const f32x4 (&acc)[2][2][4][2], const Unit& u, int wr, int wc, int fr, int fq) const {
        const int row0 = u.pm * BM + wr * 64 + fr, col0 = u.pn * BM + wc * 32 + 4 * fq; const float* gp = gate + (size_t)(u.pm >> 3) * NMOD;
#pragma unroll
        for (int bj = 0; bj < 2; ++bj)
#pragma unroll
            for (int n = 0; n < 2; ++n) { const int c = col0 + bj * HALF + n * 16; const f32x4 gv = *(const f32x4*)(gp + c);
#pragma unroll
                for (int ai = 0; ai < 2; ++ai)
#pragma unroll
                    for (int m = 0; m < 4; ++m) { const size_t off = (size_t)(row0 + ai * HALF + m * 16) * DM + c;
                        const f32x4 xv = *(const f32x4*)(X + off); *(f32x4*)(OUT + off) = xv * ALPHA + gv * acc[ai][bj][m][n]; } }
    }
};
struct EpiSwiGLU { static constexpr bool PERM = true, AFTER_DRAIN = false; bf16_t* ACT;
    __device__ __forceinline__ void operator()(const f32x4 (&acc)[2][2][4][2], const Unit& u, int wr, int wc, int fr, int fq) const {
        const int row0 = u.pm * BM + wr * 64 + fr, col0 = u.pn * HALF + wc * 32 + 8 * fq;
#pragma unroll
        for (int ai = 0; ai < 2; ++ai)
#pragma unroll
            for (int m = 0; m < 4; ++m) { const f32x4 g0 = acc[ai][0][m][0], g1 = acc[ai][0][m][1], u0 = acc[ai][1][m][0], u1 = acc[ai][1][m][1];
                const f32x4 a0 = g0 * sig4(g0) * u0, a1 = g1 * sig4(g1) * u1;
                *(u32x4*)(ACT + (size_t)(row0 + ai * HALF + m * 16) * DFF + col0) = pack8(a0, a1); }
    }
};

__device__ __forceinline__ void row_stats_exchange(const f32x4 (&v)[2][2][4][2], const Unit& u, int wr, int wc, int fr, int fq, PG8_LAS unsigned char* lds, int wid, int lane, float* slots, const XcdBarrier& bar) {
    PG8_LAS f32x2* P = (PG8_LAS f32x2*)lds; PG8_LAS f32x2* S = (PG8_LAS f32x2*)(lds + 8192);
#pragma unroll
    for (int ai = 0; ai < 2; ++ai)
#pragma unroll
        for (int m = 0; m < 4; ++m) {
            float s = 0.f;
#pragma unroll
            for (int bj = 0; bj < 2; ++bj)
#pragma unroll
                for (int n = 0; n < 2; ++n) { const f32x4 x = v[ai][bj][m][n]; s += (x[0] + x[1]) + (x[2] + x[3]); }
            s += __shfl_xor(s, 16); s += __shfl_xor(s, 32);
            const float mw = s * (1.0f / 64.0f); float q = 0.f;
#pragma unroll
            for (int bj = 0; bj < 2; ++bj)
#pragma unroll
                for (int n = 0; n < 2; ++n) { const f32x4 d = v[ai][bj][m][n] - mw; q += (d[0] * d[0] + d[1] * d[1]) + (d[2] * d[2] + d[3] * d[3]); }
            q += __shfl_xor(q, 16); q += __shfl_xor(q, 32);
            if (fq == 0) P[(ai * HALF + wr * 64 + m * 16 + fr) * 4 + wc] = (f32x2){mw, q};
        }
    asm volatile("s_waitcnt lgkmcnt(0)" ::: "memory"); __builtin_amdgcn_s_barrier(); asm volatile("" ::: "memory");
    const int row = wid * 32 + (lane & 31);
    if (lane < 32) {
        const f32x2 a = P[row * 4 + 0], b = P[row * 4 + 1], c = P[row * 4 + 2], d = P[row * 4 + 3];
        const float mt = (a[0] + b[0] + c[0] + d[0]) * 0.25f;
        const float da = a[0] - mt, db = b[0] - mt, dc = c[0] - mt, dd = d[0] - mt;
        const float m2 = (a[1] + b[1]) + (c[1] + d[1]) + 64.0f * ((da * da + db * db) + (dc * dc + dd * dd));
        *(f32x2*)(slots + ((size_t)(u.pm * BM + row) * 8 + u.pn) * 2) = (f32x2){mt, m2};
    }
    xcd_barrier(bar);
    if (lane < 32) {
        const float* sp = slots + (size_t)(u.pm * BM + row) * 16; float mt[8], m2[8]; float ms = 0.f;
#pragma unroll
        for (int t = 0; t < 8; ++t) { const f32x2 w = *(const f32x2*)(sp + 2 * t); mt[t] = w[0]; m2[t] = w[1]; ms += w[0]; }
        const float mean = ms * 0.125f; float q = 0.f;
#pragma unroll
        for (int t = 0; t < 8; ++t) { const float dm = mt[t] - mean; q += m2[t] + 256.0f * dm * dm; }
        S[row] = (f32x2){mean, __builtin_amdgcn_rsqf(q * (1.0f / 2048.0f) + LN_EPS)};
    }
    asm volatile("s_waitcnt lgkmcnt(0)" ::: "memory"); __builtin_amdgcn_s_barrier(); asm volatile("" ::: "memory");
}
#define LNF_PIN(ai, m) asm volatile("" : "+v"(acc[ai][0][m][0]), "+v"(acc[ai][0][m][1]), "+v"(acc[ai][1][m][0]), "+v"(acc[ai][1][m][1]))
#define LNF_RESID(Xp, gvv) do { _Pragma("unroll") for (int ai = 0; ai < 2; ++ai) _Pragma("unroll") for (int m = 0; m < 4; ++m) { const float* rp_ = (Xp) + (size_t)(row0 + ai * HALF + m * 16) * DM + col0; \
        _Pragma("unroll") for (int bj = 0; bj < 2; ++bj) _Pragma("unroll") for (int n = 0; n < 2; ++n) acc[ai][bj][m][n] = *(const f32x4*)(rp_ + bj * HALF + n * 16) * ALPHA + gvv[bj][n] * acc[ai][bj][m][n]; \
        LNF_PIN(ai, m); if (m & 1) asm volatile("" ::: "memory"); } } while (0)
struct EpiResLn { static constexpr bool PERM = false, AFTER_DRAIN = true; const float* X; float* OUT; const float* gate; const float* lg; const float* lb; float* slots; const XcdBarrier* bar;
    __device__ __forceinline__ void operator()(const f32x4 (&)[2][2][4][2], const Unit&, int, int, int, int) const {}
    __device__ __forceinline__ void fused(f32x4 (&acc)[2][2][4][2], const Unit& u, int wr, int wc, int fr, int fq, PG8_LAS unsigned char* lds, int wid, int lane) const {
        const PG8_LAS f32x2* S = (const PG8_LAS f32x2*)(lds + 8192);
        const int row0 = u.pm * BM + wr * 64 + fr, col0 = u.pn * BM + wc * 32 + 4 * fq; const float* gp = gate + (size_t)(u.pm >> 3) * NMOD + col0;
        { f32x4 gv[2][2];
#pragma unroll
          for (int bj = 0; bj < 2; ++bj)
#pragma unroll
              for (int n = 0; n < 2; ++n) gv[bj][n] = *(const f32x4*)(gp + bj * HALF + n * 16);
          LNF_RESID(X, gv); }
        row_stats_exchange(acc, u, wr, wc, fr, fq, lds, wid, lane, slots, *bar);
        f32x4 g4[2][2], b4[2][2];
#pragma unroll
        for (int bj = 0; bj < 2; ++bj)
#pragma unroll
            for (int n = 0; n < 2; ++n) { g4[bj][n] = *(const f32x4*)(lg + col0 + bj * HALF + n * 16); b4[bj][n] = *(const f32x4*)(lb + col0 + bj * HALF + n * 16); }
#pragma unroll
        for (int ai = 0; ai < 2; ++ai)
#pragma unroll
            for (int m = 0; m < 4; ++m) { const int r = ai * HALF + wr * 64 + m * 16 + fr; const f32x2 sr = S[r]; float* op = OUT + (size_t)(u.pm * BM + r) * DM + col0;
#pragma unroll
                for (int bj = 0; bj < 2; ++bj)
#pragma unroll
                    for (int n = 0; n < 2; ++n) *(f32x4*)(op + bj * HALF + n * 16) = (acc[ai][bj][m][n] - sr[0]) * sr[1] * g4[bj][n] + b4[bj][n];
                if (m & 1) asm volatile("" ::: "memory"); }
    }
};
struct EpiResLnLn { static constexpr bool PERM = false, AFTER_DRAIN = true; const float* X; float* X1; bf16_t* H2; const float* mod; const float* lg; const float* lb; float* slots1; float* slots2; const XcdBarrier* bar;
    __device__ __forceinline__ void operator()(const f32x4 (&)[2][2][4][2], const Unit&, int, int, int, int) const {}
    __device__ __forceinline__ void fused(f32x4 (&acc)[2][2][4][2], const Unit& u, int wr, int wc, int fr, int fq, PG8_LAS unsigned char* lds, int wid, int lane) const {
        const PG8_LAS f32x2* S = (const PG8_LAS f32x2*)(lds + 8192);
        const int row0 = u.pm * BM + wr * 64 + fr, col0 = u.pn * BM + wc * 32 + 4 * fq; const float* mb = mod + (size_t)(u.pm >> 3) * NMOD + col0;
        { f32x4 gv[2][2];
#pragma unroll
          for (int bj = 0; bj < 2; ++bj)
#pragma unroll
              for (int n = 0; n < 2; ++n) gv[bj][n] = *(const f32x4*)(mb + 2 * DM + bj * HALF + n * 16);
          LNF_RESID(X, gv); }
        row_stats_exchange(acc, u, wr, wc, fr, fq, lds, wid, lane, slots1, *bar);
        { f32x4 g4[2][2], b4[2][2];
#pragma unroll
          for (int bj = 0; bj < 2; ++bj)
#pragma unroll
              for (int n = 0; n < 2; ++n) { g4[bj][n] = *(const f32x4*)(lg + col0 + bj * HALF + n * 16); b4[bj][n] = *(const f32x4*)(lb + col0 + bj * HALF + n * 16); }
#pragma unroll
          for (int ai = 0; ai < 2; ++ai)
#pragma unroll
              for (int m = 0; m < 4; ++m) { const int r = ai * HALF + wr * 64 + m * 16 + fr; const f32x2 sr = S[r]; float* op = X1 + (size_t)(u.pm * BM + r) * DM + col0;
#pragma unroll
                  for (int bj = 0; bj < 2; ++bj)
#pragma unroll
                      for (int n = 0; n < 2; ++n) { const f32x4 x1 = (acc[ai][bj][m][n] - sr[0]) * sr[1] * g4[bj][n] + b4[bj][n]; acc[ai][bj][m][n] = x1; *(f32x4*)(op + bj * HALF + n * 16) = x1; }
                  LNF_PIN(ai, m); if (m & 1) asm volatile("" ::: "memory"); } }
        row_stats_exchange(acc, u, wr, wc, fr, fq, lds, wid, lane, slots2, *bar);
        f32x4 sh[2][2], sc[2][2];
#pragma unroll
        for (int bj = 0; bj < 2; ++bj)
#pragma unroll
            for (int n = 0; n < 2; ++n) { sh[bj][n] = *(const f32x4*)(mb + 3 * DM + bj * HALF + n * 16); sc[bj][n] = *(const f32x4*)(mb + 4 * DM + bj * HALF + n * 16) + 1.f; }
#pragma unroll
        for (int ai = 0; ai < 2; ++ai)
#pragma unroll
            for (int m = 0; m < 4; ++m) { const int r = ai * HALF + wr * 64 + m * 16 + fr; const f32x2 sr = S[r]; bf16_t* op = H2 + (size_t)(u.pm * BM + r) * DM + col0;
#pragma unroll
                for (int bj = 0; bj < 2; ++bj)
#pragma unroll
                    for (int n = 0; n < 2; ++n) { const f32x4 o = (acc[ai][bj][m][n] - sr[0]) * sr[1] * sc[bj][n] + sh[bj][n]; u32x2 w; w.x = cvt_pk_bf16(o[0], o[1]); w.y = cvt_pk_bf16(o[2], o[3]);
                        *(u32x2*)(op + bj * HALF + n * 16) = w; }
                if (m & 1) asm volatile("" ::: "memory"); }
    }
};
}
__device__ __forceinline__ int q_pop(unsigned* ctr, int lane) { unsigned v = 0u; if (lane == 0) v = __hip_atomic_fetch_add(ctr, 1u, __ATOMIC_RELAXED, __HIP_MEMORY_SCOPE_AGENT); return (int)__builtin_amdgcn_readfirstlane(v); }
struct MapId { __device__ __forceinline__ int operator()(int n) const { return n; } };
struct MapWin { __device__ __forceinline__ int operator()(int n) const {
    return n < 4096 ? n : n < 8192 ? 7624 + (n - 4096) : n < 11712 ? 4104 + (n - 8192) : n < 11720 ? 4096 + (n - 11712) : -1; } };
struct MapGu { __device__ __forceinline__ int operator()(int n) const { const int pn = n >> 8, j = n & 255; return j < 128 ? 128 * pn + j : DFF + 128 * pn + (j - 128); } };
template <class Map>
__device__ __forceinline__ void transpose_item(const float* W, int ldw, bf16_t* WT, int Kd, int kb, int nb, LAS float* scr, int lane, Map map) {
    const int k0 = 64 * kb, n0 = 32 * nb; const int src = map(n0 + (lane & 31));
    const float* wp = W + (size_t)(k0 + (lane >> 5)) * ldw + (src >= 0 ? src : 0);
    float tv[32];
#pragma unroll
    for (int i = 0; i < 32; ++i) tv[i] = src >= 0 ? __builtin_nontemporal_load(wp + (size_t)(2 * i) * ldw) : 0.f;
#pragma unroll
    for (int i = 0; i < 32; ++i) scr[(2 * i + (lane >> 5)) * 33 + (lane & 31)] = tv[i];
    LDS_WAIT();
    const int c = lane & 7;
#pragma unroll
    for (int j = 0; j < 4; ++j) { const int n = (lane >> 3) + 8 * j; const LAS float* s = scr + (8 * c) * 33 + n;
        u32x4 o; o.x = pk2(s[0 * 33], s[1 * 33]); o.y = pk2(s[2 * 33], s[3 * 33]); o.z = pk2(s[4 * 33], s[5 * 33]); o.w = pk2(s[6 * 33], s[7 * 33]);
        *(u32x4*)(WT + (size_t)(n0 + n) * Kd + k0 + 8 * c) = o; }
    LDS_WAIT();
}
template <class Map>
__device__ __forceinline__ void transpose_item2(const float* W, int ldw, bf16_t* WT, int Kd, int kb, int nb, LAS float* scrf, int lane, Map map) {
    LAS unsigned* scr = (LAS unsigned*)scrf;
    const int k0 = 64 * kb, n0 = 64 * nb, half = lane >> 5, c2 = lane & 31; const int src = map(n0 + 2 * c2);
    const float* wp = W + (size_t)(k0 + 32 * half) * ldw + (src >= 0 ? src : 0);
    f32x2 tv[32];
#pragma unroll
    for (int i = 0; i < 32; ++i) tv[i] = src >= 0 ? __builtin_nontemporal_load((const f32x2*)(wp + (size_t)i * ldw)) : (f32x2){0.f, 0.f};
    LAS unsigned* w0 = scr + (2 * c2) * 33 + 16 * half;
#pragma unroll
    for (int j = 0; j < 16; ++j) { w0[j] = pk2(tv[2 * j][0], tv[2 * j + 1][0]); w0[33 + j] = pk2(tv[2 * j][1], tv[2 * j + 1][1]); }
    LDS_WAIT();
    const int c = lane & 7;
#pragma unroll
    for (int j = 0; j < 8; ++j) { const int n = (lane >> 3) + 8 * j; const LAS unsigned* sp = scr + n * 33 + 4 * c;
        u32x4 o; o.x = sp[0]; o.y = sp[1]; o.z = sp[2]; o.w = sp[3];
        *(u32x4*)(WT + (size_t)(n0 + n) * Kd + k0 + 8 * c) = o; }
    LDS_WAIT();
}
__device__ __forceinline__ void ln_stats(const f32x4 (&v)[8], float& mean, float& rstd) {
    float s = 0.f;
#pragma unroll
    for (int j = 0; j < 8; ++j) s += (v[j][0] + v[j][1]) + (v[j][2] + v[j][3]);
    mean = wave_sum(s) * (1.f / DM); float q = 0.f;
#pragma unroll
    for (int j = 0; j < 8; ++j) { const f32x4 d = v[j] - mean; q += (d[0] * d[0] + d[1] * d[1]) + (d[2] * d[2] + d[3] * d[3]); }
    rstd = __builtin_amdgcn_rsqf(wave_sum(q) * (1.f / DM) + LN_EPS);
}

__device__ __forceinline__ void prep_row(const Params& p, int t, int lane) {
    unsigned char* ws = p.ws;
    const bf16_t* PBF = (const bf16_t*)(ws + WS_PBF) + (size_t)t * PBP;
    bf16_t* QN = (bf16_t*)(ws + WS_QN) + (size_t)t * 1024; bf16_t* KN = (bf16_t*)(ws + WS_KN) + (size_t)t * 1024;
    u32x4 qk4[4];
#pragma unroll
    for (int ps = 0; ps < 4; ++ps) qk4[ps] = *(const u32x4*)(PBF + (ps >> 1) * 1024 + (ps & 1) * 512 + lane * 8);
#pragma unroll
    for (int ps = 0; ps < 4; ++ps) {
        const int isk = ps >> 1, c = (ps & 1) * 512 + lane * 8;
        const u32x4 w = qk4[ps];
        float x[8] = {bflo(w.x), bfhi(w.x), bflo(w.y), bfhi(w.y), bflo(w.z), bfhi(w.z), bflo(w.w), bfhi(w.w)};
        float ss = 0.f;
#pragma unroll
        for (int i = 0; i < 8; ++i) ss += x[i] * x[i];
        ss = rowsum16(ss);
        const float rs = __builtin_amdgcn_rsqf(ss * (1.f / 128.f) + RMS_EPS);
        const float* gp = (isk ? p.in[7] : p.in[6]) + (c & 127);
        const f32x4 g0 = *(const f32x4*)gp, g1 = *(const f32x4*)(gp + 4);
        u32x4 o; o.x = pk2(x[0] * rs * g0[0], x[1] * rs * g0[1]); o.y = pk2(x[2] * rs * g0[2], x[3] * rs * g0[3]);
        o.z = pk2(x[4] * rs * g1[0], x[5] * rs * g1[1]); o.w = pk2(x[6] * rs * g1[2], x[7] * rs * g1[3]);
        *(u32x4*)((isk ? KN : QN) + c) = o;
    }
    const bf16_t* cur = (const bf16_t*)(ws + WS_PRW) + (size_t)t * NF32; const bf16_t* prv = cur - NF32;
    const bool first = (t & (SEQ - 1)) == 0; const float* mu = p.in[8];
#define SHIFTED(col) ({ const f32x4 c_ = ld4bf(cur + (col)); const f32x4 p_ = first ? (f32x4){0.f, 0.f, 0.f, 0.f} : ld4bf(prv + (col)); const f32x4 m_ = *(const f32x4*)(mu + (col)); c_ + (p_ - c_) * m_; })
    bf16_t* AC = (bf16_t*)(ws + WS_ACAT) + (size_t)t * 256; bf16_t* AC2 = (bf16_t*)(ws + WS_ACAT2) + (size_t)t * 256;
    if (lane < 32) {
        f32x4 a = {0.f, 0.f, 0.f, 0.f}, b = {0.f, 0.f, 0.f, 0.f};
        if (lane < 24) { const f32x4 xw = SHIFTED(3072 + lane * 4); b = SHIFTED(3168 + lane * 4);
#pragma unroll
            for (int i = 0; i < 4; ++i) { const float e = __expf(-2.f * fabsf(xw[i])); const float th = (1.f - e) / (1.f + e); a[i] = xw[i] < 0.f ? -th : th; } }
        u32x2 wa, wb; wa.x = pk2(a[0], a[1]); wa.y = pk2(a[2], a[3]); wb.x = pk2(b[0], b[1]); wb.y = pk2(b[2], b[3]);
        *(u32x2*)(AC + lane * 4) = wa; *(u32x2*)(AC + 128 + lane * 4) = wb; }
    { const f32x4 xg = SHIFTED(3264 + lane * 4); u32x2 w; w.x = pk2(sigm(xg[0]), sigm(xg[1])); w.y = pk2(sigm(xg[2]), sigm(xg[3])); *(u32x2*)(AC2 + lane * 4) = w; }
#undef SHIFTED
}

__device__ __forceinline__ void rwkv_job(LAS unsigned char* lds, int job, const float* mu, const float* k_k, const float* k_a, const bf16_t* PRW, const float* WD, const float* AA, float* Y, int tid, int wave, int lane) {
    const int bh = job >> 1, half = job & 1, b = bh >> 4, h = bh & 15;
    const size_t tok0 = (size_t)b * SEQ;
    constexpr int TC = 32, CHF = TC * 384, NCH = SEQ / TC;
    LAS float* buf = (LAS float*)lds;
    const int lt = tid & 255, lrow = lt >> 4, piece = lt & 15, hc = h * 64 + piece * 4;
    const size_t goff = (tok0 + lrow) * 1024 + hc;
    const bf16_t* prw0 = PRW + tok0 * NF32 + hc;
    u32x2 rb[12]; f32x4 rg[4];
    const f32x4 kkc = *(const f32x4*)(k_k + hc), kac = *(const f32x4*)(k_a + hc), mur = *(const f32x4*)(mu + hc), muk = *(const f32x4*)(mu + 1024 + hc), muv = *(const f32x4*)(mu + 2048 + hc);
#define RW_LOAD(rg, c) do { const size_t o_ = goff + (size_t)(c) * TC * 1024; _Pragma("unroll") for (int p_ = 0; p_ < 2; ++p_) { const int t_ = (c) * TC + lrow + 16 * p_, tp_ = t_ > 0 ? t_ - 1 : 0; \
        _Pragma("unroll") for (int s_ = 0; s_ < 3; ++s_) { rb[6 * p_ + 2 * s_] = *(const u32x2*)(prw0 + (size_t)t_ * NF32 + s_ * 1024); rb[6 * p_ + 2 * s_ + 1] = *(const u32x2*)(prw0 + (size_t)tp_ * NF32 + s_ * 1024); } \
        rg[p_] = *(const f32x4*)(WD + o_ + (size_t)p_ * 16 * 1024); rg[2 + p_] = *(const f32x4*)(AA + o_ + (size_t)p_ * 16 * 1024); } } while (0)
#define RW_BF4(w) ((f32x4){bflo((w).x), bfhi((w).x), bflo((w).y), bfhi((w).y)})
#define RW_WRITE(rg, c) do { _Pragma("unroll") for (int p_ = 0; p_ < 2; ++p_) { LAS float* d_ = buf + ((c) & 1) * CHF + (lrow + 16 * p_) * 384 + piece * 4; \
        const float fz_ = ((c) * TC + lrow + 16 * p_) > 0 ? 1.f : 0.f;     \
        const f32x4 rc_ = RW_BF4(rb[6 * p_]), rp_ = RW_BF4(rb[6 * p_ + 1]) * fz_, kc_ = RW_BF4(rb[6 * p_ + 2]), kp_ = RW_BF4(rb[6 * p_ + 3]) * fz_, vc_ = RW_BF4(rb[6 * p_ + 4]), vp_ = RW_BF4(rb[6 * p_ + 5]) * fz_; \
        const f32x4 ks_ = kc_ + (kp_ - kc_) * muk, a_ = rg[2 + p_]; const f32x4 kv_ = ks_ * kkc; \
        const float nn_ = rowsum16((kv_[0] * kv_[0] + kv_[1] * kv_[1]) + (kv_[2] * kv_[2] + kv_[3] * kv_[3])); const f32x4 kk_ = kv_ * __builtin_amdgcn_rsqf(fmaxf(nn_, 1e-24f));     \
        *(LAS f32x4*)(d_) = kk_; *(LAS f32x4*)(d_ + 64) = rg[p_]; *(LAS f32x4*)(d_ + 128) = kk_ * a_; *(LAS f32x4*)(d_ + 192) = ks_ * ((a_ - 1.f) * kac + 1.f); \
        *(LAS f32x4*)(d_ + 256) = rc_ + (rp_ - rc_) * mur; *(LAS f32x4*)(d_ + 320) = vc_ + (vp_ - vc_) * muv; } } while (0)
    if (wave >= 4) { RW_LOAD(rg, 0); RW_WRITE(rg, 0); RW_LOAD(rg, 1); }
    __syncthreads();
    const int rw = lane >> 3, j = lane & 7, rl = wave * 8 + rw;
    f32x2 S[4] = {{0.f, 0.f}, {0.f, 0.f}, {0.f, 0.f}, {0.f, 0.f}};
#define RW_STEP(dst, dv, st_) do { const LAS float* sp_ = cb + (st_) * 384; \
        _Pragma("unroll") for (int s_ = 0; s_ < 5; ++s_) { dst[2 * s_] = *(const LAS f32x4*)(sp_ + s_ * 64); dst[2 * s_ + 1] = *(const LAS f32x4*)(sp_ + s_ * 64 + 4); } \
        dv = vb[(st_) * 384]; } while (0)
    for (int c = 0; c < NCH; ++c) {
        if (wave >= 4) { if (c + 1 < NCH) { RW_WRITE(rg, c + 1); if (c + 2 < NCH) RW_LOAD(rg, c + 2); } }
        else {
            const LAS float* cb = buf + (c & 1) * CHF + 8 * j;
            const LAS float* vb = buf + (c & 1) * CHF + 320 + half * 32 + rl;
            float* yp = Y + (tok0 + (size_t)c * TC) * 1024 + h * 64 + half * 32 + rl;
            f32x4 q[10]; float vv;
            RW_STEP(q, vv, 0);
#pragma unroll 8
            for (int st = 0; st < TC; ++st) {
                f32x4 n[10]; float nv; const int ns = st + 1 < TC ? st + 1 : st;
                RW_STEP(n, nv, ns);
                f32x2 ta = S[0] * q[0].lo, tb = S[1] * q[0].hi; ta = S[2] * q[1].lo + ta; tb = S[3] * q[1].hi + tb; ta = ta + tb;
                float d = ta[0] + ta[1];
                d += dppf<0xB1>(d); d += dppf<0x4E>(d); d += dppf<0x141>(d);
                S[0] = S[0] * q[2].lo - q[4].lo * d + q[6].lo * vv;
                S[1] = S[1] * q[2].hi - q[4].hi * d + q[6].hi * vv;
                S[2] = S[2] * q[3].lo - q[5].lo * d + q[7].lo * vv;
                S[3] = S[3] * q[3].hi - q[5].hi * d + q[7].hi * vv;
                f32x2 ua = S[0] * q[8].lo, ub = S[1] * q[8].hi; ua = S[2] * q[9].lo + ua; ub = S[3] * q[9].hi + ub; ua = ua + ub;
                float y = ua[0] + ua[1];
                y += dppf<0xB1>(y); y += dppf<0x4E>(y); y += dppf<0x141>(y);
                yp[(size_t)st * 1024] = y;
#pragma unroll
                for (int i = 0; i < 10; ++i) q[i] = n[i];
                vv = nv;
            }
        }
        __syncthreads();
    }
#undef RW_STEP
#undef RW_LOAD
#undef RW_BF4
#undef RW_WRITE
}

__device__ __forceinline__ void post_row(const Params& p, int t, int lane) {
    unsigned char* ws = p.ws;
    const float* Y = (const float*)(ws + WS_YRAW) + (size_t)t * 1024; const bf16_t* G = (const bf16_t*)(ws + WS_G) + (size_t)t * 1024;
    const float* AA = p.out + (size_t)MT * 1024 + (size_t)t * 1024;
    const bf16_t* cur = (const bf16_t*)(ws + WS_PRW) + (size_t)t * NF32; const bool first = (t & (SEQ - 1)) == 0; const bf16_t* prv = first ? cur : cur - NF32; const float fz = first ? 0.f : 1.f; const float* mu = p.in[8];
    bf16_t* YB = (bf16_t*)(ws + WS_KN) + (size_t)t * 1024;
#pragma unroll
    for (int pp = 0; pp < 2; ++pp) {
        f32x4 y_[2], r_[2], k_[2], v_[2], rk_[2], lg_[2], lb_[2], a_[2], ka_[2]; u32x2 g_[2];
#pragma unroll
        for (int q = 0; q < 2; ++q) { const int c = (2 * pp + q) * 256 + lane * 4;
            y_[q] = *(const f32x4*)(Y + c); a_[q] = *(const f32x4*)(AA + c); ka_[q] = *(const f32x4*)(p.in[15] + c);
            { const f32x4 rc = ld4bf(cur + c), rp = ld4bf(prv + c) * fz, kc = ld4bf(cur + 1024 + c), kp = ld4bf(prv + 1024 + c) * fz, vc = ld4bf(cur + 2048 + c), vp = ld4bf(prv + 2048 + c) * fz;
              r_[q] = rc + (rp - rc) * *(const f32x4*)(mu + c); k_[q] = kc + (kp - kc) * *(const f32x4*)(mu + 1024 + c); v_[q] = vc + (vp - vc) * *(const f32x4*)(mu + 2048 + c); }
            rk_[q] = *(const f32x4*)(p.in[16] + c); lg_[q] = *(const f32x4*)(p.in[17] + c); lb_[q] = *(const f32x4*)(p.in[18] + c); g_[q] = *(const u32x2*)(G + c); }
#pragma unroll
        for (int q = 0; q < 2; ++q) { const int c = (2 * pp + q) * 256 + lane * 4;
            const f32x4 y = y_[q];
            const float mean = rowsum16((y[0] + y[1]) + (y[2] + y[3])) * (1.f / 64.f);
            const f32x4 d = y - mean;
            const float var = rowsum16((d[0] * d[0] + d[1] * d[1]) + (d[2] * d[2] + d[3] * d[3])) * (1.f / 64.f);
            const float rs = __builtin_amdgcn_rsqf(var + LNX_EPS);
            const f32x4 yn = d * rs * lg_[q] + lb_[q];
            const f32x4 pr = r_[q] * (k_[q] * ((a_[q] - 1.f) * ka_[q] + 1.f)) * rk_[q];
            const float bs = rowsum16((pr[0] + pr[1]) + (pr[2] + pr[3]));
            const u32x2 gw = g_[q];
            const f32x4 o = (yn + v_[q] * bs) * (f32x4){bflo(gw.x), bfhi(gw.x), bflo(gw.y), bfhi(gw.y)};
            u32x2 w; w.x = pk2(o[0], o[1]); w.y = pk2(o[2], o[3]); *(u32x2*)(YB + c) = w; }
    }
}

__device__ __forceinline__ void og_row(const Params& p, int t, int lane) {
    unsigned char* ws = p.ws;
    bf16_t* O = (bf16_t*)(ws + WS_O) + (size_t)t * 1024; const bf16_t* SG = (const bf16_t*)(ws + WS_PBF) + (size_t)t * PBP + 3072;
    u32x4 o8[2], s8[2];
#pragma unroll
    for (int ps = 0; ps < 2; ++ps) { o8[ps] = *(const u32x4*)(O + ps * 512 + lane * 8); s8[ps] = *(const u32x4*)(SG + ps * 512 + lane * 8); }
#pragma unroll
    for (int ps = 0; ps < 2; ++ps) { const int c = ps * 512 + lane * 8;
        const u32x4 o = o8[ps], s = s8[ps]; u32x4 w;
        w.x = pk2(bflo(o.x) * bflo(s.x), bfhi(o.x) * bfhi(s.x)); w.y = pk2(bflo(o.y) * bflo(s.y), bfhi(o.y) * bfhi(s.y));
        w.z = pk2(bflo(o.z) * bflo(s.z), bfhi(o.z) * bfhi(s.z)); w.w = pk2(bflo(o.w) * bflo(s.w), bfhi(o.w) * bfhi(s.w));
        *(u32x4*)(O + c) = w; }
}

__device__ __forceinline__ void cumsum_job(const Params& p, int job, LAS unsigned char* lds, int tid, int wave, int lane) {
    unsigned char* ws = p.ws; float* CUM = (float*)(ws + WS_CUM); LAS float* wsum = (LAS float*)lds;
    const int b = job >> 3, h = job & 7; const float bias = p.in[5][h]; const int t0 = tid * 4; float l[4];
#pragma unroll
    for (int i = 0; i < 4; ++i) { const float x = ((const float*)(ws + WS_LF))[(size_t)(b * SEQ + t0 + i) * 256 + 192 + h] + bias; l[i] = fminf(x, 0.f) - log1pf(expf(-fabsf(x))); }
    l[1] += l[0]; l[2] += l[1]; l[3] += l[2];
    const float tot = l[3]; float sc = tot;
#pragma unroll
    for (int o = 1; o < 64; o <<= 1) { const float n = __shfl_up(sc, o); if (lane >= o) sc += n; }
    __syncthreads();
    if (lane == 63) wsum[wave] = sc;
    __syncthreads();
    float woff = 0.f;
    for (int w = 0; w < wave; ++w) woff += wsum[w];
    const float base = woff + sc - tot;
    *(f32x4*)(CUM + (size_t)job * SEQ + t0) = (f32x4){base + l[0], base + l[1], base + l[2], base + l[3]};
}

typedef __hip_bfloat16 fabt;
__device__ __forceinline__ fa::BlockRef<fabt, fabt> fa_ref(int L, int pass, const fabt* Qn, const fabt* Kn, const fabt* Vb, fabt* O, const float* CUM) {
    const int bh = (L & 127) >> 2, x = L & 3, qb = pass ? 7 - x : x, b = bh >> 3, h = bh & 7; const size_t row0 = (size_t)b * SEQ;
    fa::BlockRef<fabt, fabt> r;
    r.Q = Qn + (row0 + (size_t)qb * 256) * 1024 + h * 128; r.O = O + (row0 + (size_t)qb * 256) * 1024 + h * 128;
    r.K = Kn + row0 * 1024 + h * 128; r.V = Vb + row0 * PBP + h * 128; r.SG = Vb + (row0 + (size_t)qb * 256) * PBP + 1024 + h * 128; r.CB = CUM + bh * SEQ; r.P0 = qb * 256;
    return r;
}
#ifndef REP_P0
#define REP_P0 1
#endif
#ifndef REP_P3
#define REP_P3 1
#endif
#ifndef REP_REC
#define REP_REC 1
#endif
#ifndef REP_P10
#define REP_P10 1
#endif
#ifndef REP_P2
#define REP_P2 1
#endif
#ifndef REP_ATT
#define REP_ATT 1
#endif
#ifndef REP_P7B
#define REP_P7B 1
#endif
#ifndef REP_P8
#define REP_P8 1
#endif
#ifndef PROBE_MASK
#define PROBE_MASK 0
#endif
#ifndef PROBE_MULT
#define PROBE_MULT 8
#endif
#ifndef GU_SPLIT
#define GU_SPLIT 11264
#endif
#ifndef REP_SYNC
#define REP_SYNC 0
#endif
__global__ void __launch_bounds__(512) mk_fwd(Params p) {
    extern __shared__ __attribute__((aligned(16))) unsigned char lds_raw[];
    cg::grid_group grid = cg::this_grid();
    LAS unsigned char* lds = (LAS unsigned char*)lds_raw;
    if (threadIdx.x < 2) ((LAS unsigned*)(lds + 131072))[threadIdx.x] = 0u;
    __syncthreads();
#if PROBE_MASK
    unsigned long long* tsb = (unsigned long long*)(p.ws + WS_BAR + 49152); int nts = 0;
#define STAMP() do { if (blockIdx.x == 0 && threadIdx.x == 0) tsb[nts] = __builtin_amdgcn_s_memrealtime(); ++nts; } while (0)
#else
#define STAMP() do {} while (0)
#endif
    STAMP();
    const XcdBarrier bar = xcd_barrier_post((unsigned*)(p.ws + WS_BAR), (volatile LAS unsigned*)(lds + 131072));
    const int G = gridDim.x, blk = blockIdx.x, NGW = G * 8;
#define PHASE_IDS() int tid = threadIdx.x; asm volatile("" : "+v"(tid)); const int lane = tid & 63, wave = __builtin_amdgcn_readfirstlane(tid >> 6), gw = blk * 8 + wave; (void)gw; (void)lane; LAS float* scr = (LAS float*)(lds + wave * 8704); (void)scr
    unsigned char* ws = p.ws;
    float* MOD = (float*)(ws + WS_MOD); float* CUM = (float*)(ws + WS_CUM); float* PART = (float*)(ws + WS_PART);
    bf16_t* XN = (bf16_t*)(ws + WS_XN); bf16_t* PBF = (bf16_t*)(ws + WS_PBF); float* PF32 = (float*)(ws + WS_PF32);

    for (int rep_ = 0; rep_ < REP_P0; ++rep_) {
        PHASE_IDS();
        __syncthreads();
        LAS float* sl = (LAS float*)(lds + 73728);
        for (int i = tid; i < NB * DM; i += 512) { const float v = p.in[1][i]; sl[i] = v * sigm(v); }
        __syncthreads();
        constexpr int I_MOD = 16 * 48, I_IN = 32 * (NPROJ / 64), I_OUT = 32 * 32, I_A = 16 * 32;
        const int vgw = wave * G + blk, ntr = I_IN;
        for (int r = vgw; r < I_MOD; r += 8 * G) {
            const int ks = r / 48, cc = r % 48;
            const float* wp = p.in[2] + (size_t)(ks * 128) * NMOD + cc * 256 + lane * 4;
            f32x4 a0 = {0.f, 0.f, 0.f, 0.f}, a1 = a0, a2 = a0, a3 = a0;
#pragma unroll 16
            for (int rr = 0; rr < 128; ++rr) { const f32x4 w = __builtin_nontemporal_load((const f32x4*)(wp + (size_t)rr * NMOD)); const int d = ks * 128 + rr;
                a0 += w * sl[d]; a1 += w * sl[DM + d]; a2 += w * sl[2 * DM + d]; a3 += w * sl[3 * DM + d]; }
            float* pp = PART + (size_t)(ks * 4) * NMOD + cc * 256 + lane * 4;
            *(f32x4*)pp = a0; *(f32x4*)(pp + NMOD) = a1; *(f32x4*)(pp + 2 * NMOD) = a2; *(f32x4*)(pp + 3 * NMOD) = a3;
        }
        const bool bal = (G == 256);
        const int t_lo = bal ? (vgw < 768 ? 0 : 5 * (vgw - 768)) : vgw, t_n = bal ? (vgw < 768 ? 0 : 5) : ntr, t_st = bal ? 1 : 8 * G;
        for (int k = 0; k < t_n; ++k) {
            int r = t_lo + k * t_st; if (r >= ntr) break;
            transpose_item2(p.in[4], 11720, (bf16_t*)(ws + WS_WIN), DM, r / (NPROJ / 64), r % (NPROJ / 64), scr, lane, MapWin());
        }
        bf16_t* WL = (bf16_t*)(ws + WS_WLORA);
        for (int idx = blk * 512 + tid; idx < 3072 * 32; idx += G * 512) {
            const int n = idx % 3072, kc = idx / 3072, k0 = kc * 8; float v[8];
#pragma unroll
            for (int i = 0; i < 8; ++i) { const int k = k0 + i; float x = 0.f;
                if (n < 1024) { if (k < 96) x = p.in[10][(size_t)k * 1024 + n]; }
                else if (n < 2048) { if (k >= 128 && k < 224) x = p.in[12][(size_t)(k - 128) * 1024 + (n - 1024)]; }
                else x = p.in[13][(size_t)k * 1024 + (n - 2048)];
                v[i] = x; }
            u32x4 o; o.x = pk2(v[0], v[1]); o.y = pk2(v[2], v[3]); o.z = pk2(v[4], v[5]); o.w = pk2(v[6], v[7]);
            *(u32x4*)(WL + (size_t)n * 256 + k0) = o;
        }
    }
    grid.sync();
    STAMP();
    for (int rep_ = 0; rep_ < REP_SYNC; ++rep_) xcd_barrier(bar);

    {
        PHASE_IDS();
        LAS float* lsm = (LAS float*)lds;
        for (int rb = blk; rb < MT / 32; rb += G) {
            const int b = rb / 64;
            __syncthreads();
            for (int i = tid; i < 2 * DM; i += 512) { float s = p.in[3][i];
#pragma unroll
                for (int ks = 0; ks < 16; ++ks) s += PART[(size_t)(ks * 4 + b) * NMOD + i];
                lsm[i] = s; }
            __syncthreads();
            for (int rr = wave; rr < 32; rr += 16) { const int row = rb * 32 + rr, row2 = row + 8;
                const float* xr = p.in[0] + (size_t)row * DM + lane * 4; const float* xr2 = p.in[0] + (size_t)row2 * DM + lane * 4; f32x4 v[8], u[8];
#pragma unroll
                for (int j = 0; j < 8; ++j) { v[j] = __builtin_nontemporal_load((const f32x4*)(xr + j * 256)); u[j] = __builtin_nontemporal_load((const f32x4*)(xr2 + j * 256)); }
                float mean, rstd, mean2, rstd2; ln_stats(v, mean, rstd); ln_stats(u, mean2, rstd2);
                bf16_t* orow = XN + (size_t)row * DM + lane * 4; bf16_t* orow2 = XN + (size_t)row2 * DM + lane * 4;
#pragma unroll
                for (int j = 0; j < 8; ++j) { const int c = j * 256 + lane * 4; const f32x4 sh = *(const LAS f32x4*)(lsm + c), sc = *(const LAS f32x4*)(lsm + DM + c);
                    const f32x4 o = (v[j] - mean) * rstd * (sc + 1.f) + sh; u32x2 w; w.x = pk2(o[0], o[1]); w.y = pk2(o[2], o[3]); *(u32x2*)(orow + j * 256) = w;
                    const f32x4 o2 = (u[j] - mean2) * rstd2 * (sc + 1.f) + sh; u32x2 w2; w2.x = pk2(o2[0], o2[1]); w2.y = pk2(o2[2], o2[3]); *(u32x2*)(orow2 + j * 256) = w2; } }
        }
        for (int i = blk * 512 + tid; i < NB * NMOD; i += G * 512) { const int b = i / NMOD, col = i % NMOD; float s = p.in[3][col];
#pragma unroll
            for (int ks = 0; ks < 16; ++ks) s += PART[(size_t)(ks * 4 + b) * NMOD + col];
            MOD[i] = s; }
    }
    xcd_barrier(bar);
    STAMP();

    for (int rep_ = 0; rep_ < REP_P2; ++rep_) {
        {
        pg8::StaticOrder S; S.init(MT, NBF, G, blk);
        pg8::Gemm g{XN, (const bf16_t*)(ws + WS_WIN), MT, NBF, DM}; pg8::EpiProjBf E{PBF};
        pg8::gemm_phase<pg8::EpiProjBf, pg8::StaticOrder, true, true>(lds, g, S, E);
        }
        {
        pg8::StaticOrder S; S.init(MT, NF32, G, blk);
        pg8::Gemm g{XN, (const bf16_t*)(ws + WS_WIN) + (size_t)NBF * DM, MT, NF32, DM}; pg8::EpiRw E{(bf16_t*)(ws + WS_PRW), (float*)(ws + WS_LF)};
        pg8::gemm_phase<pg8::EpiRw, pg8::StaticOrder, true, true>(lds, g, S, E);
        }
    }
    xcd_barrier(bar);
    STAMP();

    for (int rep_ = 0; rep_ < REP_P3; ++rep_) {
        PHASE_IDS();
        __syncthreads();
        for (int row = gw; row < MT; row += NGW) prep_row(p, row, lane);
    }
    xcd_barrier(bar);
    STAMP();

    {
        { pg8::StaticOrder S; S.init(MT, 2048, G, blk);
          pg8::Gemm g{(const bf16_t*)(ws + WS_ACAT), (const bf16_t*)(ws + WS_WLORA), MT, 2048, 256};
          pg8::EpiLora E{p.in[9], p.in[11], p.out, p.out + (size_t)MT * 1024, (bf16_t*)(ws + WS_G), 0};
          pg8::gemm_phase<pg8::EpiLora, pg8::StaticOrder, true, true>(lds, g, S, E); }
    }
    xcd_barrier(bar);
    STAMP();

    if (blk >= G / 2) {
        pg8::StaticOrder S; S.init(MT, 1024, G - G / 2, blk - G / 2);
        pg8::Gemm g{(const bf16_t*)(ws + WS_ACAT2), (const bf16_t*)(ws + WS_WLORA) + (size_t)2048 * 256, MT, 1024, 256};
        pg8::EpiLora E{p.in[9], p.in[11], p.out, p.out + (size_t)MT * 1024, (bf16_t*)(ws + WS_G), 8};
        pg8::gemm_phase<pg8::EpiLora, pg8::StaticOrder, true, true>(lds, g, S, E);
    }
    {
        PHASE_IDS();
        const int NREC = G / 2;
        if (blk < NREC) {
            for (int rep_ = 0; rep_ < REP_REC; ++rep_)
            for (int job = blk; job < 128; job += NREC)
                rwkv_job(lds, job, p.in[8], p.in[14], p.in[15], (const bf16_t*)(ws + WS_PRW), p.out, p.out + (size_t)MT * 1024, (float*)(ws + WS_YRAW), tid, wave, lane);
        } else {
            const int AW = G - NREC, total = 128 * REP_ATT; int L = blk - NREC;
            for (int Lc = blk - NREC; Lc < 128; Lc += AW) cumsum_job(p, Lc >> 2, lds, tid, wave, lane);
            asm volatile("s_waitcnt vmcnt(0)" ::: "memory"); __syncthreads();
            if (L < total) {
                const fabt* Qn = (const fabt*)(ws + WS_QN); const fabt* Kn = (const fabt*)(ws + WS_KN); const fabt* Vb = (const fabt*)(ws + WS_PBF) + 2048; fabt* O = (fabt*)(ws + WS_O);
                constexpr int W = 1 << 20; char* ldsc = (char*)lds_raw;
                int pass = 0; fa::BlockRef<fabt, fabt> cur = fa_ref(L, 0, Qn, Kn, Vb, O, CUM);
                fa::Seam<fabt> S;
                fa::causal_swa_prime<fabt, fabt, 1024, 1024, PBP>(cur, W, ldsc, S);
                for (;;) {
                    const bool more_pass = pass == 0, more_item = L + AW < total, last = !more_pass && !more_item;
                    int passn = pass + 1, Ln = L;
                    if (!more_pass) { passn = 0; Ln = more_item ? L + AW : L; }
                    const fa::BlockRef<fabt, fabt> nxt = last ? cur : fa_ref(Ln, passn, Qn, Kn, Vb, O, CUM);
                    fa::causal_swa_block<fabt, fabt, 1024, 1024, PBP>(cur, nxt, SEQ, W, ldsc, S);
                    if (last) break;
                    cur = nxt; pass = passn; L = Ln;
                }
            }
            __syncthreads();
            const int aw = (blk - NREC) * 8 + wave, AWV = AW * 8;
            for (int r = aw; r < (DFF / 64) * 32; r += AWV) transpose_item2(p.in[25], DM, (bf16_t*)(ws + WS_WDOWN), DFF, r / 32, r % 32, scr, lane, MapId());
            for (int r = aw; r < 32 * (2 * DFF / 64); r += AWV) transpose_item2(p.in[24], 2 * DFF, (bf16_t*)(ws + WS_WGU), DM, r / (2 * DFF / 64), r % (2 * DFF / 64), scr, lane, MapGu());
            for (int r = aw; r < 32 * 32; r += AWV) transpose_item2(p.in[21], DM, (bf16_t*)(ws + WS_WOUT), DM, r / 32, r % 32, scr, lane, MapId());
            for (int r = aw; r < 2 * 16 * 32; r += AWV) { const int q = r & 511; transpose_item2(r < 512 ? p.in[19] : p.in[20], DM, (bf16_t*)(ws + (r < 512 ? WS_WA : WS_WB)), 1024, q / 32, q % 32, scr, lane, MapId()); }
        }
    }
    xcd_barrier(bar);
    STAMP();

    {
        PHASE_IDS();
        for (int row = gw; row < MT; row += NGW) post_row(p, row, lane);
    }
    xcd_barrier(bar);
    STAMP();

    for (int rep_ = 0; rep_ < REP_P7B; ++rep_) {
        pg8::StaticOrder S; S.init(MT, DM, G, blk);
        pg8::Gemm g{(const bf16_t*)(ws + WS_O), (const bf16_t*)(ws + WS_WA), MT, DM, 1024, (const bf16_t*)(ws + WS_KN), (const bf16_t*)(ws + WS_WB)};
        pg8::EpiMergeDual E{PBF + 4096, PBF + 6144, (bf16_t*)(ws + WS_MERGED)};
        pg8::gemm_phase<pg8::EpiMergeDual, pg8::StaticOrder, true, true, true>(lds, g, S, E);
    }
    xcd_barrier(bar);
    STAMP();

    const bool fusedln = (G == 256);
    if (fusedln) {
        pg8::StaticOrder S; S.init(MT, DM, G, blk);
        pg8::Gemm g{(const bf16_t*)(ws + WS_MERGED), (const bf16_t*)(ws + WS_WOUT), MT, DM, DM};
        pg8::EpiResLnLn E{p.in[0], p.out, XN, MOD, p.in[22], p.in[23], (float*)(ws + WS_SLOT), (float*)(ws + WS_SLOT + 512 * 1024), &bar};
        pg8::gemm_phase<pg8::EpiResLnLn, pg8::StaticOrder, false, true>(lds, g, S, E);
        xcd_barrier(bar);
    } else {
        for (int rep_ = 0; rep_ < REP_P8; ++rep_) {
            pg8::StaticOrder S; S.init(MT, DM, G, blk);
            pg8::Gemm g{(const bf16_t*)(ws + WS_MERGED), (const bf16_t*)(ws + WS_WOUT), MT, DM, DM}; pg8::EpiRes E{p.in[0], p.out, MOD + 2 * DM};
            pg8::gemm_phase<pg8::EpiRes, pg8::StaticOrder, true, true>(lds, g, S, E);
        }
        xcd_barrier(bar);
        STAMP();

        { PHASE_IDS();
        for (int row = gw; row < MT; row += 2 * NGW) {
            const int row2 = row + NGW < MT ? row + NGW : row;
            float* xr = p.out + (size_t)row * DM + lane * 4; float* xr2 = p.out + (size_t)row2 * DM + lane * 4; f32x4 v[8], u[8];
    #pragma unroll
            for (int j = 0; j < 8; ++j) { v[j] = *(const f32x4*)(xr + j * 256); u[j] = *(const f32x4*)(xr2 + j * 256); }
            float mean, rstd, mean2, rstd2; ln_stats(v, mean, rstd); ln_stats(u, mean2, rstd2);
    #pragma unroll
            for (int j = 0; j < 8; ++j) { const int c = j * 256 + lane * 4; const f32x4 g = *(const f32x4*)(p.in[22] + c), b = *(const f32x4*)(p.in[23] + c);
                v[j] = (v[j] - mean) * rstd * g + b; u[j] = (u[j] - mean2) * rstd2 * g + b; *(f32x4*)(xr + j * 256) = v[j]; if (row2 != row) *(f32x4*)(xr2 + j * 256) = u[j]; }
            ln_stats(v, mean, rstd); ln_stats(u, mean2, rstd2);
            const float* mb = MOD + (size_t)(row / SEQ) * NMOD; const float* mb2 = MOD + (size_t)(row2 / SEQ) * NMOD;
            bf16_t* orow = XN + (size_t)row * DM + lane * 4; bf16_t* orow2 = XN + (size_t)row2 * DM + lane * 4;
    #pragma unroll
            for (int j = 0; j < 8; ++j) { const int c = j * 256 + lane * 4;
                { const f32x4 sh = *(const f32x4*)(mb + 3 * DM + c), sc = *(const f32x4*)(mb + 4 * DM + c);
                  const f32x4 o = (v[j] - mean) * rstd * (sc + 1.f) + sh; u32x2 w; w.x = pk2(o[0], o[1]); w.y = pk2(o[2], o[3]); *(u32x2*)(orow + j * 256) = w; }
                if (row2 != row) { const f32x4 sh = *(const f32x4*)(mb2 + 3 * DM + c), sc = *(const f32x4*)(mb2 + 4 * DM + c);
                  const f32x4 o = (u[j] - mean2) * rstd2 * (sc + 1.f) + sh; u32x2 w; w.x = pk2(o[0], o[1]); w.y = pk2(o[2], o[3]); *(u32x2*)(orow2 + j * 256) = w; } }
        } }
        xcd_barrier(bar);
        STAMP();
    }

    for (int rep_ = 0; rep_ < REP_P10; ++rep_) {
        pg8::StaticOrder S; S.init(MT, 2 * DFF, G, blk);
        pg8::Gemm g{XN, (const bf16_t*)(ws + WS_WGU), MT, 2 * DFF, DM}; pg8::EpiSwiGLU E{PBF};
        pg8::gemm_phase<pg8::EpiSwiGLU, pg8::StaticOrder, true, true>(lds, g, S, E);
    }
    xcd_barrier(bar);
    STAMP();

    if (fusedln) {
        pg8::StaticOrder S; S.init(MT, DM, G, blk);
        pg8::Gemm g{PBF, (const bf16_t*)(ws + WS_WDOWN), MT, DM, DFF};
        pg8::EpiResLn E{p.out, p.out, MOD + 5 * DM, p.in[26], p.in[27], (float*)(ws + WS_SLOT + 1024 * 1024), &bar};
        pg8::gemm_phase<pg8::EpiResLn, pg8::StaticOrder, false, true>(lds, g, S, E);
    } else {
        {
            pg8::StaticOrder S; S.init(MT, DM, G, blk);
            pg8::Gemm g{PBF, (const bf16_t*)(ws + WS_WDOWN), MT, DM, DFF}; pg8::EpiRes E{p.out, p.out, MOD + 5 * DM};
            pg8::gemm_phase<pg8::EpiRes, pg8::StaticOrder, true, true>(lds, g, S, E);
        }
        xcd_barrier(bar);
        STAMP();

        { PHASE_IDS();
        for (int row = gw; row < MT; row += 2 * NGW) {
            const int row2 = row + NGW < MT ? row + NGW : row;
            float* xr = p.out + (size_t)row * DM + lane * 4; float* xr2 = p.out + (size_t)row2 * DM + lane * 4; f32x4 v[8], u[8];
    #pragma unroll
            for (int j = 0; j < 8; ++j) { v[j] = *(const f32x4*)(xr + j * 256); u[j] = *(const f32x4*)(xr2 + j * 256); }
            float mean, rstd, mean2, rstd2; ln_stats(v, mean, rstd); ln_stats(u, mean2, rstd2);
    #pragma unroll
            for (int j = 0; j < 8; ++j) { const int c = j * 256 + lane * 4; const f32x4 g = *(const f32x4*)(p.in[26] + c), b = *(const f32x4*)(p.in[27] + c);
                *(f32x4*)(xr + j * 256) = (v[j] - mean) * rstd * g + b; if (row2 != row) *(f32x4*)(xr2 + j * 256) = (u[j] - mean2) * rstd2 * g + b; }
        } }
    }
#if PROBE_MASK
    STAMP();
    if (blockIdx.x == 0 && threadIdx.x == 0) { unsigned long long sp = 0; for (int i = 0; i + 1 < nts; ++i) if ((PROBE_MASK >> i) & 1) sp += tsb[i + 1] - tsb[i];
        const unsigned long long t0 = __builtin_amdgcn_s_memrealtime(); while (__builtin_amdgcn_s_memrealtime() - t0 < sp * PROBE_MULT) __builtin_amdgcn_s_sleep(8); }
#endif
}

extern "C" void kernel_launch(void* const* d_in, const int* in_sizes, int n_in, void* d_out, int out_size, void* d_ws, size_t ws_size, hipStream_t stream) {
    static int grid_blocks = 0;
    if (grid_blocks == 0) {
        if (n_in != 28 || out_size != MT * DM || ws_size < WS_END) { fprintf(stderr, "kernel_launch: unexpected shapes (n_in %d out %d ws %zu, need %zu)\n", n_in, out_size, ws_size, (size_t)WS_END); grid_blocks = -1; return; }
        int dev = 0, cus = 0, per_cu = 0;
        hipGetDevice(&dev);
        hipDeviceGetAttribute(&cus, hipDeviceAttributeMultiprocessorCount, dev);
        hipFuncSetAttribute((const void*)mk_fwd, hipFuncAttributeMaxDynamicSharedMemorySize, LDS_BYTES);
        hipOccupancyMaxActiveBlocksPerMultiprocessor(&per_cu, (const void*)mk_fwd, 512, LDS_BYTES);
        if (per_cu < 1 || cus < 1) { fprintf(stderr, "kernel_launch: occupancy query failed (%d x %d)\n", cus, per_cu); grid_blocks = -1; return; }
        grid_blocks = cus * per_cu;
        if (grid_blocks > 256) grid_blocks = 256;
    }
    if (grid_blocks < 0) return;
    if (hipMemsetAsync((char*)d_ws + WS_BAR, 0, 65536, stream) != hipSuccess) { fprintf(stderr, "kernel_launch: memset of the barrier words failed\n"); return; }
    Params p{};
    for (int i = 0; i < 28; ++i) p.in[i] = (const float*)d_in[i];
    p.out = (float*)d_out; p.ws = (unsigned char*)d_ws;
    void* args[] = {&p};
    hipError_t e = hipLaunchCooperativeKernel((const void*)mk_fwd, dim3(grid_blocks), dim3(512), args, LDS_BYTES, stream);
    if (e != hipSuccess) fprintf(stderr, "cooperative launch failed: %s (grid %d)\n", hipGetErrorString(e), grid_blocks);
}
```

```cpp
#include <hip/hip_runtime.h>
#include <hip/hip_bf16.h>
#include <hip/hip_cooperative_groups.h>
#include <cstdio>
#include <cstdint>
namespace cg = cooperative_groups;

namespace pg8 {
#define PG8_LAS __attribute__((address_space(3)))
typedef unsigned short bf16_t;
typedef short bf16x8 __attribute__((ext_vector_type(8)));
typedef float f32x4 __attribute__((ext_vector_type(4)));
typedef unsigned u32x4 __attribute__((ext_vector_type(4)));
constexpr int BM = 256, BK = 64, HALF = 128, HTB = HALF * BK * 2  , STAGE_BYTES = 8 * HTB, NXCD = 8, WGM = 8;

__host__ __device__ __forceinline__ int lds_byte(int r, int c) { const int st = (r >> 4) * 2 + (c >> 5), rr = r & 15, cc = c & 31, ob = rr * 64 + cc * 2; return st * 1024 + (ob ^ (((ob >> 9) & 1) << 5)); }
__host__ __device__ __forceinline__ void stage_rc(int b, int& R, int& C) { const int st = b / 1024, sb = b % 1024, swz = sb ^ (((sb >> 9) & 1) << 5); R = (st >> 1) * 16 + swz / 64; C = (st & 1) * 32 + (swz % 64) / 2; }
__host__ __device__ __forceinline__ int perm32(int rho) { const int n = rho >> 4, i = rho & 15; return 8 * (i >> 2) + 4 * n + (i & 3); }

struct Unit { int pm, pn; };
struct Gemm { const bf16_t* A; const bf16_t* Bt; int M, N, K; const bf16_t* A2 = nullptr; const bf16_t* Bt2 = nullptr; };

struct StaticOrder {
    int nM, nN, nwg, G, c;
    __host__ __device__ void init(int M, int N, int G_, int c_) { nM = M / BM; nN = N / BM; nwg = nM * nN; G = G_; c = c_; }
    __host__ __device__ bool next(int i, Unit& u) const {
        const long L = (long)i * G + c; if (L >= nwg) return false;
        int wgid = (int)L; { const int q = nwg / NXCD, r = nwg % NXCD, xcd = wgid % NXCD, off = wgid / NXCD; wgid = (xcd < r ? xcd * (q + 1) : r * (q + 1) + (xcd - r) * q) + off; }
        const int nig = WGM * nN, gid = wgid / nig, fm = gid * WGM, gsz = (nM - fm) < WGM ? (nM - fm) : WGM;
        u.pm = fm + ((wgid % nig) % gsz); u.pn = (wgid % nig) / gsz; return true;
    }
    __device__ __forceinline__ void a_ready(const Unit&) const {}
    __device__ __forceinline__ void done(const Unit&) const {}
};
__device__ __forceinline__ unsigned cvt_pk_bf16(float lo, float hi) { unsigned r; asm volatile("v_cvt_pk_bf16_f32 %0, %1, %2" : "=v"(r) : "v"(lo), "v"(hi)); return r; }
typedef float f32x2 __attribute__((ext_vector_type(2)));
template <class Epi, class Sched, bool ALIGN_EPI = false, bool SP2 = false, bool DUAL = false>
__device__ __forceinline__ void gemm_phase(PG8_LAS unsigned char* lds, const Gemm g, const Sched& S, const Epi& E) {
    int tid = threadIdx.x; asm volatile("" : "+v"(tid));
    const int wid = __builtin_amdgcn_readfirstlane(tid >> 6), lane = tid & 63, wr = wid >> 2, wc = wid & 3, fr = lane & 15, fq = lane >> 4;
    const int K = g.K, HT = K / BK, nt = DUAL ? 2 * HT : HT;
    unsigned voffA[2], voffB[2];
#pragma unroll
    for (int i = 0; i < 2; ++i) { int R, C; stage_rc(tid * 16 + i * 8192, R, C); const int Rb = Epi::PERM ? ((R & ~31) + perm32(R & 31)) : R;
        voffA[i] = (unsigned)(R * K + C) * 2u; voffB[i] = (unsigned)(Rb * K + C) * 2u; }
    const size_t kstep = (size_t)(BK * 2);
    const size_t hstep = (size_t)HALF * K * 2;
    const size_t tstep = 2 * hstep;
    const unsigned ldsw = (unsigned)wid * 1024u;
    const int aoff = lds_byte(wr * 64 + fr, fq * 8), boff = lds_byte(wc * 32 + fr, fq * 8);
#define PG8_SA(b, h) (((b) * 2 + (h)) * HTB)
#define PG8_SB(b, h) ((4 + (b) * 2 + (h)) * HTB)
#define PG8_STAGE(bufoff, gbase, voff) do { _Pragma("unroll") for (int _i = 0; _i < 2; ++_i) \
        __builtin_amdgcn_global_load_lds((const unsigned*)((const char*)(gbase) + (voff)[_i]), (PG8_LAS unsigned*)(lds + (bufoff) + ldsw + _i * 8192), 16, 0, 0); } while (0)
#define PG8_LDA(dst, b, h) do { _Pragma("unroll") for (int m = 0; m < 4; ++m) _Pragma("unroll") for (int k = 0; k < 2; ++k) dst[m][k] = *(const PG8_LAS bf16x8*)(lds + PG8_SA(b, h) + aoff + m * 2048 + k * 1024); } while (0)
#define PG8_LDB(dst, b, h) do { _Pragma("unroll") for (int n = 0; n < 2; ++n) _Pragma("unroll") for (int k = 0; k < 2; ++k) dst[n][k] = *(const PG8_LAS bf16x8*)(lds + PG8_SB(b, h) + boff + n * 2048 + k * 1024); } while (0)
#define PG8_MMA(ai, bj, At, Bt) do { __builtin_amdgcn_s_setprio(1); _Pragma("unroll") for (int m = 0; m < 4; ++m) _Pragma("unroll") for (int n = 0; n < 2; ++n) _Pragma("unroll") for (int k = 0; k < 2; ++k) \
        acc[ai][bj][m][n] = __builtin_amdgcn_mfma_f32_16x16x32_bf16(Bt[n][k], At[m][k], acc[ai][bj][m][n], 0, 0, 0); __builtin_amdgcn_s_setprio(0); } while (0)
#define PG8_WAIT_V(n) asm volatile("s_waitcnt vmcnt(" #n ")" ::: "memory")
#define PG8_WAIT_L(n) asm volatile("s_waitcnt lgkmcnt(" #n ")" ::: "memory")
#define PG8_BAR __builtin_amdgcn_s_barrier()
#define PG8_SCHED __builtin_amdgcn_sched_barrier(0)
    Unit cur, nxt; int ui = 0;
    if (!S.next(0, cur)) return;
    f32x4 acc[2][2][4][2];
#pragma unroll
    for (int a = 0; a < 2; ++a)
#pragma unroll
        for (int b = 0; b < 2; ++b)
#pragma unroll
            for (int m = 0; m < 4; ++m)
#pragma unroll
                for (int n = 0; n < 2; ++n) acc[a][b][m][n] = (f32x4){0.f, 0.f, 0.f, 0.f};
    bf16x8 At[4][2], B0[2][2], B1[2][2];
    const char* cA = (const char*)g.A + (size_t)cur.pm * tstep; const char* cB = (const char*)g.Bt + (size_t)cur.pn * tstep;
    S.a_ready(cur);
    if constexpr (SP2) {
        PG8_STAGE(PG8_SB(0, 0), cB, voffB); PG8_STAGE(PG8_SB(0, 1), cB + hstep, voffB); PG8_STAGE(PG8_SA(0, 0), cA, voffA); PG8_STAGE(PG8_SA(0, 1), cA + hstep, voffA);
        if (wr == 1) PG8_BAR;
        PG8_WAIT_V(2); PG8_BAR;
        PG8_STAGE(PG8_SB(1, 0), cB + kstep, voffB); PG8_STAGE(PG8_SA(1, 0), cA + kstep, voffA); PG8_STAGE(PG8_SB(1, 1), cB + hstep + kstep, voffB);
        PG8_WAIT_V(6); PG8_BAR;
    } else {
        PG8_STAGE(PG8_SB(0, 0), cB, voffB); PG8_STAGE(PG8_SA(0, 0), cA, voffA); PG8_STAGE(PG8_SB(0, 1), cB + hstep, voffB); PG8_STAGE(PG8_SA(0, 1), cA + hstep, voffA);
        if (wr == 1) PG8_BAR;
        PG8_WAIT_V(4); PG8_BAR;
        PG8_STAGE(PG8_SB(1, 0), cB + kstep, voffB); PG8_STAGE(PG8_SA(1, 0), cA + kstep, voffA); PG8_STAGE(PG8_SB(1, 1), cB + hstep + kstep, voffB);
        PG8_WAIT_V(6); PG8_BAR;
    }
    for (;;) {
        const bool has_next = S.next(ui + 1, nxt);
        const char* cA2 = DUAL ? (const char*)g.A2 + (size_t)cur.pm * tstep - (size_t)HT * kstep : cA; const char* cB2 = DUAL ? (const char*)g.Bt2 + (size_t)cur.pn * tstep - (size_t)HT * kstep : cB;
        const char* nA = has_next ? (const char*)g.A + (size_t)nxt.pm * tstep : cA; const char* nB = has_next ? (const char*)g.Bt + (size_t)nxt.pn * tstep : cB;
        for (int t = 0; t < nt; t += 2) {
            const bool last = (t == nt - 2);
            const char* bA0 = (DUAL && t >= HT) ? cA2 : cA; const char* bA2 = (DUAL && t + 2 >= HT) ? cA2 : cA; const char* bB2 = (DUAL && t + 2 >= HT) ? cB2 : cB;
            if constexpr (DUAL) { if (t == HT) E.mid(acc, cur, wr, wc, fr, fq); }
            const char* a1 = bA0 + (size_t)(t + 1) * kstep;
            const char* a2 = last ? nA : bA2 + (size_t)(t + 2) * kstep; const char* b2 = last ? nB : bB2 + (size_t)(t + 2) * kstep;
            const char* a3 = a2 + kstep; const char* b3 = b2 + kstep;
            if (last && has_next) S.a_ready(nxt);
            if constexpr (SP2) {
            PG8_LDB(B0, 0, 0); PG8_LDB(B1, 0, 1); PG8_SCHED; PG8_LDA(At, 0, 0); PG8_STAGE(PG8_SA(1, 1), a1 + hstep, voffA);
            PG8_WAIT_V(8); PG8_WAIT_L(0); PG8_BAR; PG8_MMA(0, 0, At, B0); PG8_MMA(0, 1, At, B1); PG8_BAR; PG8_SCHED;
            PG8_LDA(At, 0, 1); PG8_STAGE(PG8_SB(0, 0), b2, voffB); PG8_STAGE(PG8_SB(0, 1), b2 + hstep, voffB); PG8_STAGE(PG8_SA(0, 0), a2, voffA);
            PG8_WAIT_V(8); PG8_WAIT_L(0); PG8_BAR; PG8_MMA(1, 0, At, B0); PG8_MMA(1, 1, At, B1); PG8_BAR; PG8_SCHED;
            PG8_LDB(B0, 1, 0); PG8_LDB(B1, 1, 1); PG8_SCHED; PG8_LDA(At, 1, 0); PG8_STAGE(PG8_SA(0, 1), a2 + hstep, voffA);
            PG8_WAIT_V(8); PG8_WAIT_L(0); PG8_BAR; PG8_MMA(0, 0, At, B0); PG8_MMA(0, 1, At, B1); PG8_BAR; PG8_SCHED;
            PG8_LDA(At, 1, 1); PG8_STAGE(PG8_SB(1, 0), b3, voffB); PG8_STAGE(PG8_SB(1, 1), b3 + hstep, voffB); PG8_STAGE(PG8_SA(1, 0), a3, voffA);
            PG8_WAIT_V(8); PG8_WAIT_L(0); PG8_BAR; PG8_MMA(1, 0, At, B0); PG8_MMA(1, 1, At, B1); PG8_BAR; PG8_SCHED;
            } else {
            PG8_LDB(B0, 0, 0); PG8_SCHED; PG8_LDA(At, 0, 0); PG8_STAGE(PG8_SA(1, 1), a1 + hstep, voffA);
            PG8_WAIT_L(8); PG8_BAR; PG8_WAIT_L(0); PG8_MMA(0, 0, At, B0); PG8_BAR; PG8_SCHED;
            PG8_LDB(B1, 0, 1); PG8_STAGE(PG8_SB(0, 0), b2, voffB);
            PG8_BAR; PG8_WAIT_L(0); PG8_MMA(0, 1, At, B1); PG8_BAR;
            PG8_LDA(At, 0, 1); PG8_STAGE(PG8_SA(0, 0), a2, voffA);
            PG8_BAR; PG8_WAIT_L(0); PG8_MMA(1, 0, At, B0); PG8_BAR; PG8_SCHED;
            PG8_STAGE(PG8_SB(0, 1), b2 + hstep, voffB);
            PG8_WAIT_V(6); PG8_BAR; PG8_MMA(1, 1, At, B1); PG8_BAR;
            PG8_LDB(B0, 1, 0); PG8_SCHED; PG8_LDA(At, 1, 0); PG8_STAGE(PG8_SA(0, 1), a2 + hstep, voffA);
            PG8_WAIT_L(8); PG8_BAR; PG8_WAIT_L(0); PG8_MMA(0, 0, At, B0); PG8_BAR; PG8_SCHED;
            PG8_LDB(B1, 1, 1); PG8_STAGE(PG8_SB(1, 0), b3, voffB);
            PG8_BAR; PG8_WAIT_L(0); PG8_MMA(0, 1, At, B1); PG8_BAR;
            PG8_LDA(At, 1, 1); PG8_STAGE(PG8_SA(1, 0), a3, voffA);
            PG8_BAR; PG8_WAIT_L(0); PG8_MMA(1, 0, At, B0); PG8_BAR; PG8_SCHED;
            PG8_STAGE(PG8_SB(1, 1), b3 + hstep, voffB);
            PG8_WAIT_V(6); PG8_BAR; PG8_MMA(1, 1, At, B1); PG8_BAR;
            }
        }
        if constexpr (ALIGN_EPI) { if (wr == 0) PG8_BAR; }
        if constexpr (!Epi::AFTER_DRAIN) { E(acc, cur, wr, wc, fr, fq); S.done(cur); }
        if (!has_next) break;
#pragma unroll
        for (int a = 0; a < 2; ++a)
#pragma unroll
            for (int b = 0; b < 2; ++b)
#pragma unroll
                for (int m = 0; m < 4; ++m)
#pragma unroll
                    for (int n = 0; n < 2; ++n) acc[a][b][m][n] = (f32x4){0.f, 0.f, 0.f, 0.f};
        cur = nxt; cA = nA; cB = nB; ++ui;
        if constexpr (ALIGN_EPI) { if (wr == 1) PG8_BAR; }
    }
    PG8_WAIT_V(0);
    if constexpr (!ALIGN_EPI) { if (wr == 0) PG8_BAR; }
    PG8_BAR;
    if constexpr (Epi::AFTER_DRAIN) { E.fused(acc, cur, wr, wc, fr, fq, lds, wid, lane); S.done(cur); }
#undef PG8_SA
#undef PG8_SB
#undef PG8_STAGE
#undef PG8_LDA
#undef PG8_LDB
#undef PG8_MMA
#undef PG8_WAIT_V
#undef PG8_WAIT_L
#undef PG8_BAR
#undef PG8_SCHED
}
}
namespace fa {
constexpr int D = 128; constexpr bool WSKIP = false; constexpr float THR = 8.f;
constexpr float SCALE = 0.08838834764831845f;
constexpr int NW = 8, QBLK = 32, KVBLK = 64, QB = NW * QBLK;
constexpr int SHM_V = KVBLK * D * 2, SHM_K = KVBLK * D * 2;
constexpr int LDS_BYTES = 2 * SHM_V + 2 * SHM_K + NW * 64 * 4;
constexpr int KB_OFF = LDS_BYTES;
constexpr int FA_LDS_BYTES = LDS_BYTES + 2 * 2048 * 4;
__device__ __forceinline__ void load_kbias(const float* CB, int P0, float* dst) {
    const float c0 = CB[P0]; const float inv = 1.0f / SCALE;
    for (int s = threadIdx.x; s < P0 + QB; s += 512) dst[s] = (c0 - CB[s]) * inv;
}
using bf16 = __hip_bfloat16;
typedef short bf16x8 __attribute__((ext_vector_type(8)));
typedef short s16x4 __attribute__((ext_vector_type(4)));
typedef float f32x16 __attribute__((ext_vector_type(16)));
typedef float f32x4 __attribute__((ext_vector_type(4)));
typedef unsigned u32x4 __attribute__((ext_vector_type(4)));
template <class A, class Bt> struct same_t { static constexpr bool v = false; };
template <class A> struct same_t<A, A> { static constexpr bool v = true; };

#define KSWZ(row, colB) ((row) * 256 + ((colB) ^ (((row) & 7) << 4)))
#define SBAR() __builtin_amdgcn_sched_barrier(0)
__device__ __forceinline__ int v_st(int k, int c) { const int kk = (k & ~0xC) | ((k & 4) << 1) | ((k & 8) >> 1); return ((kk >> 3) * 4 + (c >> 5)) * 512 + ((kk & 7) * 32 + (c & 31)) * 2; }
__device__ __forceinline__ int v_rd_base(int lane) { return ((lane & 3) << 3) | (((lane >> 2) & 3) << 6) | (((lane >> 4) & 1) << 5) | (((lane >> 5) & 1) << 8); }
constexpr int v_rd_off(int d0, int ks, int half) { return d0 * 512 + ks * 4096 + half * 2048; }
__device__ __forceinline__ int crow(int r, int hi) { return (r & 3) + 8 * (r >> 2) + 4 * hi; }
__device__ __forceinline__ unsigned cvtpk(float lo, float hi) {
    unsigned r; asm volatile("v_cvt_pk_bf16_f32 %0, %1, %2" : "=v"(r) : "v"(lo), "v"(hi)); return r;
}
__device__ __forceinline__ bf16x8 pack8(f32x4 a, f32x4 b) {
    u32x4 w = {cvtpk(a[0], a[1]), cvtpk(a[2], a[3]), cvtpk(b[0], b[1]), cvtpk(b[2], b[3])};
    return *reinterpret_cast<bf16x8*>(&w);
}
template <class T> __device__ __forceinline__ bf16x8 load8(const T* p) {
    if constexpr (same_t<T, float>::v) { return pack8(*(const f32x4*)p, *(const f32x4*)(p + 4)); }
    else { return *reinterpret_cast<const bf16x8*>(p); }
}
__device__ __forceinline__ void mask_tile(f32x16& p0, f32x16& p1, int dq, unsigned W) {
    const float NEG = -__builtin_inff();
#pragma unroll
    for (int r = 0; r < 16; ++r) {
        const int c = (r & 3) + 8 * (r >> 2);
        if ((unsigned)(dq - c) >= W) p0[r] = NEG;
        if ((unsigned)(dq - c - 32) >= W) p1[r] = NEG;
    }
}
__device__ __forceinline__ void partialSM(f32x16& p0, f32x16& p1, float& m_reg, float& mn, float& alpha) {
    float pmax = p0[0]; for (int r = 1; r < 16; ++r) pmax = fmaxf(pmax, p0[r]); for (int r = 0; r < 16; ++r) pmax = fmaxf(pmax, p1[r]);
    { auto rr = __builtin_amdgcn_permlane32_swap(__float_as_uint(pmax), __float_as_uint(pmax), false, false);
      pmax = fmaxf(__uint_as_float(rr[0]), __uint_as_float(rr[1])); }
    constexpr float C2 = 1.4426950408889634f * SCALE;
    if (__builtin_expect(__all((pmax - m_reg) * SCALE <= THR), 1)) { mn = m_reg; alpha = 1.f; }
    else { mn = fmaxf(m_reg, pmax); alpha = __builtin_amdgcn_exp2f((m_reg - mn) * C2); m_reg = mn; }
    const float mnL = -mn * C2;
    for (int r = 0; r < 16; ++r) p0[r] = fmaf(p0[r], C2, mnL); for (int r = 0; r < 16; ++r) p1[r] = fmaf(p1[r], C2, mnL);
    for (int r = 0; r < 16; ++r) p0[r] = __builtin_amdgcn_exp2f(p0[r]);
}
__device__ __forceinline__ void finishSM(f32x16& p0, f32x16& p1, float alpha, float& l_reg, bf16x8& pa0, bf16x8& pa1, bf16x8& pa2, bf16x8& pa3) {
    for (int r = 0; r < 16; ++r) p1[r] = __builtin_amdgcn_exp2f(p1[r]);
    float ps = 0; for (int r = 0; r < 16; ++r) ps += p0[r]; for (int r = 0; r < 16; ++r) ps += p1[r];
    { auto rr = __builtin_amdgcn_permlane32_swap(__float_as_uint(ps), __float_as_uint(ps), false, false);
      ps = __uint_as_float(rr[0]) + __uint_as_float(rr[1]); }
    l_reg = l_reg * alpha + ps;
#define PK4(P, B_, OUT) do { unsigned a0 = cvtpk(P[B_+0], P[B_+1]), a1 = cvtpk(P[B_+2], P[B_+3]);                          \
        unsigned b0 = cvtpk(P[B_+4], P[B_+5]), b1 = cvtpk(P[B_+6], P[B_+7]);                                             \
        auto r0 = __builtin_amdgcn_permlane32_swap(a0, b0, false, false); auto r1 = __builtin_amdgcn_permlane32_swap(a1, b1, false, false); \
        u32x4 w = {r0[0], r1[0], r0[1], r1[1]}; OUT = *reinterpret_cast<bf16x8*>(&w); } while (0)
    PK4(p0, 0, pa0); PK4(p0, 8, pa1); PK4(p1, 0, pa2); PK4(p1, 8, pa3);
#undef PK4
}
template <int KB, bool SK>
__device__ __forceinline__ void qkt(f32x16& p0, f32x16& p1, const char* K_lds, int r32, int hi, const bf16x8* qr, bool act, const float* kbp) {
    if (SK && !act) { const float NEG = -__builtin_inff();
#pragma unroll
        for (int r = 0; r < 16; ++r) { p0[r] = NEG; p1[r] = NEG; } return; }
    p0 = f32x16{}; p1 = f32x16{};
    const char* kb[4];
#pragma unroll
    for (int dd = 0; dd < 4; ++dd) kb[dd] = K_lds + KB * SHM_K + KSWZ(r32, (dd * 16 + hi * 8) * 2);
#pragma unroll
    for (int d0 = 0; d0 < 8; ++d0) { const char* a = kb[d0 & 3] + (d0 >> 2) * 128;
        bf16x8 b0 = *reinterpret_cast<const bf16x8*>(a);
        bf16x8 b1 = *reinterpret_cast<const bf16x8*>(a + 32 * 256);
        p0 = __builtin_amdgcn_mfma_f32_32x32x16_bf16(b0, qr[d0], p0, 0, 0, 0);
        p1 = __builtin_amdgcn_mfma_f32_32x32x16_bf16(b1, qr[d0], p1, 0, 0, 0); }
    {
        const float c0_ = hi ? 0.f : kbp[r32], c1_ = hi ? 0.f : kbp[32 + r32];
        const unsigned hp = cvtpk(c0_, c1_); const float r0_ = c0_ - __uint_as_float(hp << 16), r1_ = c1_ - __uint_as_float(hp & 0xffff0000u);
        const unsigned mp = cvtpk(r0_, r1_); const unsigned lp = cvtpk(r0_ - __uint_as_float(mp << 16), r1_ - __uint_as_float(mp & 0xffff0000u));
        u32x4 k0_ = {(hp & 0xffffu) | (mp << 16), lp & 0xffffu, 0u, 0u}, k1_ = {(hp >> 16) | (mp & 0xffff0000u), lp >> 16, 0u, 0u};
        const u32x4 q1_ = {0x3F803F80u, 0x00003F80u, 0u, 0u};
        p0 = __builtin_amdgcn_mfma_f32_32x32x16_bf16(*reinterpret_cast<bf16x8*>(&k0_), *reinterpret_cast<const bf16x8*>(&q1_), p0, 0, 0, 0);
        p1 = __builtin_amdgcn_mfma_f32_32x32x16_bf16(*reinterpret_cast<bf16x8*>(&k1_), *reinterpret_cast<const bf16x8*>(&q1_), p1, 0, 0, 0); }
}
template <int VB, bool SK>
__device__ __forceinline__ void pv_tile(f32x16* o, int vb0, bf16x8 pa0, bf16x8 pa1, bf16x8 pa2, bf16x8 pa3, bool act) {
    if (SK && !act) return;
#define TRRD(dst, off) asm volatile("ds_read_b64_tr_b16 %0, %1 offset:%2" : "=&v"(dst) : "v"(vb0), "i"(off) : "memory")
#define PV_D0(d0) do { s16x4 l0, l1, l2, l3, h0, h1, h2, h3; constexpr int b_ = VB * SHM_V + v_rd_off(d0, 0, 0);     \
        TRRD(l0, b_); TRRD(h0, b_ + 2048); TRRD(l1, b_ + 4096); TRRD(h1, b_ + 6144); TRRD(l2, b_ + 8192); TRRD(h2, b_ + 10240); TRRD(l3, b_ + 12288); TRRD(h3, b_ + 14336); \
        asm volatile("s_waitcnt lgkmcnt(0)" ::: "memory"); SBAR();                 \
        o[d0] = __builtin_amdgcn_mfma_f32_32x32x16_bf16(pa0, (bf16x8){l0[0], l0[1], l0[2], l0[3], h0[0], h0[1], h0[2], h0[3]}, o[d0], 0, 0, 0);   \
        o[d0] = __builtin_amdgcn_mfma_f32_32x32x16_bf16(pa1, (bf16x8){l1[0], l1[1], l1[2], l1[3], h1[0], h1[1], h1[2], h1[3]}, o[d0], 0, 0, 0);   \
        o[d0] = __builtin_amdgcn_mfma_f32_32x32x16_bf16(pa2, (bf16x8){l2[0], l2[1], l2[2], l2[3], h2[0], h2[1], h2[2], h2[3]}, o[d0], 0, 0, 0);   \
        o[d0] = __builtin_amdgcn_mfma_f32_32x32x16_bf16(pa3, (bf16x8){l3[0], l3[1], l3[2], l3[3], h3[0], h3[1], h3[2], h3[3]}, o[d0], 0, 0, 0); } while (0)
    PV_D0(0); PV_D0(1); PV_D0(2); PV_D0(3);
#undef PV_D0
#undef TRRD
}
template <class TIn, class TOut> struct BlockRef { const TIn* Q; const TIn* K; const TIn* V; TOut* O; const TOut* SG; const float* CB; int P0; };
template <class TIn> struct Seam {
    bf16x8 qr[8];
    bf16x8 st_v0, st_v1, st_k0, st_k1; f32x4 sf0, sf1, sf2, sf3;
    int kbsel;
};
__device__ __forceinline__ int swa_jlo(int P0, int W) { const int lowk = P0 - W + 1; return lowk > 0 ? lowk / KVBLK : 0; }
#define ROW(p, k0, rr) ((p) + (size_t)((k0) + (rr)) * D + sc)
#define VMW() asm volatile("s_waitcnt vmcnt(0)" ::: "memory")
#define VMWN(n) asm volatile("s_waitcnt vmcnt(%0)" :: "i"(n) : "memory")
#define ROWK(p, k0, rr) ((p) + (size_t)((k0) + (rr)) * KP + sc)
#define ROWV(p, k0, rr) ((p) + (size_t)((k0) + (rr)) * VP + sc)
#define SLOAD_H(Kp, Vp, k0) do { S.st_v0 = load8<TIn>(ROWV(Vp, k0, sr)); S.st_v1 = load8<TIn>(ROWV(Vp, k0, 32 + sr));              \
                         S.st_k0 = load8<TIn>(ROWK(Kp, k0, sr)); S.st_k1 = load8<TIn>(ROWK(Kp, k0, 32 + sr)); } while (0)
#define SWRITE_HK(bf) do { *(bf16x8*)(K_lds + (bf) * SHM_K + kws) = S.st_k0; *(bf16x8*)(K_lds + (bf) * SHM_K + kws + 32 * 256) = S.st_k1; } while (0)
#define SWRITE_HV(bf) do { *(bf16x8*)(V_lds + (bf) * SHM_V + vst0) = S.st_v0; *(bf16x8*)(V_lds + (bf) * SHM_V + vst1) = S.st_v1; } while (0)
#define SWRITE_H(bf) do { SWRITE_HV(bf); SWRITE_HK(bf); } while (0)
#define SLOAD_F(p, k0) do { S.sf0 = *(const f32x4*)ROW(p, k0, sr); S.sf1 = *(const f32x4*)(ROW(p, k0, sr) + 4);                \
                            S.sf2 = *(const f32x4*)ROW(p, k0, 32 + sr); S.sf3 = *(const f32x4*)(ROW(p, k0, 32 + sr) + 4); } while (0)
#define SWRITE_KF(bf) do { *(bf16x8*)(K_lds + (bf) * SHM_K + kws) = pack8(S.sf0, S.sf1); *(bf16x8*)(K_lds + (bf) * SHM_K + kws + 32 * 256) = pack8(S.sf2, S.sf3); } while (0)
#define SWRITE_VF(bf) do { *(bf16x8*)(V_lds + (bf) * SHM_V + vst0) = pack8(S.sf0, S.sf1); *(bf16x8*)(V_lds + (bf) * SHM_V + vst1) = pack8(S.sf2, S.sf3); } while (0)
template <class TIn, class TOut, int QP, int KP, int VP>
__device__ __forceinline__ void causal_swa_prime(const BlockRef<TIn, TOut>& cur, int W, char* lds, Seam<TIn>& S) {
    constexpr bool F32 = same_t<TIn, float>::v;
    int tid = threadIdx.x; asm volatile("" : "+v"(tid));
    const int wid = __builtin_amdgcn_readfirstlane(tid >> 6), lane = tid & 63, r32 = lane & 31, hi = lane >> 5;
    const int sr = tid >> 4, sc = (tid & 15) * 8, kws = KSWZ(sr, sc * 2); char* K_lds = lds + 2 * SHM_V;
    const int kb0 = swa_jlo(cur.P0, W) * KVBLK;
    for (int d0 = 0; d0 < 8; ++d0) S.qr[d0] = load8<TIn>(cur.Q + (size_t)(wid * QBLK + r32) * QP + d0 * 16 + hi * 8);
    if constexpr (F32) { SLOAD_F((const float*)cur.K, kb0); VMW(); SWRITE_KF(0); SBAR(); SLOAD_F((const float*)cur.V, kb0); }
    else { SLOAD_H(cur.K, cur.V, kb0); VMW(); SWRITE_HK(0); }
    load_kbias(cur.CB, cur.P0, (float*)(lds + KB_OFF)); S.kbsel = 0;
    __syncthreads();
}
template <class TIn, class TOut, int QP, int KP, int VP>
__device__ __forceinline__ void causal_swa_block(const BlockRef<TIn, TOut>& cur, const BlockRef<TIn, TOut>& nxt, int skv, int W, char* lds, Seam<TIn>& S) {
    constexpr bool F32 = same_t<TIn, float>::v;
    int tid = threadIdx.x; asm volatile("" : "+v"(tid));
    const int wid = __builtin_amdgcn_readfirstlane(tid >> 6), lane = tid & 63, r32 = lane & 31, hi = lane >> 5;
    const int j_lo = swa_jlo(cur.P0, W);
    int j_hi = (cur.P0 + QB - 1) / KVBLK + 1; if (j_hi > skv / KVBLK) j_hi = skv / KVBLK;
    const int NT = j_hi - j_lo;
    const int kbn = swa_jlo(nxt.P0, W) * KVBLK;
    const int qlo = cur.P0 + wid * QBLK, qm = qlo + r32 - 4 * hi;
    char* V_lds = lds; char* K_lds = lds + 2 * SHM_V; const float* kbl = (const float*)(lds + KB_OFF) + S.kbsel * 2048;
    float* ws = (float*)(lds + 2 * SHM_V + 2 * SHM_K) + wid * 64; float* li_l = ws, * al_l = ws + 32;
    float m_reg = -1e30f, l_reg = 0; f32x16 o[4] = {};
    const int sr = tid >> 4, sc = (tid & 15) * 8, vst0 = v_st(sr, sc), vst1 = v_st(32 + sr, sc), kws = KSWZ(sr, sc * 2);
    const int vb0 = (int)(uintptr_t)V_lds + v_rd_base(lane);
    const TIn* Kh = cur.K; const TIn* Vh = cur.V;
#define RESC(a) do { if (__any((a) < 1.f)) { if (hi == 0) al_l[r32] = (a); asm volatile("s_waitcnt lgkmcnt(0)" ::: "memory");              \
                     for (int d_ = 0; d_ < 4; ++d_) for (int r = 0; r < 16; ++r) o[d_][r] *= al_l[crow(r, hi)]; } } while (0)
#define KBASE(t) ((j_lo + (t)) * KVBLK)
#define KBP(t) (kbl + KBASE(t))
#define ACT(t) (KBASE(t) <= qlo + QBLK - 1 && KBASE(t) + KVBLK - 1 >= qlo - W + 1)
#define MASKT(P0_, P1_, t) do { const int kb_ = KBASE(t); if ((!SK || ACT(t)) && (kb_ + KVBLK - 1 > qlo || kb_ <= qlo + QBLK - 1 - W)) mask_tile(P0_, P1_, qm - kb_, (unsigned)W); } while (0)
    constexpr int NQL = F32 ? 16 : 8;
    constexpr bool SK = WSKIP && !F32;
#define SEAM_K0() do { VMWN(NQL); if constexpr (F32) { SWRITE_KF(0); SBAR(); SLOAD_F((const float*)nxt.V, kbn); } else { SWRITE_HK(0); } SBAR(); } while (0)
    f32x16 pA0, pA1, pB0, pB1; float mnA, mnB, alA, alB; bf16x8 pa0, pa1, pa2, pa3;
    if constexpr (F32) { VMW(); SWRITE_VF(0); SBAR(); } else { SWRITE_HV(0); SBAR(); }
    if (NT > 1) { if constexpr (F32) SLOAD_F((const float*)Kh, KBASE(1)); else SLOAD_H(Kh, Vh, KBASE(1)); }
    SBAR(); qkt<0, SK>(pA0, pA1, K_lds, r32, hi, S.qr, ACT(0), KBP(0));
    if constexpr (F32) { if (NT > 1) { VMW(); SWRITE_KF(1); SBAR(); SLOAD_F((const float*)Vh, KBASE(1)); } }
    MASKT(pA0, pA1, 0); partialSM(pA0, pA1, m_reg, mnA, alA);
    if (NT > 1) { VMW(); if constexpr (F32) { SWRITE_VF(1); SBAR(); if (NT > 2) SLOAD_F((const float*)Kh, KBASE(2)); } else SWRITE_H(1); }
    __syncthreads();
#define HALF_STEP(PX0, PX1, mnX, alX, PY0, PY1, alY, t, KB, VB, SB) do {                                                      \
        SBAR(); qkt<KB, SK>(PX0, PX1, K_lds, r32, hi, S.qr, ACT(t), KBP(t));                                             \
        finishSM(PY0, PY1, alY, l_reg, pa0, pa1, pa2, pa3); SBAR();                                                           \
        if ((t) + 1 < NT) { if constexpr (F32) { VMW(); SWRITE_KF(SB); SBAR(); SLOAD_F((const float*)Vh, KBASE((t) + 1)); }  \
                            else { SLOAD_H(Kh, Vh, KBASE((t) + 1)); } SBAR(); }                                               \
        pv_tile<VB, SK>(o, vb0, pa0, pa1, pa2, pa3, ACT((t) - 1)); MASKT(PX0, PX1, (t)); partialSM(PX0, PX1, m_reg, mnX, alX);                                        \
        __syncthreads();                                                                                                      \
        if ((t) + 1 < NT) { VMW(); if constexpr (F32) { SWRITE_VF(SB); SBAR(); if ((t) + 2 < NT) SLOAD_F((const float*)Kh, KBASE((t) + 2)); } \
                            else { SWRITE_H(SB); } }                                                                          \
        RESC(alX); __syncthreads(); } while (0)
    for (int t = 1; t + 1 < NT; t += 2) {
        HALF_STEP(pB0, pB1, mnB, alB, pA0, pA1, alA, t, 1, 0, 0);
        HALF_STEP(pA0, pA1, mnA, alA, pB0, pB1, alB, t + 1, 0, 1, 1);
    }
    const bool even = (NT & 1) == 0;
    if (even) { SBAR(); qkt<1, SK>(pB0, pB1, K_lds, r32, hi, S.qr, ACT(NT - 1), KBP(NT - 1)); SBAR(); }
#define QROW(e) (nxt.Q + (size_t)(wid * QBLK + r32) * D + ((e) >> 1) * 16 + hi * 8 + ((e) & 1) * 4)
    if constexpr (F32) { SLOAD_F((const float*)nxt.K, kbn); SBAR();
#pragma unroll
        for (int e = 0; e < 8; ++e) (void)0; }
    else { SLOAD_H(nxt.K, nxt.V, kbn); SBAR();
#pragma unroll
        for (int d0 = 0; d0 < 8; ++d0) S.qr[d0] = load8<TIn>(nxt.Q + (size_t)(wid * QBLK + r32) * QP + d0 * 16 + hi * 8); }
    SBAR();
    finishSM(pA0, pA1, alA, l_reg, pa0, pa1, pa2, pa3); SBAR();
    if constexpr (F32) {
#pragma unroll
        for (int e = 8; e < 16; ++e) (void)0; SBAR(); }
#undef QROW
    pv_tile<0, SK>(o, vb0, pa0, pa1, pa2, pa3, ACT(even ? NT - 2 : NT - 1));
    if (even) { MASKT(pB0, pB1, NT - 1); partialSM(pB0, pB1, m_reg, mnB, alB); __syncthreads(); RESC(alB);
        finishSM(pB0, pB1, alB, l_reg, pa0, pa1, pa2, pa3); SBAR(); pv_tile<1, SK>(o, vb0, pa0, pa1, pa2, pa3, ACT(NT - 1)); }
    SBAR(); SEAM_K0();
    if (hi == 0) li_l[r32] = l_reg; asm volatile("s_waitcnt lgkmcnt(0)" ::: "memory");
    float rli[16];
#pragma unroll
    for (int r = 0; r < 16; ++r) rli[r] = __builtin_amdgcn_rcpf(li_l[crow(r, hi)]);
    TOut* Ow = cur.O + (size_t)(wid * QBLK) * QP; const TOut* SGw = cur.SG + (size_t)(wid * QBLK) * VP;
#pragma unroll
    for (int r = 0; r < 16; ++r) { const int orow = crow(r, hi);
#pragma unroll
        for (int d0 = 0; d0 < 4; ++d0) { const float v = o[d0][r] * rli[r] * __bfloat162float(SGw[(size_t)orow * VP + d0 * 32 + r32]);
            if constexpr (same_t<TOut, float>::v) { Ow[(size_t)orow * QP + d0 * 32 + r32] = v; }
            else { const float vn = __shfl_xor(v, 1);
                   if ((r32 & 1) == 0) *(unsigned*)(Ow + (size_t)orow * QP + d0 * 32 + r32) = cvtpk(v, vn); } } }
    if constexpr (F32) {
#pragma unroll
        for (int d0 = 0; d0 < 8; ++d0) (void)0; }
    load_kbias(nxt.CB, nxt.P0, (float*)(lds + KB_OFF) + (S.kbsel ^ 1) * 2048);
    __syncthreads();
    S.kbsel ^= 1;
#undef RESC
#undef KBASE
#undef KBP
#undef ACT
#undef MASKT
#undef SEAM_K0
#undef HALF_STEP
}
#undef ROW
#undef VMW
#undef VMWN
#undef SLOAD_H
#undef SWRITE_HK
#undef SWRITE_HV
#undef SWRITE_H
#undef SLOAD_F
#undef SWRITE_KF
#undef SWRITE_VF

}
#ifndef LAS
#define LAS __attribute__((address_space(3)))
#endif
#define RLX_AGENT __ATOMIC_RELAXED, __HIP_MEMORY_SCOPE_AGENT
#define XB_TMO      128
#define XB_XCNT(j)  (256  + 64 * (j))
#define XB_XSUB(j)  (1280 + 64 * (j))
#define XB_XGEN(j)  (2304 + 64 * (j))
#define XB_TOP      3328
#define XB_TOPGEN   3392
#define XCD_BAR_WORDS 3456
#define XB_SPIN_CAP (1u << 18)

__device__ __forceinline__ unsigned xb_ld(unsigned* p)              { return __hip_atomic_load(p, __ATOMIC_RELAXED, __HIP_MEMORY_SCOPE_AGENT); }
__device__ __forceinline__ unsigned xb_add(unsigned* p, unsigned v) { return __hip_atomic_fetch_add(p, v, __ATOMIC_RELAXED, __HIP_MEMORY_SCOPE_AGENT); }
__device__ __forceinline__ unsigned xb_xcc_id() { return (unsigned)__builtin_amdgcn_s_getreg((3 << 11) | 20) & 0xFu; }
#define XB_SPIN(cond, bar) do { unsigned _sp = 0; while (cond) { __builtin_amdgcn_s_sleep(1); \
    if ((++_sp & 255u) == 0u) { if (xb_ld(&(bar)[XB_TMO])) break; if (_sp > XB_SPIN_CAP) { atomicAdd(&(bar)[XB_TMO], 1u); break; } } } } while (0)

struct XcdBarrier {
    unsigned* bar; unsigned x;
    volatile LAS unsigned* st;
};

__device__ __forceinline__ XcdBarrier xcd_barrier_post(unsigned* bar, volatile LAS unsigned* st) {
    XcdBarrier b; b.bar = bar; b.x = xb_xcc_id(); b.st = st;
    if (threadIdx.x == 0) (void)xb_add(&bar[XB_XCNT(b.x)], 1u);
    return b;
}
__device__ __forceinline__ void xcd_barrier_complete(unsigned* bar, unsigned x, unsigned& nloc, unsigned& nx) {
    const unsigned G = gridDim.x * gridDim.y * gridDim.z;
    unsigned sum, cnt, mine, sp = 0u;
    for (;;) {
        sum = 0u; cnt = 0u; mine = 0u;
#pragma unroll
        for (unsigned j = 0; j < 16; ++j) { const unsigned c = xb_ld(&bar[XB_XCNT(j)]); sum += c; cnt += (c > 0u) ? 1u : 0u; mine = (j == x) ? c : mine; }
        if (sum == G) break;
        __builtin_amdgcn_s_sleep(1);
        if ((++sp & 255u) == 0u) { if (xb_ld(&bar[XB_TMO])) break; if (sp > XB_SPIN_CAP) { atomicAdd(&bar[XB_TMO], 1u); break; } }
    }
    nloc = mine > 0u ? mine : 1u; nx = cnt > 0u ? cnt : 1u;
}

__device__ __forceinline__ void xcd_barrier(const XcdBarrier& b) {
    asm volatile("s_waitcnt vmcnt(0)" ::: "memory");
    __syncthreads();
    if (threadIdx.x == 0) {
        unsigned* bar = b.bar;
        __builtin_amdgcn_s_waitcnt(0);
        unsigned nloc = b.st[0], nx = b.st[1];
        if (nloc == 0u) { xcd_barrier_complete(bar, b.x, nloc, nx); b.st[0] = nloc; b.st[1] = nx; }
        const unsigned old = xb_add(&bar[XB_XSUB(b.x)], 1u);
        const unsigned gen = old / nloc;
        if (old + 1u == (gen + 1u) * nloc) {
            __builtin_amdgcn_fence(__ATOMIC_RELEASE, "agent");
            asm volatile("s_waitcnt vmcnt(0)" ::: "memory");
            const unsigned og = xb_add(&bar[XB_TOP], 1u);
            const unsigned tg = og / nx;
            if (og + 1u == (tg + 1u) * nx) xb_add(&bar[XB_TOPGEN], 1u);
            else XB_SPIN(xb_ld(&bar[XB_TOPGEN]) == tg, bar);
            __builtin_amdgcn_fence(__ATOMIC_ACQUIRE, "agent");
            xb_add(&bar[XB_XGEN(b.x)], 1u);
            asm volatile("s_waitcnt vmcnt(0)" ::: "memory");
        } else {
            XB_SPIN(xb_ld(&bar[XB_XGEN(b.x)]) == gen, bar);
            __builtin_amdgcn_fence(__ATOMIC_ACQUIRE, "agent");
            asm volatile("s_waitcnt vmcnt(0)" ::: "memory");
        }
    }
    __syncthreads();
}
#ifndef LAS
#define LAS __attribute__((address_space(3)))
#endif
typedef unsigned short bf16_t;
typedef float f32x4 __attribute__((ext_vector_type(4)));
typedef float f32x2 __attribute__((ext_vector_type(2)));
typedef unsigned u32x4 __attribute__((ext_vector_type(4)));
typedef unsigned u32x2 __attribute__((ext_vector_type(2)));
constexpr int DM = 2048, NB = 4, SEQ = 2048, MT = NB * SEQ;
constexpr int DFF = 5632, NMOD = 12288;
constexpr int NBF = 8192, NF32 = 3584, NPROJ = NBF + NF32;
constexpr int PBP = NBF + 64;
constexpr float ALPHA = 1.189207115002721f, LN_EPS = 1e-5f, RMS_EPS = 1e-6f, LNX_EPS = 64e-5f;
constexpr size_t MiB = 1u << 20;
constexpr size_t WS_MOD = 0, WS_CUM = 1 * MiB, WS_PART = 2 * MiB, WS_BAR = 5 * MiB, WS_SLOT = 6 * MiB;
constexpr size_t WS_WOUT = 8 * MiB, WS_WA = 16 * MiB, WS_WB = 20 * MiB, WS_WLORA = 24 * MiB;
constexpr size_t WS_WIN = 28 * MiB;
constexpr size_t WS_ACAT = 60 * MiB, WS_ACAT2 = 363 * MiB, WS_MERGED = 235 * MiB;
constexpr int KSP = PBP / 2;
constexpr size_t WS_XN = 74 * MiB;
constexpr size_t WS_QN = 74 * MiB, WS_KN = 90 * MiB;
constexpr size_t WS_PBF = 106 * MiB;
constexpr size_t WS_PRW = 235 * MiB, WS_LF = 291 * MiB;
constexpr size_t WS_PF32 = 235 * MiB;
constexpr size_t WS_G = 347 * MiB, WS_YRAW = 299 * MiB, WS_WGU = 28 * MiB;
constexpr size_t WS_KK = 347 * MiB;
constexpr size_t WS_O = 379 * MiB;
constexpr size_t WS_WDOWN = 395 * MiB;
constexpr size_t WS_END = 417 * MiB;
constexpr int LDS_BYTES = 131072 + 64;

struct Params { const float* in[28]; float* out; unsigned char* ws; };

__device__ __forceinline__ unsigned f2bf(float f) { unsigned u = __builtin_bit_cast(unsigned, f); return (u + 0x7fffu + ((u >> 16) & 1u)) >> 16; }
__device__ __forceinline__ unsigned pk2(float lo, float hi) { return pg8::cvt_pk_bf16(lo, hi); }
__device__ __forceinline__ float bflo(unsigned w) { return __builtin_bit_cast(float, w << 16); }
__device__ __forceinline__ float bfhi(unsigned w) { return __builtin_bit_cast(float, w & 0xffff0000u); }
__device__ __forceinline__ f32x4 ld4bf(const bf16_t* p) { const u32x2 w = *(const u32x2*)p; return (f32x4){bflo(w.x), bfhi(w.x), bflo(w.y), bfhi(w.y)}; }
__device__ __forceinline__ float sigm(float x) { return __builtin_amdgcn_rcpf(1.f + __builtin_amdgcn_exp2f(-1.4426950408889634f * x)); }
__device__ __forceinline__ float wave_sum(float v) {
#pragma unroll
    for (int o = 1; o < 64; o <<= 1) v += __shfl_xor(v, o);
    return v;
}
template <int CTRL> __device__ __forceinline__ float dppf(float x) { return __builtin_bit_cast(float, __builtin_amdgcn_mov_dpp(__builtin_bit_cast(int, x), CTRL, 0xf, 0xf, true)); }
__device__ __forceinline__ float rowsum16(float v) { v += dppf<0xB1>(v); v += dppf<0x4E>(v); v += dppf<0x141>(v); v += dppf<0x128>(v); return v; }
#define LDS_WAIT() asm volatile("s_waitcnt lgkmcnt(0)" ::: "memory")

namespace pg8 {
__device__ __forceinline__ f32x4 sig4(f32x4 v) { f32x4 r; r[0] = sigm(v[0]); r[1] = sigm(v[1]); r[2] = sigm(v[2]); r[3] = sigm(v[3]); return r; }
__device__ __forceinline__ u32x4 pack8(f32x4 a, f32x4 b) { u32x4 w; w.x = cvt_pk_bf16(a[0], a[1]); w.y = cvt_pk_bf16(a[2], a[3]); w.z = cvt_pk_bf16(b[0], b[1]); w.w = cvt_pk_bf16(b[2], b[3]); return w; }
struct EpiProjBf { static constexpr bool PERM = true, AFTER_DRAIN = false; bf16_t* O;
    __device__ __forceinline__ void operator()(const f32x4 (&acc)[2][2][4][2], const Unit& u, int wr, int wc, int fr, int fq) const {
        const int row0 = u.pm * BM + wr * 64 + fr, col0 = u.pn * BM + wc * 32 + 8 * fq; const bool sg = u.pn >= 12;
#pragma unroll
        for (int ai = 0; ai < 2; ++ai)
#pragma unroll
            for (int m = 0; m < 4; ++m) { bf16_t* rowp = O + (size_t)(row0 + ai * HALF + m * 16) * PBP + col0;
#pragma unroll
                for (int bj = 0; bj < 2; ++bj) { f32x4 v0 = acc[ai][bj][m][0], v1 = acc[ai][bj][m][1];
                    if (sg) { v0 = sig4(v0); v1 = sig4(v1); }
                    *(u32x4*)(rowp + bj * HALF) = pack8(v0, v1); } }
    }
};
struct EpiF32 { static constexpr bool PERM = false, AFTER_DRAIN = false; float* O; int ldc;
    __device__ __forceinline__ void operator()(const f32x4 (&acc)[2][2][4][2], const Unit& u, int wr, int wc, int fr, int fq) const {
        const int row0 = u.pm * BM + wr * 64 + fr, col0 = u.pn * BM + wc * 32 + 4 * fq;
#pragma unroll
        for (int ai = 0; ai < 2; ++ai)
#pragma unroll
            for (int m = 0; m < 4; ++m) { float* rowp = O + (size_t)(row0 + ai * HALF + m * 16) * ldc + col0;
#pragma unroll
                for (int bj = 0; bj < 2; ++bj)
#pragma unroll
                    for (int n = 0; n < 2; ++n) *(f32x4*)(rowp + bj * HALF + n * 16) = acc[ai][bj][m][n]; }
    }
};
struct EpiRw { static constexpr bool PERM = false, AFTER_DRAIN = false; bf16_t* O; float* LF;
    __device__ __forceinline__ void operator()(const f32x4 (&acc)[2][2][4][2], const Unit& u, int wr, int wc, int fr, int fq) const {
        const int row0 = u.pm * BM + wr * 64 + fr, colt = wc * 32 + 4 * fq, col0 = u.pn * BM + colt; const bool last = u.pn == 13;
#pragma unroll
        for (int ai = 0; ai < 2; ++ai)
#pragma unroll
            for (int m = 0; m < 4; ++m) { const size_t row = (size_t)(row0 + ai * HALF + m * 16);
#pragma unroll
                for (int bj = 0; bj < 2; ++bj)
#pragma unroll
                    for (int n = 0; n < 2; ++n) { const f32x4 v = acc[ai][bj][m][n]; u32x2 w; w.x = cvt_pk_bf16(v[0], v[1]); w.y = cvt_pk_bf16(v[2], v[3]);
                        *(u32x2*)(O + row * NF32 + col0 + bj * HALF + n * 16) = w;
                        if (last) *(f32x4*)(LF + row * 256 + colt + bj * HALF + n * 16) = v; } }
    }
};
struct EpiLora { static constexpr bool PERM = false, AFTER_DRAIN = false;
    const float* w0; const float* a0; float* WD; float* AA; bf16_t* G; int pn0;
    __device__ __forceinline__ void operator()(const f32x4 (&acc)[2][2][4][2], const Unit& u, int wr, int wc, int fr, int fq) const {
        const int pnq = u.pn + pn0, sel = pnq >> 2; int row0 = u.pm * BM + wr * 64 + fr, cb = (pnq & 3) * BM + wc * 32 + 4 * fq;
        asm volatile("" : "+v"(row0), "+v"(cb));
#pragma unroll
        for (int bj = 0; bj < 2; ++bj)
#pragma unroll
            for (int n = 0; n < 2; ++n) { const int c = cb + bj * HALF + n * 16;
                if (sel == 0) { const f32x4 wv = *(const f32x4*)(w0 + c);
#pragma unroll
                    for (int ai = 0; ai < 2; ++ai)
#pragma unroll
                        for (int m = 0; m < 4; ++m) { const size_t off = (size_t)(row0 + ai * HALF + m * 16) * 1024 + c; f32x4 o;
#pragma unroll
                            for (int i = 0; i < 4; ++i) { const float x = wv[i] + acc[ai][bj][m][n][i];
                                const float wraw = fminf(x, 0.f) - __logf(1.f + __expf(-fabsf(x))) - 0.5f; o[i] = __expf(-__expf(wraw)); }
                            *(f32x4*)(WD + off) = o; }
                } else if (sel == 1) { const f32x4 av = *(const f32x4*)(a0 + c);
#pragma unroll
                    for (int ai = 0; ai < 2; ++ai)
#pragma unroll
                        for (int m = 0; m < 4; ++m) { const size_t off = (size_t)(row0 + ai * HALF + m * 16) * 1024 + c; f32x4 oa;
#pragma unroll
                            for (int i = 0; i < 4; ++i) oa[i] = sigm(av[i] + acc[ai][bj][m][n][i]);
                            *(f32x4*)(AA + off) = oa; }
                } else {
#pragma unroll
                    for (int ai = 0; ai < 2; ++ai)
#pragma unroll
                        for (int m = 0; m < 4; ++m) { const size_t off = (size_t)(row0 + ai * HALF + m * 16) * 1024 + c; const f32x4 v = acc[ai][bj][m][n];
                            u32x2 w; w.x = cvt_pk_bf16(v[0], v[1]); w.y = cvt_pk_bf16(v[2], v[3]); *(u32x2*)(G + off) = w; }
                } }
    }
};
template <int PASS> struct EpiMerge { static constexpr bool PERM = true, AFTER_DRAIN = false; const bf16_t* SG; float* TMP; bf16_t* MG;
    __device__ __forceinline__ void operator()(const f32x4 (&acc)[2][2][4][2], const Unit& u, int wr, int wc, int fr, int fq) const {
        const int row0 = u.pm * BM + wr * 64 + fr, col0 = u.pn * BM + wc * 32 + 8 * fq;
#pragma unroll
        for (int ai = 0; ai < 2; ++ai)
#pragma unroll
            for (int m = 0; m < 4; ++m) { const int row = row0 + ai * HALF + m * 16;
#pragma unroll
                for (int bj = 0; bj < 2; ++bj) { const int c = col0 + bj * HALF; const u32x4 s = *(const u32x4*)(SG + (size_t)row * PBP + c);
                    f32x4 v0 = acc[ai][bj][m][0], v1 = acc[ai][bj][m][1];
                    v0 = v0 * (f32x4){bflo(s.x), bfhi(s.x), bflo(s.y), bfhi(s.y)}; v1 = v1 * (f32x4){bflo(s.z), bfhi(s.z), bflo(s.w), bfhi(s.w)};
                    float* tp = TMP + (size_t)row * DM + c;
                    if (PASS == 1) { *(f32x4*)tp = v0; *(f32x4*)(tp + 4) = v1; }
                    else { v0 = v0 + *(const f32x4*)tp; v1 = v1 + *(const f32x4*)(tp + 4); *(u32x4*)(MG + (size_t)row * DM + c) = pack8(v0, v1); } } }
    }
};
struct EpiMergeDual { static constexpr bool PERM = true, AFTER_DRAIN = false; const bf16_t* SGA; const bf16_t* SGB; bf16_t* MG;
    __device__ __forceinline__ void mid(f32x4 (&acc)[2][2][4][2], const Unit& u, int wr, int wc, int fr, int fq) const {
        int row0 = u.pm * BM + wr * 64 + fr, col0 = u.pn * BM + wc * 32 + 8 * fq;
        asm volatile("" : "+v"(row0), "+v"(col0));
#pragma unroll
        for (int ai = 0; ai < 2; ++ai)
#pragma unroll
            for (int m = 0; m < 4; ++m) { const size_t ro = (size_t)(row0 + ai * HALF + m * 16) * PBP;
#pragma unroll
                for (int bj = 0; bj < 2; ++bj) { const int c = col0 + bj * HALF; const u32x4 a = *(const u32x4*)(SGA + ro + c), b = *(const u32x4*)(SGB + ro + c);
#define MRG_R(x, y) ((x) * __builtin_amdgcn_rcpf(fmaxf((y), 1e-20f)))
                    acc[ai][bj][m][0] = acc[ai][bj][m][0] * (f32x4){MRG_R(bflo(a.x), bflo(b.x)), MRG_R(bfhi(a.x), bfhi(b.x)), MRG_R(bflo(a.y), bflo(b.y)), MRG_R(bfhi(a.y), bfhi(b.y))};
                    acc[ai][bj][m][1] = acc[ai][bj][m][1] * (f32x4){MRG_R(bflo(a.z), bflo(b.z)), MRG_R(bfhi(a.z), bfhi(b.z)), MRG_R(bflo(a.w), bflo(b.w)), MRG_R(bfhi(a.w), bfhi(b.w))};
#undef MRG_R
                }
                asm volatile("" ::: "memory"); }
    }
    __device__ __forceinline__ void operator()(const f32x4 (&acc)[2][2][4][2], const Unit& u, int wr, int wc, int fr, int fq) const {
        const int row0 = u.pm * BM + wr * 64 + fr, col0 = u.pn * BM + wc * 32 + 8 * fq;
#pragma unroll
        for (int ai = 0; ai < 2; ++ai)
#pragma unroll
            for (int m = 0; m < 4; ++m) { const int row = row0 + ai * HALF + m * 16;
#pragma unroll
                for (int bj = 0; bj < 2; ++bj) { const int c = col0 + bj * HALF; const u32x4 s = *(const u32x4*)(SGB + (size_t)row * PBP + c);
                    const f32x4 v0 = acc[ai][bj][m][0] * (f32x4){bflo(s.x), bfhi(s.x), bflo(s.y), bfhi(s.y)}, v1 = acc[ai][bj][m][1] * (f32x4){bflo(s.z), bfhi(s.z), bflo(s.w), bfhi(s.w)};
                    *(u32x4*)(MG + (size_t)row * DM + c) = pack8(v0, v1); } }
    }
};
struct EpiRes { static constexpr bool PERM = false, AFTER_DRAIN = false; const float* X; float* OUT; const float* gate;
    __device__ __forceinline__ void operator()(const f32x4 (&acc)[2][2][4][2], const Unit& u, int wr, int wc, int fr, int fq) const {
        const int row0 = u.pm * BM + wr * 64 + fr, col0 = u.pn * BM + wc * 32 + 4 * fq; const float* gp = gate + (size_t)(u.pm >> 3) * NMOD;
#pragma unroll
        for (int bj = 0; bj < 2; ++bj)
#pragma unroll
            for (int n = 0; n < 2; ++n) { const int c = col0 + bj * HALF + n * 16; const f32x4 gv = *(const f32x4*)(gp + c);
#pragma unroll
                for (int ai = 0; ai < 2; ++ai)
#pragma unroll
                    for (int m = 0; m < 4; ++m) { const size_t off = (size_t)(row0 + ai * HALF + m * 16) * DM + c;
                        const f32x4 xv = *(const f32x4*)(X + off); *(f32x4*)(OUT + off) = xv * ALPHA + gv * acc[ai][bj][m][n]; } }
    }
};
struct EpiSwiGLU { static constexpr bool PERM = true, AFTER_DRAIN = false; bf16_t* ACT;
    __device__ __forceinline__ void operator()(const f32x4 (&acc)[2][2][4][2], const Unit& u, int wr, int wc, int fr, int fq) const {
        const int row0 = u.pm * BM + wr * 64 + fr, col0 = u.pn * HALF + wc * 32 + 8 * fq;
#pragma unroll
        for (int ai = 0; ai < 2; ++ai)
#pragma unroll
            for (int m = 0; m < 4; ++m) { const f32x4 g0 = acc[ai][0][m][0], g1 = acc[ai][0][m][1], u0 = acc[ai][1][m][0], u1 = acc[ai][1][m][1];
                const f32x4 a0 = g0 * sig4(g0) * u0, a1 = g1 * sig4(g1) * u1;
                *(u32x4*)(ACT + (size_t)(row0 + ai * HALF + m * 16) * DFF + col0) = pack8(a0, a1); }
    }
};

__device__ __forceinline__ void row_stats_exchange(const f32x4 (&v)[2][2][4][2], const Unit& u, int wr, int wc, int fr, int fq, PG8_LAS unsigned char* lds, int wid, int lane, float* slots, const XcdBarrier& bar) {
    PG8_LAS f32x2* P = (PG8_LAS f32x2*)lds; PG8_LAS f32x2* S = (PG8_LAS f32x2*)(lds + 8192);
#pragma unroll
    for (int ai = 0; ai < 2; ++ai)
#pragma unroll
        for (int m = 0; m < 4; ++m) {
            float s = 0.f;
#pragma unroll
            for (int bj = 0; bj < 2; ++bj)
#pragma unroll
                for (int n = 0; n < 2; ++n) { const f32x4 x = v[ai][bj][m][n]; s += (x[0] + x[1]) + (x[2] + x[3]); }
            s += __shfl_xor(s, 16); s += __shfl_xor(s, 32);
            const float mw = s * (1.0f / 64.0f); float q = 0.f;
#pragma unroll
            for (int bj = 0; bj < 2; ++bj)
#pragma unroll
                for (int n = 0; n < 2; ++n) { const f32x4 d = v[ai][bj][m][n] - mw; q += (d[0] * d[0] + d[1] * d[1]) + (d[2] * d[2] + d[3] * d[3]); }
            q += __shfl_xor(q, 16); q += __shfl_xor(q, 32);
            if (fq == 0) P[(ai * HALF + wr * 64 + m * 16 + fr) * 4 + wc] = (f32x2){mw, q};
        }
    asm volatile("s_waitcnt lgkmcnt(0)" ::: "memory"); __builtin_amdgcn_s_barrier(); asm volatile("" ::: "memory");
    const int row = wid * 32 + (lane & 31);
    if (lane < 32) {
        const f32x2 a = P[row * 4 + 0], b = P[row * 4 + 1], c = P[row * 4 + 2], d = P[row * 4 + 3];
        const float mt = (a[0] + b[0] + c[0] + d[0]) * 0.25f;
        const float da = a[0] - mt, db = b[0] - mt, dc = c[0] - mt, dd = d[0] - mt;
        const float m2 = (a[1] + b[1]) + (c[1] + d[1]) + 64.0f * ((da * da + db * db) + (dc * dc + dd * dd));
        *(f32x2*)(slots + ((size_t)(u.pm * BM + row) * 8 + u.pn) * 2) = (f32x2){mt, m2};
    }
    xcd_barrier(bar);
    if (lane < 32) {
        const float* sp = slots + (size_t)(u.pm * BM + row) * 16; float mt[8], m2[8]; float ms = 0.f;
#pragma unroll
        for (int t = 0; t < 8; ++t) { const f32x2 w = *(const f32x2*)(sp + 2 * t); mt[t] = w[0]; m2[t] = w[1]; ms += w[0]; }
        const float mean = ms * 0.125f; float q = 0.f;
#pragma unroll
        for (int t = 0; t < 8; ++t) { const float dm = mt[t] - mean; q += m2[t] + 256.0f * dm * dm; }
        S[row] = (f32x2){mean, __builtin_amdgcn_rsqf(q * (1.0f / 2048.0f) + LN_EPS)};
    }
    asm volatile("s_waitcnt lgkmcnt(0)" ::: "memory"); __builtin_amdgcn_s_barrier(); asm volatile("" ::: "memory");
}
#define LNF_PIN(ai, m) asm volatile("" : "+v"(acc[ai][0][m][0]), "+v"(acc[ai][0][m][1]), "+v"(acc[ai][1][m][0]), "+v"(acc[ai][1][m][1]))
#define LNF_RESID(Xp, gvv) do { _Pragma("unroll") for (int ai = 0; ai < 2; ++ai) _Pragma("unroll") for (int m = 0; m < 4; ++m) { const float* rp_ = (Xp) + (size_t)(row0 + ai * HALF + m * 16) * DM + col0; \
        _Pragma("unroll") for (int bj = 0; bj < 2; ++bj) _Pragma("unroll") for (int n = 0; n < 2; ++n) acc[ai][bj][m][n] = *(const f32x4*)(rp_ + bj * HALF + n * 16) * ALPHA + gvv[bj][n] * acc[ai][bj][m][n]; \
        LNF_PIN(ai, m); if (m & 1) asm volatile("" ::: "memory"); } } while (0)
struct EpiResLn { static constexpr bool PERM = false, AFTER_DRAIN = true; const float* X; float* OUT; const float* gate; const float* lg; const float* lb; float* slots; const XcdBarrier* bar;
    __device__ __forceinline__ void operator()(const f32x4 (&)[2][2][4][2], const Unit&, int, int, int, int) const {}
    __device__ __forceinline__ void fused(f32x4 (&acc)[2][2][4][2], const Unit& u, int wr, int wc, int fr, int fq, PG8_LAS unsigned char* lds, int wid, int lane) const {
        const PG8_LAS f32x2* S = (const PG8_LAS f32x2*)(lds + 8192);
        const int row0 = u.pm * BM + wr * 64 + fr, col0 = u.pn * BM + wc * 32 + 4 * fq; const float* gp = gate + (size_t)(u.pm >> 3) * NMOD + col0;
        { f32x4 gv[2][2];
#pragma unroll
          for (int bj = 0; bj < 2; ++bj)
#pragma unroll
              for (int n = 0; n < 2; ++n) gv[bj][n] = *(const f32x4*)(gp + bj * HALF + n * 16);
          LNF_RESID(X, gv); }
        row_stats_exchange(acc, u, wr, wc, fr, fq, lds, wid, lane, slots, *bar);
        f32x4 g4[2][2], b4[2][2];
#pragma unroll
        for (int bj = 0; bj < 2; ++bj)
#pragma unroll
            for (int n = 0; n < 2; ++n) { g4[bj][n] = *(const f32x4*)(lg + col0 + bj * HALF + n * 16); b4[bj][n] = *(const f32x4*)(lb + col0 + bj * HALF + n * 16); }
#pragma unroll
        for (int ai = 0; ai < 2; ++ai)
#pragma unroll
            for (int m = 0; m < 4; ++m) { const int r = ai * HALF + wr * 64 + m * 16 + fr; const f32x2 sr = S[r]; float* op = OUT + (size_t)(u.pm * BM + r) * DM + col0;
#pragma unroll
                for (int bj = 0; bj < 2; ++bj)
#pragma unroll
                    for (int n = 0; n < 2; ++n) *(f32x4*)(op + bj * HALF + n * 16) = (acc[ai][bj][m][n] - sr[0]) * sr[1] * g4[bj][n] + b4[bj][n];
                if (m & 1) asm volatile("" ::: "memory"); }
    }
};
struct EpiResLnLn { static constexpr bool PERM = false, AFTER_DRAIN = true; const float* X; float* X1; bf16_t* H2; const float* mod; const float* lg; const float* lb; float* slots1; float* slots2; const XcdBarrier* bar;
    __device__ __forceinline__ void operator()(const f32x4 (&)[2][2][4][2], const Unit&, int, int, int, int) const {}
    __device__ __forceinline__ void fused(f32x4 (&acc)[2][2][4][2], const Unit& u, int wr, int wc, int fr, int fq, PG8_LAS unsigned char* lds, int wid, int lane) const {
        const PG8_LAS f32x2* S = (const PG8_LAS f32x2*)(lds + 8192);
        const int row0 = u.pm * BM + wr * 64 + fr, col0 = u.pn * BM + wc * 32 + 4 * fq; const float* mb = mod + (size_t)(u.pm >> 3) * NMOD + col0;
        { f32x4 gv[2][2];
#pragma unroll
          for (int bj = 0; bj < 2; ++bj)
#pragma unroll
              for (int n = 0; n < 2; ++n) gv[bj][n] = *(const f32x4*)(mb + 2 * DM + bj * HALF + n * 16);
          LNF_RESID(X, gv); }
        row_stats_exchange(acc, u, wr, wc, fr, fq, lds, wid, lane, slots1, *bar);
        { f32x4 g4[2][2], b4[2][2];
#pragma unroll
          for (int bj = 0; bj < 2; ++bj)
#pragma unroll
              for (int n = 0; n < 2; ++n) { g4[bj][n] = *(const f32x4*)(lg + col0 + bj * HALF + n * 16); b4[bj][n] = *(const f32x4*)(lb + col0 + bj * HALF + n * 16); }
#pragma unroll
          for (int ai = 0; ai < 2; ++ai)
#pragma unroll
              for (int m = 0; m < 4; ++m) { const int r = ai * HALF + wr * 64 + m * 16 + fr; const f32x2 sr = S[r]; float* op = X1 + (size_t)(u.pm * BM + r) * DM + col0;
#pragma unroll
                  for (int bj = 0; bj < 2; ++bj)
#pragma unroll
                      for (int n = 0; n < 2; ++n) { const f32x4 x1 = (acc[ai][bj][m][n] - sr[0]) * sr[1] * g4[bj][n] + b4[bj][n]; acc[ai][bj][m][n] = x1; *(f32x4*)(op + bj * HALF + n * 16) = x1; }
                  LNF_PIN(ai, m); if (m & 1) asm volatile("" ::: "memory"); } }
        row_stats_exchange(acc, u, wr, wc, fr, fq, lds, wid, lane, slots2, *bar);
        f32x4 sh[2][2], sc[2][2];
#pragma unroll
        for (int bj = 0; bj < 2; ++bj)
#pragma unroll
            for (int n = 0; n < 2; ++n) { sh[bj][n] = *(const f32x4*)(mb + 3 * DM + bj * HALF + n * 16); sc[bj][n] = *(const f32x4*)(mb + 4 * DM + bj * HALF + n * 16) + 1.f; }
#pragma unroll
        for (int ai = 0; ai < 2; ++ai)
#pragma unroll
            for (int m = 0; m < 4; ++m) { const int r = ai * HALF + wr * 64 + m * 16 + fr; const f32x2 sr = S[r]; bf16_t* op = H2 + (size_t)(u.pm * BM + r) * DM + col0;
#pragma unroll
                for (int bj = 0; bj < 2; ++bj)
#pragma unroll
                    for (int n = 0; n < 2; ++n) { const f32x4 o = (acc[ai][bj][m][n] - sr[0]) * sr[1] * sc[bj][n] + sh[bj][n]; u32x2 w; w.x = cvt_pk_bf16(o[0], o[1]); w.y = cvt_pk_bf16(o[2], o[3]);
                        *(u32x2*)(op + bj * HALF + n * 16) = w; }
                if (m & 1) asm volatile("" ::: "memory"); }
    }
};
}
__device__ __forceinline__ int q_pop(unsigned* ctr, int lane) { unsigned v = 0u; if (lane == 0) v = __hip_atomic_fetch_add(ctr, 1u, __ATOMIC_RELAXED, __HIP_MEMORY_SCOPE_AGENT); return (int)__builtin_amdgcn_readfirstlane(v); }
struct MapId { __device__ __forceinline__ int operator()(int n) const { return n; } };
struct MapWin { __device__ __forceinline__ int operator()(int n) const {
    return n < 4096 ? n : n < 8192 ? 7624 + (n - 4096) : n < 11712 ? 4104 + (n - 8192) : n < 11720 ? 4096 + (n - 11712) : -1; } };
struct MapGu { __device__ __forceinline__ int operator()(int n) const { const int pn = n >> 8, j = n & 255; return j < 128 ? 128 * pn + j : DFF + 128 * pn + (j - 128); } };
template <class Map>
__device__ __forceinline__ void transpose_item(const float* W, int ldw, bf16_t* WT, int Kd, int kb, int nb, LAS float* scr, int lane, Map map) {
    const int k0 = 64 * kb, n0 = 32 * nb; const int src = map(n0 + (lane & 31));
    const float* wp = W + (size_t)(k0 + (lane >> 5)) * ldw + (src >= 0 ? src : 0);
    float tv[32];
#pragma unroll
    for (int i = 0; i < 32; ++i) tv[i] = src >= 0 ? __builtin_nontemporal_load(wp + (size_t)(2 * i) * ldw) : 0.f;
#pragma unroll
    for (int i = 0; i < 32; ++i) scr[(2 * i + (lane >> 5)) * 33 + (lane & 31)] = tv[i];
    LDS_WAIT();
    const int c = lane & 7;
#pragma unroll
    for (int j = 0; j < 4; ++j) { const int n = (lane >> 3) + 8 * j; const LAS float* s = scr + (8 * c) * 33 + n;
        u32x4 o; o.x = pk2(s[0 * 33], s[1 * 33]); o.y = pk2(s[2 * 33], s[3 * 33]); o.z = pk2(s[4 * 33], s[5 * 33]); o.w = pk2(s[6 * 33], s[7 * 33]);
        *(u32x4*)(WT + (size_t)(n0 + n) * Kd + k0 + 8 * c) = o; }
    LDS_WAIT();
}
template <class Map>
__device__ __forceinline__ void transpose_item2(const float* W, int ldw, bf16_t* WT, int Kd, int kb, int nb, LAS float* scrf, int lane, Map map) {
    LAS unsigned* scr = (LAS unsigned*)scrf;
    const int k0 = 64 * kb, n0 = 64 * nb, half = lane >> 5, c2 = lane & 31; const int src = map(n0 + 2 * c2);
    const float* wp = W + (size_t)(k0 + 32 * half) * ldw + (src >= 0 ? src : 0);
    f32x2 tv[32];
#pragma unroll
    for (int i = 0; i < 32; ++i) tv[i] = src >= 0 ? __builtin_nontemporal_load((const f32x2*)(wp + (size_t)i * ldw)) : (f32x2){0.f, 0.f};
    LAS unsigned* w0 = scr + (2 * c2) * 33 + 16 * half;
#pragma unroll
    for (int j = 0; j < 16; ++j) { w0[j] = pk2(tv[2 * j][0], tv[2 * j + 1][0]); w0[33 + j] = pk2(tv[2 * j][1], tv[2 * j + 1][1]); }
    LDS_WAIT();
    const int c = lane & 7;
#pragma unroll
    for (int j = 0; j < 8; ++j) { const int n = (lane >> 3) + 8 * j; const LAS unsigned* sp = scr + n * 33 + 4 * c;
        u32x4 o; o.x = sp[0]; o.y = sp[1]; o.z = sp[2]; o.w = sp[3];
        *(u32x4*)(WT + (size_t)(n0 + n) * Kd + k0 + 8 * c) = o; }
    LDS_WAIT();
}
__device__ __forceinline__ void ln_stats(const f32x4 (&v)[8], float& mean, float& rstd) {
    float s = 0.f;
#pragma unroll
    for (int j = 0; j < 8; ++j) s += (v[j][0] + v[j][1]) + (v[j][2] + v[j][3]);
    mean = wave_sum(s) * (1.f / DM); float q = 0.f;
#pragma unroll
    for (int j = 0; j < 8; ++j) { const f32x4 d = v[j] - mean; q += (d[0] * d[0] + d[1] * d[1]) + (d[2] * d[2] + d[3] * d[3]); }
    rstd = __builtin_amdgcn_rsqf(wave_sum(q) * (1.f / DM) + LN_EPS);
}

__device__ __forceinline__ void prep_row(const Params& p, int t, int lane) {
    unsigned char* ws = p.ws;
    const bf16_t* PBF = (const bf16_t*)(ws + WS_PBF) + (size_t)t * PBP;
    bf16_t* QN = (bf16_t*)(ws + WS_QN) + (size_t)t * 1024; bf16_t* KN = (bf16_t*)(ws + WS_KN) + (size_t)t * 1024;
    u32x4 qk4[4];
#pragma unroll
    for (int ps = 0; ps < 4; ++ps) qk4[ps] = *(const u32x4*)(PBF + (ps >> 1) * 1024 + (ps & 1) * 512 + lane * 8);
#pragma unroll
    for (int ps = 0; ps < 4; ++ps) {
        const int isk = ps >> 1, c = (ps & 1) * 512 + lane * 8;
        const u32x4 w = qk4[ps];
        float x[8] = {bflo(w.x), bfhi(w.x), bflo(w.y), bfhi(w.y), bflo(w.z), bfhi(w.z), bflo(w.w), bfhi(w.w)};
        float ss = 0.f;
#pragma unroll
        for (int i = 0; i < 8; ++i) ss += x[i] * x[i];
        ss = rowsum16(ss);
        const float rs = __builtin_amdgcn_rsqf(ss * (1.f / 128.f) + RMS_EPS);
        const float* gp = (isk ? p.in[7] : p.in[6]) + (c & 127);
        const f32x4 g0 = *(const f32x4*)gp, g1 = *(const f32x4*)(gp + 4);
        u32x4 o; o.x = pk2(x[0] * rs * g0[0], x[1] * rs * g0[1]); o.y = pk2(x[2] * rs * g0[2], x[3] * rs * g0[3]);
        o.z = pk2(x[4] * rs * g1[0], x[5] * rs * g1[1]); o.w = pk2(x[6] * rs * g1[2], x[7] * rs * g1[3]);
        *(u32x4*)((isk ? KN : QN) + c) = o;
    }
    const bf16_t* cur = (const bf16_t*)(ws + WS_PRW) + (size_t)t * NF32; const bf16_t* prv = cur - NF32;
    const bool first = (t & (SEQ - 1)) == 0; const float* mu = p.in[8];
#define SHIFTED(col) ({ const f32x4 c_ = ld4bf(cur + (col)); const f32x4 p_ = first ? (f32x4){0.f, 0.f, 0.f, 0.f} : ld4bf(prv + (col)); const f32x4 m_ = *(const f32x4*)(mu + (col)); c_ + (p_ - c_) * m_; })
    bf16_t* AC = (bf16_t*)(ws + WS_ACAT) + (size_t)t * 256; bf16_t* AC2 = (bf16_t*)(ws + WS_ACAT2) + (size_t)t * 256;
    if (lane < 32) {
        f32x4 a = {0.f, 0.f, 0.f, 0.f}, b = {0.f, 0.f, 0.f, 0.f};
        if (lane < 24) { const f32x4 xw = SHIFTED(3072 + lane * 4); b = SHIFTED(3168 + lane * 4);
#pragma unroll
            for (int i = 0; i < 4; ++i) { const float e = __expf(-2.f * fabsf(xw[i])); const float th = (1.f - e) / (1.f + e); a[i] = xw[i] < 0.f ? -th : th; } }
        u32x2 wa, wb; wa.x = pk2(a[0], a[1]); wa.y = pk2(a[2], a[3]); wb.x = pk2(b[0], b[1]); wb.y = pk2(b[2], b[3]);
        *(u32x2*)(AC + lane * 4) = wa; *(u32x2*)(AC + 128 + lane * 4) = wb; }
    { const f32x4 xg = SHIFTED(3264 + lane * 4); u32x2 w; w.x = pk2(sigm(xg[0]), sigm(xg[1])); w.y = pk2(sigm(xg[2]), sigm(xg[3])); *(u32x2*)(AC2 + lane * 4) = w; }
#undef SHIFTED
}

__device__ __forceinline__ void rwkv_job(LAS unsigned char* lds, int job, const float* mu, const float* k_k, const float* k_a, const bf16_t* PRW, const float* WD, const float* AA, float* Y, int tid, int wave, int lane) {
    const int bh = job >> 1, half = job & 1, b = bh >> 4, h = bh & 15;
    const size_t tok0 = (size_t)b * SEQ;
    constexpr int TC = 32, CHF = TC * 384, NCH = SEQ / TC;
    LAS float* buf = (LAS float*)lds;
    const int lt = tid & 255, lrow = lt >> 4, piece = lt & 15, hc = h * 64 + piece * 4;
    const size_t goff = (tok0 + lrow) * 1024 + hc;
    const bf16_t* prw0 = PRW + tok0 * NF32 + hc;
    u32x2 rb[12]; f32x4 rg[4];
    const f32x4 kkc = *(const f32x4*)(k_k + hc), kac = *(const f32x4*)(k_a + hc), mur = *(const f32x4*)(mu + hc), muk = *(const f32x4*)(mu + 1024 + hc), muv = *(const f32x4*)(mu + 2048 + hc);
#define RW_LOAD(rg, c) do { const size_t o_ = goff + (size_t)(c) * TC * 1024; _Pragma("unroll") for (int p_ = 0; p_ < 2; ++p_) { const int t_ = (c) * TC + lrow + 16 * p_, tp_ = t_ > 0 ? t_ - 1 : 0; \
        _Pragma("unroll") for (int s_ = 0; s_ < 3; ++s_) { rb[6 * p_ + 2 * s_] = *(const u32x2*)(prw0 + (size_t)t_ * NF32 + s_ * 1024); rb[6 * p_ + 2 * s_ + 1] = *(const u32x2*)(prw0 + (size_t)tp_ * NF32 + s_ * 1024); } \
        rg[p_] = *(const f32x4*)(WD + o_ + (size_t)p_ * 16 * 1024); rg[2 + p_] = *(const f32x4*)(AA + o_ + (size_t)p_ * 16 * 1024); } } while (0)
#define RW_BF4(w) ((f32x4){bflo((w).x), bfhi((w).x), bflo((w).y), bfhi((w).y)})
#define RW_WRITE(rg, c) do { _Pragma("unroll") for (int p_ = 0; p_ < 2; ++p_) { LAS float* d_ = buf + ((c) & 1) * CHF + (lrow + 16 * p_) * 384 + piece * 4; \
        const float fz_ = ((c) * TC + lrow + 16 * p_) > 0 ? 1.f : 0.f;     \
        const f32x4 rc_ = RW_BF4(rb[6 * p_]), rp_ = RW_BF4(rb[6 * p_ + 1]) * fz_, kc_ = RW_BF4(rb[6 * p_ + 2]), kp_ = RW_BF4(rb[6 * p_ + 3]) * fz_, vc_ = RW_BF4(rb[6 * p_ + 4]), vp_ = RW_BF4(rb[6 * p_ + 5]) * fz_; \
        const f32x4 ks_ = kc_ + (kp_ - kc_) * muk, a_ = rg[2 + p_]; const f32x4 kv_ = ks_ * kkc; \
        const float nn_ = rowsum16((kv_[0] * kv_[0] + kv_[1] * kv_[1]) + (kv_[2] * kv_[2] + kv_[3] * kv_[3])); const f32x4 kk_ = kv_ * __builtin_amdgcn_rsqf(fmaxf(nn_, 1e-24f));     \
        *(LAS f32x4*)(d_) = kk_; *(LAS f32x4*)(d_ + 64) = rg[p_]; *(LAS f32x4*)(d_ + 128) = kk_ * a_; *(LAS f32x4*)(d_ + 192) = ks_ * ((a_ - 1.f) * kac + 1.f); \
        *(LAS f32x4*)(d_ + 256) = rc_ + (rp_ - rc_) * mur; *(LAS f32x4*)(d_ + 320) = vc_ + (vp_ - vc_) * muv; } } while (0)
    if (wave >= 4) { RW_LOAD(rg, 0); RW_WRITE(rg, 0); RW_LOAD(rg, 1); }
    __syncthreads();
    const int rw = lane >> 3, j = lane & 7, rl = wave * 8 + rw;
    f32x2 S[4] = {{0.f, 0.f}, {0.f, 0.f}, {0.f, 0.f}, {0.f, 0.f}};
#define RW_STEP(dst, dv, st_) do { const LAS float* sp_ = cb + (st_) * 384; \
        _Pragma("unroll") for (int s_ = 0; s_ < 5; ++s_) { dst[2 * s_] = *(const LAS f32x4*)(sp_ + s_ * 64); dst[2 * s_ + 1] = *(const LAS f32x4*)(sp_ + s_ * 64 + 4); } \
        dv = vb[(st_) * 384]; } while (0)
    for (int c = 0; c < NCH; ++c) {
        if (wave >= 4) { if (c + 1 < NCH) { RW_WRITE(rg, c + 1); if (c + 2 < NCH) RW_LOAD(rg, c + 2); } }
        else {
            const LAS float* cb = buf + (c & 1) * CHF + 8 * j;
            const LAS float* vb = buf + (c & 1) * CHF + 320 + half * 32 + rl;
            float* yp = Y + (tok0 + (size_t)c * TC) * 1024 + h * 64 + half * 32 + rl;
            f32x4 q[10]; float vv;
            RW_STEP(q, vv, 0);
#pragma unroll 8
            for (int st = 0; st < TC; ++st) {
                f32x4 n[10]; float nv; const int ns = st + 1 < TC ? st + 1 : st;
                RW_STEP(n, nv, ns);
                f32x2 ta = S[0] * q[0].lo, tb = S[1] * q[0].hi; ta = S[2] * q[1].lo + ta; tb = S[3] * q[1].hi + tb; ta = ta + tb;
                float d = ta[0] + ta[1];
                d += dppf<0xB1>(d); d += dppf<0x4E>(d); d += dppf<0x141>(d);
                S[0] = S[0] * q[2].lo - q[4].lo * d + q[6].lo * vv;
                S[1] = S[1] * q[2].hi - q[4].hi * d + q[6].hi * vv;
                S[2] = S[2] * q[3].lo - q[5].lo * d + q[7].lo * vv;
                S[3] = S[3] * q[3].hi - q[5].hi * d + q[7].hi * vv;
                f32x2 ua = S[0] * q[8].lo, ub = S[1] * q[8].hi; ua = S[2] * q[9].lo + ua; ub = S[3] * q[9].hi + ub; ua = ua + ub;
                float y = ua[0] + ua[1];
                y += dppf<0xB1>(y); y += dppf<0x4E>(y); y += dppf<0x141>(y);
                yp[(size_t)st * 1024] = y;
#pragma unroll
                for (int i = 0; i < 10; ++i) q[i] = n[i];
                vv = nv;
            }
        }
        __syncthreads();
    }
#undef RW_STEP
#undef RW_LOAD
#undef RW_BF4
#undef RW_WRITE
}

__device__ __forceinline__ void post_row(const Params& p, int t, int lane) {
    unsigned char* ws = p.ws;
    const float* Y = (const float*)(ws + WS_YRAW) + (size_t)t * 1024; const bf16_t* G = (const bf16_t*)(ws + WS_G) + (size_t)t * 1024;
    const float* AA = p.out + (size_t)MT * 1024 + (size_t)t * 1024;
    const bf16_t* cur = (const bf16_t*)(ws + WS_PRW) + (size_t)t * NF32; const bool first = (t & (SEQ - 1)) == 0; const bf16_t* prv = first ? cur : cur - NF32; const float fz = first ? 0.f : 1.f; const float* mu = p.in[8];
    bf16_t* YB = (bf16_t*)(ws + WS_KN) + (size_t)t * 1024;
#pragma unroll
    for (int pp = 0; pp < 2; ++pp) {
        f32x4 y_[2], r_[2], k_[2], v_[2], rk_[2], lg_[2], lb_[2], a_[2], ka_[2]; u32x2 g_[2];
#pragma unroll
        for (int q = 0; q < 2; ++q) { const int c = (2 * pp + q) * 256 + lane * 4;
            y_[q] = *(const f32x4*)(Y + c); a_[q] = *(const f32x4*)(AA + c); ka_[q] = *(const f32x4*)(p.in[15] + c);
            { const f32x4 rc = ld4bf(cur + c), rp = ld4bf(prv + c) * fz, kc = ld4bf(cur + 1024 + c), kp = ld4bf(prv + 1024 + c) * fz, vc = ld4bf(cur + 2048 + c), vp = ld4bf(prv + 2048 + c) * fz;
              r_[q] = rc + (rp - rc) * *(const f32x4*)(mu + c); k_[q] = kc + (kp - kc) * *(const f32x4*)(mu + 1024 + c); v_[q] = vc + (vp - vc) * *(const f32x4*)(mu + 2048 + c); }
            rk_[q] = *(const f32x4*)(p.in[16] + c); lg_[q] = *(const f32x4*)(p.in[17] + c); lb_[q] = *(const f32x4*)(p.in[18] + c); g_[q] = *(const u32x2*)(G + c); }
#pragma unroll
        for (int q = 0; q < 2; ++q) { const int c = (2 * pp + q) * 256 + lane * 4;
            const f32x4 y = y_[q];
            const float mean = rowsum16((y[0] + y[1]) + (y[2] + y[3])) * (1.f / 64.f);
            const f32x4 d = y - mean;
            const float var = rowsum16((d[0] * d[0] + d[1] * d[1]) + (d[2] * d[2] + d[3] * d[3])) * (1.f / 64.f);
            const float rs = __builtin_amdgcn_rsqf(var + LNX_EPS);
            const f32x4 yn = d * rs * lg_[q] + lb_[q];
            const f32x4 pr = r_[q] * (k_[q] * ((a_[q] - 1.f) * ka_[q] + 1.f)) * rk_[q];
            const float bs = rowsum16((pr[0] + pr[1]) + (pr[2] + pr[3]));
            const u32x2 gw = g_[q];
            const f32x4 o = (yn + v_[q] * bs) * (f32x4){bflo(gw.x), bfhi(gw.x), bflo(gw.y), bfhi(gw.y)};
            u32x2 w; w.x = pk2(o[0], o[1]); w.y = pk2(o[2], o[3]); *(u32x2*)(YB + c) = w; }
    }
}

__device__ __forceinline__ void og_row(const Params& p, int t, int lane) {
    unsigned char* ws = p.ws;
    bf16_t* O = (bf16_t*)(ws + WS_O) + (size_t)t * 1024; const bf16_t* SG = (const bf16_t*)(ws + WS_PBF) + (size_t)t * PBP + 3072;
    u32x4 o8[2], s8[2];
#pragma unroll
    for (int ps = 0; ps < 2; ++ps) { o8[ps] = *(const u32x4*)(O + ps * 512 + lane * 8); s8[ps] = *(const u32x4*)(SG + ps * 512 + lane * 8); }
#pragma unroll
    for (int ps = 0; ps < 2; ++ps) { const int c = ps * 512 + lane * 8;
        const u32x4 o = o8[ps], s = s8[ps]; u32x4 w;
        w.x = pk2(bflo(o.x) * bflo(s.x), bfhi(o.x) * bfhi(s.x)); w.y = pk2(bflo(o.y) * bflo(s.y), bfhi(o.y) * bfhi(s.y));
        w.z = pk2(bflo(o.z) * bflo(s.z), bfhi(o.z) * bfhi(s.z)); w.w = pk2(bflo(o.w) * bflo(s.w), bfhi(o.w) * bfhi(s.w));
        *(u32x4*)(O + c) = w; }
}

__device__ __forceinline__ void cumsum_job(const Params& p, int job, LAS unsigned char* lds, int tid, int wave, int lane) {
    unsigned char* ws = p.ws; float* CUM = (float*)(ws + WS_CUM); LAS float* wsum = (LAS float*)lds;
    const int b = job >> 3, h = job & 7; const float bias = p.in[5][h]; const int t0 = tid * 4; float l[4];
#pragma unroll
    for (int i = 0; i < 4; ++i) { const float x = ((const float*)(ws + WS_LF))[(size_t)(b * SEQ + t0 + i) * 256 + 192 + h] + bias; l[i] = fminf(x, 0.f) - log1pf(expf(-fabsf(x))); }
    l[1] += l[0]; l[2] += l[1]; l[3] += l[2];
    const float tot = l[3]; float sc = tot;
#pragma unroll
    for (int o = 1; o < 64; o <<= 1) { const float n = __shfl_up(sc, o); if (lane >= o) sc += n; }
    __syncthreads();
    if (lane == 63) wsum[wave] = sc;
    __syncthreads();
    float woff = 0.f;
    for (int w = 0; w < wave; ++w) woff += wsum[w];
    const float base = woff + sc - tot;
    *(f32x4*)(CUM + (size_t)job * SEQ + t0) = (f32x4){base + l[0], base + l[1], base + l[2], base + l[3]};
}

typedef __hip_bfloat16 fabt;
__device__ __forceinline__ fa::BlockRef<fabt, fabt> fa_ref(int L, int pass, const fabt* Qn, const fabt* Kn, const fabt* Vb, fabt* O, const float* CUM) {
    const int bh = (L & 127) >> 2, x = L & 3, qb = pass ? 7 - x : x, b = bh >> 3, h = bh & 7; const size_t row0 = (size_t)b * SEQ;
    fa::BlockRef<fabt, fabt> r;
    r.Q = Qn + (row0 + (size_t)qb * 256) * 1024 + h * 128; r.O = O + (row0 + (size_t)qb * 256) * 1024 + h * 128;
    r.K = Kn + row0 * 1024 + h * 128; r.V = Vb + row0 * PBP + h * 128; r.SG = Vb + (row0 + (size_t)qb * 256) * PBP + 1024 + h * 128; r.CB = CUM + bh * SEQ; r.P0 = qb * 256;
    return r;
}
#ifndef REP_P0
#define REP_P0 1
#endif
#ifndef REP_P3
#define REP_P3 1
#endif
#ifndef REP_REC
#define REP_REC 1
#endif
#ifndef REP_P10
#define REP_P10 1
#endif
#ifndef REP_P2
#define REP_P2 1
#endif
#ifndef REP_ATT
#define REP_ATT 1
#endif
#ifndef REP_P7B
#define REP_P7B 1
#endif
#ifndef REP_P8
#define REP_P8 1
#endif
#ifndef PROBE_MASK
#define PROBE_MASK 0
#endif
#ifndef PROBE_MULT
#define PROBE_MULT 8
#endif
#ifndef GU_SPLIT
#define GU_SPLIT 11264
#endif
#ifndef REP_SYNC
#define REP_SYNC 0
#endif
__global__ void __launch_bounds__(512) mk_fwd(Params p) {
    extern __shared__ __attribute__((aligned(16))) unsigned char lds_raw[];
    cg::grid_group grid = cg::this_grid();
    LAS unsigned char* lds = (LAS unsigned char*)lds_raw;
    if (threadIdx.x < 2) ((LAS unsigned*)(lds + 131072))[threadIdx.x] = 0u;
    __syncthreads();
#if PROBE_MASK
    unsigned long long* tsb = (unsigned long long*)(p.ws + WS_BAR + 49152); int nts = 0;
#define STAMP() do { if (blockIdx.x == 0 && threadIdx.x == 0) tsb[nts] = __builtin_amdgcn_s_memrealtime(); ++nts; } while (0)
#else
#define STAMP() do {} while (0)
#endif
    STAMP();
    const XcdBarrier bar = xcd_barrier_post((unsigned*)(p.ws + WS_BAR), (volatile LAS unsigned*)(lds + 131072));
    const int G = gridDim.x, blk = blockIdx.x, NGW = G * 8;
#define PHASE_IDS() int tid = threadIdx.x; asm volatile("" : "+v"(tid)); const int lane = tid & 63, wave = __builtin_amdgcn_readfirstlane(tid >> 6), gw = blk * 8 + wave; (void)gw; (void)lane; LAS float* scr = (LAS float*)(lds + wave * 8704); (void)scr
    unsigned char* ws = p.ws;
    float* MOD = (float*)(ws + WS_MOD); float* CUM = (float*)(ws + WS_CUM); float* PART = (float*)(ws + WS_PART);
    bf16_t* XN = (bf16_t*)(ws + WS_XN); bf16_t* PBF = (bf16_t*)(ws + WS_PBF); float* PF32 = (float*)(ws + WS_PF32);

    for (int rep_ = 0; rep_ < REP_P0; ++rep_) {
        PHASE_IDS();
        __syncthreads();
        LAS float* sl = (LAS float*)(lds + 73728);
        for (int i = tid; i < NB * DM; i += 512) { const float v = p.in[1][i]; sl[i] = v * sigm(v); }
        __syncthreads();
        constexpr int I_MOD = 16 * 48, I_IN = 32 * (NPROJ / 64), I_OUT = 32 * 32, I_A = 16 * 32;
        const int vgw = wave * G + blk, ntr = I_IN;
        for (int r = vgw; r < I_MOD; r += 8 * G) {
            const int ks = r / 48, cc = r % 48;
            const float* wp = p.in[2] + (size_t)(ks * 128) * NMOD + cc * 256 + lane * 4;
            f32x4 a0 = {0.f, 0.f, 0.f, 0.f}, a1 = a0, a2 = a0, a3 = a0;
#pragma unroll 32
            for (int rr = 0; rr < 128; ++rr) { const f32x4 w = __builtin_nontemporal_load((const f32x4*)(wp + (size_t)rr * NMOD)); const int d = ks * 128 + rr;
                a0 += w * sl[d]; a1 += w * sl[DM + d]; a2 += w * sl[2 * DM + d]; a3 += w * sl[3 * DM + d]; }
            float* pp = PART + (size_t)(ks * 4) * NMOD + cc * 256 + lane * 4;
            *(f32x4*)pp = a0; *(f32x4*)(pp + NMOD) = a1; *(f32x4*)(pp + 2 * NMOD) = a2; *(f32x4*)(pp + 3 * NMOD) = a3;
        }
        const bool bal = (G == 256);
        const int t_lo = bal ? (vgw < 768 ? 0 : 5 * (vgw - 768)) : vgw, t_n = bal ? (vgw < 768 ? 0 : 5) : ntr, t_st = bal ? 1 : 8 * G;
        for (int k = 0; k < t_n; ++k) {
            int r = t_lo + k * t_st; if (r >= ntr) break;
            transpose_item2(p.in[4], 11720, (bf16_t*)(ws + WS_WIN), DM, r / (NPROJ / 64), r % (NPROJ / 64), scr, lane, MapWin());
        }
        bf16_t* WL = (bf16_t*)(ws + WS_WLORA);
        for (int idx = blk * 512 + tid; idx < 3072 * 32; idx += G * 512) {
            const int n = idx % 3072, kc = idx / 3072, k0 = kc * 8; float v[8];
#pragma unroll
            for (int i = 0; i < 8; ++i) { const int k = k0 + i; float x = 0.f;
                if (n < 1024) { if (k < 96) x = p.in[10][(size_t)k * 1024 + n]; }
                else if (n < 2048) { if (k >= 128 && k < 224) x = p.in[12][(size_t)(k - 128) * 1024 + (n - 1024)]; }
                else x = p.in[13][(size_t)k * 1024 + (n - 2048)];
                v[i] = x; }
            u32x4 o; o.x = pk2(v[0], v[1]); o.y = pk2(v[2], v[3]); o.z = pk2(v[4], v[5]); o.w = pk2(v[6], v[7]);
            *(u32x4*)(WL + (size_t)n * 256 + k0) = o;
        }
    }
    grid.sync();
    STAMP();
    for (int rep_ = 0; rep_ < REP_SYNC; ++rep_) xcd_barrier(bar);

    {
        PHASE_IDS();
        LAS float* lsm = (LAS float*)lds;
        for (int rb = blk; rb < MT / 32; rb += G) {
            const int b = rb / 64;
            __syncthreads();
            for (int i = tid; i < 2 * DM; i += 512) { float s = p.in[3][i];
#pragma unroll
                for (int ks = 0; ks < 16; ++ks) s += PART[(size_t)(ks * 4 + b) * NMOD + i];
                lsm[i] = s; }
            __syncthreads();
            for (int rr = wave; rr < 32; rr += 16) { const int row = rb * 32 + rr, row2 = row + 8;
                const float* xr = p.in[0] + (size_t)row * DM + lane * 4; const float* xr2 = p.in[0] + (size_t)row2 * DM + lane * 4; f32x4 v[8], u[8];
#pragma unroll
                for (int j = 0; j < 8; ++j) { v[j] = __builtin_nontemporal_load((const f32x4*)(xr + j * 256)); u[j] = __builtin_nontemporal_load((const f32x4*)(xr2 + j * 256)); }
                float mean, rstd, mean2, rstd2; ln_stats(v, mean, rstd); ln_stats(u, mean2, rstd2);
                bf16_t* orow = XN + (size_t)row * DM + lane * 4; bf16_t* orow2 = XN + (size_t)row2 * DM + lane * 4;
#pragma unroll
                for (int j = 0; j < 8; ++j) { const int c = j * 256 + lane * 4; const f32x4 sh = *(const LAS f32x4*)(lsm + c), sc = *(const LAS f32x4*)(lsm + DM + c);
                    const f32x4 o = (v[j] - mean) * rstd * (sc + 1.f) + sh; u32x2 w; w.x = pk2(o[0], o[1]); w.y = pk2(o[2], o[3]); *(u32x2*)(orow + j * 256) = w;
                    const f32x4 o2 = (u[j] - mean2) * rstd2 * (sc + 1.f) + sh; u32x2 w2; w2.x = pk2(o2[0], o2[1]); w2.y = pk2(o2[2], o2[3]); *(u32x2*)(orow2 + j * 256) = w2; } }
        }
        for (int i = blk * 512 + tid; i < NB * NMOD; i += G * 512) { const int b = i / NMOD, col = i % NMOD; float s = p.in[3][col];
#pragma unroll
            for (int ks = 0; ks < 16; ++ks) s += PART[(size_t)(ks * 4 + b) * NMOD + col];
            MOD[i] = s; }
    }
    xcd_barrier(bar);
    STAMP();

    for (int rep_ = 0; rep_ < REP_P2; ++rep_) {
        {
        pg8::StaticOrder S; S.init(MT, NBF, G, blk);
        pg8::Gemm g{XN, (const bf16_t*)(ws + WS_WIN), MT, NBF, DM}; pg8::EpiProjBf E{PBF};
        pg8::gemm_phase<pg8::EpiProjBf, pg8::StaticOrder, true, true>(lds, g, S, E);
        }
        {
        pg8::StaticOrder S; S.init(MT, NF32, G, blk);
        pg8::Gemm g{XN, (const bf16_t*)(ws + WS_WIN) + (size_t)NBF * DM, MT, NF32, DM}; pg8::EpiRw E{(bf16_t*)(ws + WS_PRW), (float*)(ws + WS_LF)};
        pg8::gemm_phase<pg8::EpiRw, pg8::StaticOrder, true, true>(lds, g, S, E);
        }
    }
    xcd_barrier(bar);
    STAMP();

    for (int rep_ = 0; rep_ < REP_P3; ++rep_) {
        PHASE_IDS();
        __syncthreads();
        for (int row = gw; row < MT; row += NGW) prep_row(p, row, lane);
    }
    xcd_barrier(bar);
    STAMP();

    {
        { pg8::StaticOrder S; S.init(MT, 2048, G, blk);
          pg8::Gemm g{(const bf16_t*)(ws + WS_ACAT), (const bf16_t*)(ws + WS_WLORA), MT, 2048, 256};
          pg8::EpiLora E{p.in[9], p.in[11], p.out, p.out + (size_t)MT * 1024, (bf16_t*)(ws + WS_G), 0};
          pg8::gemm_phase<pg8::EpiLora, pg8::StaticOrder, true, true>(lds, g, S, E); }
    }
    xcd_barrier(bar);
    STAMP();

    if (blk >= G / 2) {
        pg8::StaticOrder S; S.init(MT, 1024, G - G / 2, blk - G / 2);
        pg8::Gemm g{(const bf16_t*)(ws + WS_ACAT2), (const bf16_t*)(ws + WS_WLORA) + (size_t)2048 * 256, MT, 1024, 256};
        pg8::EpiLora E{p.in[9], p.in[11], p.out, p.out + (size_t)MT * 1024, (bf16_t*)(ws + WS_G), 8};
        pg8::gemm_phase<pg8::EpiLora, pg8::StaticOrder, true, true>(lds, g, S, E);
    }
    {
        PHASE_IDS();
        const int NREC = G / 2;
        if (blk < NREC) {
            for (int rep_ = 0; rep_ < REP_REC; ++rep_)
            for (int job = blk; job < 128; job += NREC)
                rwkv_job(lds, job, p.in[8], p.in[14], p.in[15], (const bf16_t*)(ws + WS_PRW), p.out, p.out + (size_t)MT * 1024, (float*)(ws + WS_YRAW), tid, wave, lane);
        } else {
            const int AW = G - NREC, total = 128 * REP_ATT; int L = blk - NREC;
            for (int Lc = blk - NREC; Lc < 128; Lc += AW) cumsum_job(p, Lc >> 2, lds, tid, wave, lane);
            asm volatile("s_waitcnt vmcnt(0)" ::: "memory"); __syncthreads();
            if (L < total) {
                const fabt* Qn = (const fabt*)(ws + WS_QN); const fabt* Kn = (const fabt*)(ws + WS_KN); const fabt* Vb = (const fabt*)(ws + WS_PBF) + 2048; fabt* O = (fabt*)(ws + WS_O);
                constexpr int W = 1 << 20; char* ldsc = (char*)lds_raw;
                int pass = 0; fa::BlockRef<fabt, fabt> cur = fa_ref(L, 0, Qn, Kn, Vb, O, CUM);
                fa::Seam<fabt> S;
                fa::causal_swa_prime<fabt, fabt, 1024, 1024, PBP>(cur, W, ldsc, S);
                for (;;) {
                    const bool more_pass = pass == 0, more_item = L + AW < total, last = !more_pass && !more_item;
                    int passn = pass + 1, Ln = L;
                    if (!more_pass) { passn = 0; Ln = more_item ? L + AW : L; }
                    const fa::BlockRef<fabt, fabt> nxt = last ? cur : fa_ref(Ln, passn, Qn, Kn, Vb, O, CUM);
                    fa::causal_swa_block<fabt, fabt, 1024, 1024, PBP>(cur, nxt, SEQ, W, ldsc, S);
                    if (last) break;
                    cur = nxt; pass = passn; L = Ln;
                }
            }
            __syncthreads();
            const int aw = (blk - NREC) * 8 + wave, AWV = AW * 8;
            for (int r = aw; r < (DFF / 64) * 32; r += AWV) transpose_item2(p.in[25], DM, (bf16_t*)(ws + WS_WDOWN), DFF, r / 32, r % 32, scr, lane, MapId());
            for (int r = aw; r < 32 * (2 * DFF / 64); r += AWV) transpose_item2(p.in[24], 2 * DFF, (bf16_t*)(ws + WS_WGU), DM, r / (2 * DFF / 64), r % (2 * DFF / 64), scr, lane, MapGu());
            for (int r = aw; r < 32 * 32; r += AWV) transpose_item2(p.in[21], DM, (bf16_t*)(ws + WS_WOUT), DM, r / 32, r % 32, scr, lane, MapId());
            for (int r = aw; r < 2 * 16 * 32; r += AWV) { const int q = r & 511; transpose_item2(r < 512 ? p.in[19] : p.in[20], DM, (bf16_t*)(ws + (r < 512 ? WS_WA : WS_WB)), 1024, q / 32, q % 32, scr, lane, MapId()); }
        }
    }
    xcd_barrier(bar);
    STAMP();

    {
        PHASE_IDS();
        for (int row = gw; row < MT; row += NGW) post_row(p, row, lane);
    }
    xcd_barrier(bar);
    STAMP();

    for (int rep_ = 0; rep_ < REP_P7B; ++rep_) {
        pg8::StaticOrder S; S.init(MT, DM, G, blk);
        pg8::Gemm g{(const bf16_t*)(ws + WS_O), (const bf16_t*)(ws + WS_WA), MT, DM, 1024, (const bf16_t*)(ws + WS_KN), (const bf16_t*)(ws + WS_WB)};
        pg8::EpiMergeDual E{PBF + 4096, PBF + 6144, (bf16_t*)(ws + WS_MERGED)};
        pg8::gemm_phase<pg8::EpiMergeDual, pg8::StaticOrder, true, true, true>(lds, g, S, E);
    }
    xcd_barrier(bar);
    STAMP();

    const bool fusedln = (G == 256);
    if (fusedln) {
        pg8::StaticOrder S; S.init(MT, DM, G, blk);
        pg8::Gemm g{(const bf16_t*)(ws + WS_MERGED), (const bf16_t*)(ws + WS_WOUT), MT, DM, DM};
        pg8::EpiResLnLn E{p.in[0], p.out, XN, MOD, p.in[22], p.in[23], (float*)(ws + WS_SLOT), (float*)(ws + WS_SLOT + 512 * 1024), &bar};
        pg8::gemm_phase<pg8::EpiResLnLn, pg8::StaticOrder, false, true>(lds, g, S, E);
        xcd_barrier(bar);
    } else {
        for (int rep_ = 0; rep_ < REP_P8; ++rep_) {
            pg8::StaticOrder S; S.init(MT, DM, G, blk);
            pg8::Gemm g{(const bf16_t*)(ws + WS_MERGED), (const bf16_t*)(ws + WS_WOUT), MT, DM, DM}; pg8::EpiRes E{p.in[0], p.out, MOD + 2 * DM};
            pg8::gemm_phase<pg8::EpiRes, pg8::StaticOrder, true, true>(lds, g, S, E);
        }
        xcd_barrier(bar);
        STAMP();

        { PHASE_IDS();
        for (int row = gw; row < MT; row += 2 * NGW) {
            const int row2 = row + NGW < MT ? row + NGW : row;
            float* xr = p.out + (size_t)row * DM + lane * 4; float* xr2 = p.out + (size_t)row2 * DM + lane * 4; f32x4 v[8], u[8];
    #pragma unroll
            for (int j = 0; j < 8; ++j) { v[j] = *(const f32x4*)(xr + j * 256); u[j] = *(const f32x4*)(xr2 + j * 256); }
            float mean, rstd, mean2, rstd2; ln_stats(v, mean, rstd); ln_stats(u, mean2, rstd2);
    #pragma unroll
            for (int j = 0; j < 8; ++j) { const int c = j * 256 + lane * 4; const f32x4 g = *(const f32x4*)(p.in[22] + c), b = *(const f32x4*)(p.in[23] + c);
                v[j] = (v[j] - mean) * rstd * g + b; u[j] = (u[j] - mean2) * rstd2 * g + b; *(f32x4*)(xr + j * 256) = v[j]; if (row2 != row) *(f32x4*)(xr2 + j * 256) = u[j]; }
            ln_stats(v, mean, rstd); ln_stats(u, mean2, rstd2);
            const float* mb = MOD + (size_t)(row / SEQ) * NMOD; const float* mb2 = MOD + (size_t)(row2 / SEQ) * NMOD;
            bf16_t* orow = XN + (size_t)row * DM + lane * 4; bf16_t* orow2 = XN + (size_t)row2 * DM + lane * 4;
    #pragma unroll
            for (int j = 0; j < 8; ++j) { const int c = j * 256 + lane * 4;
                { const f32x4 sh = *(const f32x4*)(mb + 3 * DM + c), sc = *(const f32x4*)(mb + 4 * DM + c);
                  const f32x4 o = (v[j] - mean) * rstd * (sc + 1.f) + sh; u32x2 w; w.x = pk2(o[0], o[1]); w.y = pk2(o[2], o[3]); *(u32x2*)(orow + j * 256) = w; }
                if (row2 != row) { const f32x4 sh = *(const f32x4*)(mb2 + 3 * DM + c), sc = *(const f32x4*)(mb2 + 4 * DM + c);
                  const f32x4 o = (u[j] - mean2) * rstd2 * (sc + 1.f) + sh; u32x2 w; w.x = pk2(o[0], o[1]); w.y = pk2(o[2], o[3]); *(u32x2*)(orow2 + j * 256) = w; } }
        } }
        xcd_barrier(bar);
        STAMP();
    }

    for (int rep_ = 0; rep_ < REP_P10; ++rep_) {
        pg8::StaticOrder S; S.init(MT, 2 * DFF, G, blk);
        pg8::Gemm g{XN, (const bf16_t*)(ws + WS_WGU), MT, 2 * DFF, DM}; pg8::EpiSwiGLU E{PBF};
        pg8::gemm_phase<pg8::EpiSwiGLU, pg8::StaticOrder, true, true>(lds, g, S, E);
    }
    xcd_barrier(bar);
    STAMP();

    if (fusedln) {
        pg8::StaticOrder S; S.init(MT, DM, G, blk);
        pg8::Gemm g{PBF, (const bf16_t*)(ws + WS_WDOWN), MT, DM, DFF};
        pg8::EpiResLn E{p.out, p.out, MOD + 5 * DM, p.in[26], p.in[27], (float*)(ws + WS_SLOT + 1024 * 1024), &bar};
        pg8::gemm_phase<pg8::EpiResLn, pg8::StaticOrder, false, true>(lds, g, S, E);
    } else {
        {
            pg8::StaticOrder S; S.init(MT, DM, G, blk);
            pg8::Gemm g{PBF, (const bf16_t*)(ws + WS_WDOWN), MT, DM, DFF}; pg8::EpiRes E{p.out, p.out, MOD + 5 * DM};
            pg8::gemm_phase<pg8::EpiRes, pg8::StaticOrder, true, true>(lds, g, S, E);
        }
        xcd_barrier(bar);
        STAMP();

        { PHASE_IDS();
        for (int row = gw; row < MT; row += 2 * NGW) {
            const int row2 = row + NGW < MT ? row + NGW : row;
            float* xr = p.out + (size_t)row * DM + lane * 4; float* xr2 = p.out + (size_t)row2 * DM + lane * 4; f32x4 v[8], u[8];
    #pragma unroll
            for (int j = 0; j < 8; ++j) { v[j] = *(const f32x4*)(xr + j * 256); u[j] = *(const f32x4*)(xr2 + j * 256); }
            float mean, rstd, mean2, rstd2; ln_stats(v, mean, rstd); ln_stats(u, mean2, rstd2);
    #pragma unroll
            for (int j = 0; j < 8; ++j) { const int c = j * 256 + lane * 4; const f32x4 g = *(const f32x4*)(p.in[26] + c), b = *(const f32x4*)(p.in[27] + c);
                *(f32x4*)(xr + j * 256) = (v[j] - mean) * rstd * g + b; if (row2 != row) *(f32x4*)(xr2 + j * 256) = (u[j] - mean2) * rstd2 * g + b; }
        } }
    }
#if PROBE_MASK
    STAMP();
    if (blockIdx.x == 0 && threadIdx.x == 0) { unsigned long long sp = 0; for (int i = 0; i + 1 < nts; ++i) if ((PROBE_MASK >> i) & 1) sp += tsb[i + 1] - tsb[i];
        const unsigned long long t0 = __builtin_amdgcn_s_memrealtime(); while (__builtin_amdgcn_s_memrealtime() - t0 < sp * PROBE_MULT) __builtin_amdgcn_s_sleep(8); }
#endif
}

extern "C" void kernel_launch(void* const* d_in, const int* in_sizes, int n_in, void* d_out, int out_size, void* d_ws, size_t ws_size, hipStream_t stream) {
    static int grid_blocks = 0;
    if (grid_blocks == 0) {
        if (n_in != 28 || out_size != MT * DM || ws_size < WS_END) { fprintf(stderr, "kernel_launch: unexpected shapes (n_in %d out %d ws %zu, need %zu)\n", n_in, out_size, ws_size, (size_t)WS_END); grid_blocks = -1; return; }
        int dev = 0, cus = 0, per_cu = 0;
        hipGetDevice(&dev);
        hipDeviceGetAttribute(&cus, hipDeviceAttributeMultiprocessorCount, dev);
        hipFuncSetAttribute((const void*)mk_fwd, hipFuncAttributeMaxDynamicSharedMemorySize, LDS_BYTES);
        hipOccupancyMaxActiveBlocksPerMultiprocessor(&per_cu, (const void*)mk_fwd, 512, LDS_BYTES);
        if (per_cu < 1 || cus < 1) { fprintf(stderr, "kernel_launch: occupancy query failed (%d x %d)\n", cus, per_cu); grid_blocks = -1; return; }
        grid_blocks = cus * per_cu;
        if (grid_blocks > 256) grid_blocks = 256;
    }
    if (grid_blocks < 0) return;
    if (hipMemsetAsync((char*)d_ws + WS_BAR, 0, 65536, stream) != hipSuccess) { fprintf(stderr, "kernel_launch: memset of the barrier words failed\n"); return; }
    Params p{};
    for (int i = 0; i < 28; ++i) p.in[i] = (const float*)d_in[i];
    p.out = (float*)d_out; p.ws = (unsigned char*)d_ws;
    void* args[] = {&p};
    hipError_t e = hipLaunchCooperativeKernel((const void*)mk_fwd, dim3(grid_blocks), dim3(512), args, LDS_BYTES, stream);
    if (e != hipSuccess) fprintf(stderr, "cooperative launch failed: %s (grid %d)\n", hipGetErrorString(e), grid_blocks);
}
```
